# Optimizing an MI355X kernel written in HIP

```python
import jax, jax.numpy as jnp
from jax import lax
import numpy as np

D_MODEL = 2048
BATCH = 4
SEQ = 2048
DEPTH = 2

N_META = 16
NORM_EPS = 1e-5
HEAD_DIM = 64
ATT_WIDTH = D_MODEL // 2
ATT_HEADS = ATT_WIDTH // HEAD_DIM
ATT_KV_HEADS = ATT_HEADS // 4
ATT_GROUP = ATT_HEADS // ATT_KV_HEADS
Q_DIM = ATT_HEADS * HEAD_DIM
KV_DIM = ATT_KV_HEADS * HEAD_DIM
QKV_DIM = Q_DIM + 2 * KV_DIM
WINDOW = 128
BLOCK = 128
ROPE_DIM = HEAD_DIM // 4
ROPE_THETA = 500000.0
RWKV_DIM = D_MODEL - ATT_WIDTH
RWKV_HEAD_DIM = 64
RWKV_HEADS = RWKV_DIM // RWKV_HEAD_DIM
DECAY_LORA = 64
ICLR_LORA = 64
VRES_LORA = 32
GATE_LORA = 64
RWKV_IN = 3 * RWKV_DIM + DECAY_LORA + ICLR_LORA + GATE_LORA
GN_EPS = 64e-5
GATE_DIM = 2 * D_MODEL
N_IN = QKV_DIM + GATE_DIM + RWKV_IN
N_GROUPS = 8
EXPERTS_PER_GROUP = 8
N_EXPERTS = N_GROUPS * EXPERTS_PER_GROUP
TOP_K_INNER = 2
D_EXPERT = D_MODEL // 4
MOE_BLOCK = 128

kernel_name = "hybrid_swa_rwkv7_hmoe_meta"


def rms_norm(x, g):
    x32 = x.astype(jnp.float32)
    y = x32 * lax.rsqrt(jnp.mean(x32 * x32, axis=-1, keepdims=True) + NORM_EPS)
    return (y * g.astype(jnp.float32)).astype(x.dtype)


def token_shift(z):
    return jnp.pad(z, ((0, 0), (1, 0), (0, 0)))[:, :-1]


def partial_rope(x, pos):
    half = ROPE_DIM // 2
    inv = jnp.power(jnp.float32(ROPE_THETA), -jnp.arange(half, dtype=jnp.float32) / half)
    ang = pos.astype(jnp.float32)[:, None] * inv[None, :]
    cos = jnp.cos(ang)[None, :, None, :]
    sin = jnp.sin(ang)[None, :, None, :]
    xr = x[..., :ROPE_DIM].astype(jnp.float32)
    x1, x2 = xr[..., :half], xr[..., half:]
    rot = jnp.concatenate([x1 * cos - x2 * sin, x2 * cos + x1 * sin], axis=-1).astype(x.dtype)
    return jnp.concatenate([rot, x[..., ROPE_DIM:]], axis=-1)


def sliding_window_attention(q, k, v, sinks):
    B, L = q.shape[:2]
    f32 = jnp.float32
    pad = BLOCK - N_META
    nb = (L + pad) // BLOCK

    def to_blocks(t):
        t = jnp.pad(t, ((0, 0), (pad, 0)) + ((0, 0),) * (t.ndim - 2))
        return t.reshape((B, nb, BLOCK) + t.shape[2:])

    qb = to_blocks(q.reshape(B, L, ATT_KV_HEADS, ATT_GROUP, HEAD_DIM)).astype(f32)
    kb = to_blocks(k).astype(f32)
    vb = to_blocks(v)
    prev_blk = lambda t: jnp.concatenate([jnp.zeros_like(t[:, :1]), t[:, :-1]], axis=1)
    k_band = jnp.concatenate([prev_blk(kb), kb], axis=2)
    v_band = jnp.concatenate([prev_blk(vb), vb], axis=2)
    k_meta = k[:, :N_META].astype(f32)
    v_meta = v[:, :N_META]
    qpos = (jnp.arange(nb * BLOCK) - pad).reshape(nb, BLOCK)
    kpos = jnp.concatenate([qpos - BLOCK, qpos], axis=1)
    dist = qpos[:, :, None] - kpos[:, None, :]
    band_ok = (dist >= 0) & (dist < WINDOW) & (kpos[:, None, :] >= N_META)
    meta_ok = jnp.arange(N_META)[None, None, :] <= qpos[:, :, None]
    scale = HEAD_DIM ** -0.5
    s_meta = jnp.einsum('bnqhgd,bmhd->bnhgqm', qb, k_meta) * scale
    s_band = jnp.einsum('bnqhgd,bnshd->bnhgqs', qb, k_band) * scale
    neg = jnp.float32(-1e30)
    s_meta = jnp.where(meta_ok[None, :, None, None], s_meta, neg)
    s_band = jnp.where(band_ok[None, :, None, None], s_band, neg)
    sink = jnp.broadcast_to(
        sinks.astype(f32).reshape(ATT_KV_HEADS, ATT_GROUP)[None, None, :, :, None, None],
        s_meta.shape[:-1] + (1,))
    p = jax.nn.softmax(jnp.concatenate([s_meta, s_band, sink], axis=-1), axis=-1).astype(v.dtype)
    o = (jnp.einsum('bnhgqm,bmhd->bnqhgd', p[..., :N_META], v_meta)
         + jnp.einsum('bnhgqs,bnshd->bnqhgd', p[..., N_META:N_META + 2 * BLOCK], v_band))
    return o.reshape(B, nb * BLOCK, Q_DIM)[:, pad:]


def rwkv7_recurrence(r, decay, k, v, a_vec, b_vec):
    B, L, H, N = r.shape

    def step(S, inp):
        r_t, w_t, k_t, v_t, a_t, b_t = inp
        Sa = jnp.einsum('bhij,bhj->bhi', S, a_t)
        S = S * w_t[:, :, None, :] + Sa[..., None] * b_t[:, :, None, :] + v_t[..., None] * k_t[:, :, None, :]
        return S, jnp.einsum('bhij,bhj->bhi', S, r_t)

    xs = tuple(jnp.moveaxis(t, 1, 0) for t in (r, decay, k, v, a_vec, b_vec))
    _, ys = lax.scan(step, jnp.zeros((B, H, N, N), jnp.float32), xs)
    return jnp.moveaxis(ys, 0, 1)


def rwkv7_time_mix(z, u, v_first, mu, w0, w_decay_up, a0, w_iclr_up, w_gate_up,
                   k_k, k_a, r_k, ln_w, ln_b, vres):
    B, L, _ = z.shape
    H, N, C = RWKV_HEADS, RWKV_HEAD_DIM, RWKV_DIM
    f32 = jnp.float32
    zs = z + (token_shift(z) - z) * mu
    r, k, v = zs[..., :C], zs[..., C:2 * C], zs[..., 2 * C:3 * C]
    o = 3 * C
    wd = zs[..., o:o + DECAY_LORA]
    o += DECAY_LORA
    ad = zs[..., o:o + ICLR_LORA]
    o += ICLR_LORA
    gd = zs[..., o:o + GATE_LORA]
    w_log = -jax.nn.softplus(-(w0 + jnp.tanh(wd) @ w_decay_up).astype(f32)) - 0.5
    decay = jnp.exp(-jnp.exp(w_log))
    a = jax.nn.sigmoid(a0 + ad @ w_iclr_up)
    g = jax.nn.sigmoid(gd) @ w_gate_up
    if vres is None:
        v_first = v
    else:
        v_down, v_mu, v0, v_up = vres
        s = u @ v_down
        s = s + (token_shift(s) - s) * v_mu
        v = v + (v_first - v) * jax.nn.sigmoid(v0 + s @ v_up)
    heads = lambda t: t.reshape(B, L, H, N).astype(f32)
    kk = heads(k * k_k)
    kk = kk / jnp.maximum(jnp.sqrt(jnp.sum(kk * kk, axis=-1, keepdims=True)), 1e-12)
    k = k * (1 + (a - 1) * k_a)
    rh, kh, vh, ah = heads(r), heads(k), heads(v), heads(a)
    y = rwkv7_recurrence(rh, heads(decay), kh, vh, -kk, kk * ah)
    mean = jnp.mean(y, axis=-1, keepdims=True)
    var = jnp.mean(jnp.square(y - mean), axis=-1, keepdims=True)
    y = (y - mean) * lax.rsqrt(var + GN_EPS)
    y = y * ln_w.astype(f32).reshape(H, N) + ln_b.astype(f32).reshape(H, N)
    y = y + jnp.sum(rh * kh * r_k.astype(f32), axis=-1, keepdims=True) * vh
    return y.reshape(B, L, C).astype(z.dtype) * g, v_first


def hierarchical_moe(h, w_coarse, b_coarse, w_fine, b_fine, w_gate, w_up, w_down):
    B, L, D = h.shape
    T = B * L
    f32 = jnp.float32
    x = h.reshape(T, D)
    cl = (x @ w_coarse).astype(f32) + b_coarse.astype(f32)
    c_val, c_idx = lax.top_k(cl, 1)
    grp = c_idx[:, 0]
    p_grp = jnp.exp(c_val[:, 0] - jax.nn.logsumexp(cl, axis=-1))
    fl = jnp.einsum('td,dge->tge', x, w_fine).astype(f32) + b_fine.astype(f32)
    fl = jnp.take_along_axis(fl, grp[:, None, None], axis=1)[:, 0]
    f_val, f_idx = lax.top_k(fl, TOP_K_INNER)
    wts = jax.nn.softmax(f_val, axis=-1) * p_grp[:, None]
    expert = grp[:, None] * EXPERTS_PER_GROUP + f_idx

    A = T * TOP_K_INNER
    e_flat = expert.reshape(A)
    tok_flat = jnp.repeat(jnp.arange(T, dtype=jnp.int32), TOP_K_INNER)
    w_flat = wts.reshape(A)
    order = jnp.argsort(e_flat)
    e_s, tok_s, w_s = e_flat[order], tok_flat[order], w_flat[order]
    counts = jnp.zeros((N_EXPERTS,), jnp.int32).at[e_flat].add(1)
    padded = ((counts + MOE_BLOCK - 1) // MOE_BLOCK) * MOE_BLOCK
    start = jnp.cumsum(counts) - counts
    pend = jnp.cumsum(padded)
    pstart = pend - padded
    dest = pstart[e_s] + jnp.arange(A, dtype=jnp.int32) - start[e_s]
    n_blocks = -(-(A + N_EXPERTS * (MOE_BLOCK - 1)) // MOE_BLOCK)
    P = n_blocks * MOE_BLOCK
    row_tok = jnp.full((P,), T, jnp.int32).at[dest].set(tok_s)
    row_w = jnp.zeros((P,), f32).at[dest].set(w_s)
    blk_start = jnp.arange(n_blocks, dtype=jnp.int32) * MOE_BLOCK
    blk_expert = jnp.minimum(jnp.sum(blk_start[:, None] >= pend[None, :], axis=1), N_EXPERTS - 1)
    x_pad = jnp.concatenate([x, jnp.zeros((1, D), x.dtype)], axis=0)
    x_rows = x_pad[row_tok].reshape(n_blocks, MOE_BLOCK, D)

    def expert_block(args):
        xb, e = args
        hid = jax.nn.silu(xb @ w_gate[e]) * (xb @ w_up[e])
        return hid @ w_down[e]

    y_rows = lax.map(expert_block, (x_rows, blk_expert)).reshape(P, D)
    out = jax.ops.segment_sum(y_rows.astype(f32) * row_w[:, None], row_tok, num_segments=T + 1)[:T]
    return out.reshape(B, L, D).astype(h.dtype)


def setup_inputs(seed: int = 0) -> dict:
    key = jax.random.key(seed)
    keys = jax.random.split(key, 40)
    it = iter(range(40))
    nxt = lambda: keys[next(it)]
    f32 = jnp.float32
    nrm = lambda shape, scale: jax.random.normal(nxt(), shape, f32) * scale
    uni = lambda shape: jax.random.uniform(nxt(), shape, f32)
    D, C, Dl, Dr = D_MODEL, RWKV_DIM, DEPTH, DEPTH - 1
    return {
        "x": nrm((BATCH, SEQ, D), 1.0),
        "meta_tokens": nrm((N_META, D), 1.0),
        "norm_mix": 1.0 + nrm((Dl, D), 0.02),
        "w_in": nrm((Dl, D, N_IN), D ** -0.5),
        "b_qkv": nrm((Dl, QKV_DIM), 0.02),
        "sinks": nrm((Dl, ATT_HEADS), 0.5),
        "rwkv_mu": uni((Dl, RWKV_IN)),
        "rwkv_w0": jnp.linspace(-6.0, -1.0, C, dtype=f32)[None, :] + nrm((Dl, C), 0.1),
        "rwkv_w_decay_up": nrm((Dl, DECAY_LORA, C), 0.1 * DECAY_LORA ** -0.5),
        "rwkv_a0": nrm((Dl, C), 0.1),
        "rwkv_w_iclr_up": nrm((Dl, ICLR_LORA, C), ICLR_LORA ** -0.5),
        "rwkv_w_gate_up": nrm((Dl, GATE_LORA, C), GATE_LORA ** -0.5),
        "rwkv_k_k": 0.85 + nrm((Dl, C), 0.02),
        "rwkv_k_a": 1.0 + nrm((Dl, C), 0.02),
        "rwkv_r_k": nrm((Dl, RWKV_HEADS, RWKV_HEAD_DIM), 0.1),
        "rwkv_ln_w": 1.0 + nrm((Dl, C), 0.02),
        "rwkv_ln_b": nrm((Dl, C), 0.02),
        "rwkv_vres_down": nrm((Dr, D, VRES_LORA), D ** -0.5),
        "rwkv_vres_mu": uni((Dr, VRES_LORA)),
        "rwkv_v0": 1.0 + nrm((Dr, C), 0.1),
        "rwkv_vres_up": nrm((Dr, VRES_LORA, C), VRES_LORA ** -0.5),
        "w_branch_att": nrm((Dl, Q_DIM, D), Q_DIM ** -0.5),
        "w_branch_rwkv": nrm((Dl, C, D), C ** -0.5),
        "w_out": nrm((Dl, D, D), D ** -0.5),
        "norm_ffn": 1.0 + nrm((Dl, D), 0.02),
        "w_coarse": nrm((Dl, D, N_GROUPS), D ** -0.5),
        "b_coarse": nrm((Dl, N_GROUPS), 0.01),
        "w_fine": nrm((Dl, D, N_GROUPS, EXPERTS_PER_GROUP), D ** -0.5),
        "b_fine": nrm((Dl, N_GROUPS, EXPERTS_PER_GROUP), 0.01),
        "w_exp_gate": nrm((Dl, N_EXPERTS, D, D_EXPERT), D ** -0.5),
        "w_exp_up": nrm((Dl, N_EXPERTS, D, D_EXPERT), D ** -0.5),
        "w_exp_down": nrm((Dl, N_EXPERTS, D_EXPERT, D), D_EXPERT ** -0.5),
        "norm_final": 1.0 + nrm((D,), 0.02),
    }


def reference(x, meta_tokens, norm_mix, w_in, b_qkv, sinks, rwkv_mu, rwkv_w0, rwkv_w_decay_up,
              rwkv_a0, rwkv_w_iclr_up, rwkv_w_gate_up, rwkv_k_k, rwkv_k_a, rwkv_r_k, rwkv_ln_w,
              rwkv_ln_b, rwkv_vres_down, rwkv_vres_mu, rwkv_v0, rwkv_vres_up, w_branch_att,
              w_branch_rwkv, w_out, norm_ffn, w_coarse, b_coarse, w_fine, b_fine, w_exp_gate,
              w_exp_up, w_exp_down, norm_final):
    B = x.shape[0]
    meta = jnp.broadcast_to(meta_tokens.astype(x.dtype)[None], (B, N_META, D_MODEL))
    h = jnp.concatenate([meta, x], axis=1)
    L = h.shape[1]
    pos = jnp.arange(L)
    v_first = None
    for l in range(DEPTH):
        u = rms_norm(h, norm_mix[l])
        z = u @ w_in[l]
        z_qkv = z[..., :QKV_DIM] + b_qkv[l]
        z_gate = z[..., QKV_DIM:QKV_DIM + GATE_DIM]
        z_rwkv = z[..., QKV_DIM + GATE_DIM:]
        q = partial_rope(z_qkv[..., :Q_DIM].reshape(B, L, ATT_HEADS, HEAD_DIM), pos)
        k = partial_rope(z_qkv[..., Q_DIM:Q_DIM + KV_DIM].reshape(B, L, ATT_KV_HEADS, HEAD_DIM), pos)
        v = z_qkv[..., Q_DIM + KV_DIM:].reshape(B, L, ATT_KV_HEADS, HEAD_DIM)
        o_att = sliding_window_attention(q, k, v, sinks[l])
        vres = None if l == 0 else (rwkv_vres_down[l - 1], rwkv_vres_mu[l - 1],
                                    rwkv_v0[l - 1], rwkv_vres_up[l - 1])
        o_rwkv, v_first = rwkv7_time_mix(z_rwkv, u, v_first, rwkv_mu[l], rwkv_w0[l],
                                         rwkv_w_decay_up[l], rwkv_a0[l], rwkv_w_iclr_up[l],
                                         rwkv_w_gate_up[l], rwkv_k_k[l], rwkv_k_a[l], rwkv_r_k[l],
                                         rwkv_ln_w[l], rwkv_ln_b[l], vres)
        g_att = jax.nn.sigmoid(z_gate[..., :D_MODEL])
        g_rwkv = jax.nn.sigmoid(z_gate[..., D_MODEL:])
        mixed = g_att * (o_att @ w_branch_att[l]) + g_rwkv * (o_rwkv @ w_branch_rwkv[l])
        h = h + mixed @ w_out[l]
        h = h + hierarchical_moe(rms_norm(h, norm_ffn[l]), w_coarse[l], b_coarse[l], w_fine[l],
                                 b_fine[l], w_exp_gate[l], w_exp_up[l], w_exp_down[l])
    h = rms_norm(h, norm_final)
    return h[:, N_META:]
```

```cpp
#include <hip/hip_runtime.h>
#include <cstdio>
#include <cstdint>

#ifndef MK_N_LAUNCHES
#define MK_N_LAUNCHES 1
#endif

#define GAS __attribute__((address_space(1)))
#define LAS __attribute__((address_space(3)))
typedef unsigned short bf16;
typedef short bf16x8 __attribute__((ext_vector_type(8)));
typedef float f32x4 __attribute__((ext_vector_type(4)));
typedef float f32x2 __attribute__((ext_vector_type(2)));
typedef float f32x16 __attribute__((ext_vector_type(16)));
typedef unsigned u32x4 __attribute__((ext_vector_type(4)));
typedef unsigned u32x2 __attribute__((ext_vector_type(2)));
typedef __bf16 bf16x2_t __attribute__((ext_vector_type(2)));
typedef GAS unsigned gu32;
#define RLX_AGENT __ATOMIC_RELAXED, __HIP_MEMORY_SCOPE_AGENT
#define DI __device__ __forceinline__

constexpr int D = 2048, NB = 4, SEQ = 2048, NMETA = 16, L = SEQ + NMETA, T = NB * L  , TP = 8448  ;
constexpr int NIN = 8896, NZ = 8960  ;
constexpr int ZQ = 0, ZK = 1024, ZV = 1280, ZGA = 1536, ZGR = 3584, ZR0 = 5632, ZVD = 8896;
constexpr int C = 1024, NH = 16, HD = 64;
constexpr int NEXP = 64, DEXP = 512, PR = 128 * 256;
constexpr int LPAD = 2080;
constexpr float NORM_EPS = 1e-5f, GN_EPS = 64e-5f;
constexpr int NWAVES = 8, NTHR = 512;
constexpr int MBIG = 8192;
static_assert(T - MBIG == 64, "skinny64 covers exactly 64 rows");

constexpr size_t al256(size_t x) { return (x + 255) & ~(size_t)255; }
constexpr size_t WS_CTL = 0, CTL_BYTES = 1u << 20;
constexpr size_t WS_H = WS_CTL + CTL_BYTES;
constexpr size_t WS_U = WS_H + (size_t)TP * D * 4;
constexpr size_t WS_Z = WS_U + (size_t)TP * D * 2;
constexpr size_t WS_R = WS_Z + (size_t)TP * NZ * 2;
constexpr size_t SZ_TC = (size_t)T * C * 4;
constexpr size_t WS_W = WS_R + SZ_TC, WS_K = WS_W + SZ_TC, WS_V = WS_K + SZ_TC, WS_KK = WS_V + SZ_TC, WS_B = WS_KK + SZ_TC;
constexpr size_t WS_Y = WS_B + SZ_TC, WS_VF = WS_Y + SZ_TC, WS_G = WS_VF + SZ_TC;
constexpr size_t WS_RK = WS_G + SZ_TC;
constexpr size_t WS_VT = al256(WS_RK + (size_t)T * NH * 4);
constexpr size_t WS_OATT = al256(WS_VT + (size_t)NB * 4 * HD * LPAD * 2);
constexpr size_t WS_ORW = WS_OATT + (size_t)TP * C * 2;
constexpr size_t WS_T1 = WS_ORW + (size_t)TP * C * 2;
constexpr size_t WS_MIX = WS_T1 + (size_t)TP * D * 2;
constexpr size_t WS_XR = WS_MIX + (size_t)TP * D * 2;
constexpr size_t WS_HID = WS_XR + (size_t)PR * D * 2;
constexpr size_t WS_YR = WS_HID + (size_t)PR * DEXP * 2;
constexpr size_t WS_TOKE = WS_YR + (size_t)PR * D * 2;
constexpr size_t WS_TOKS = al256(WS_TOKE + (size_t)T * 2 * 4);
constexpr size_t WS_TOKW = al256(WS_TOKS + (size_t)T * 2 * 4);
constexpr size_t WS_ELIST = al256(WS_TOKW + (size_t)T * 2 * 4);
constexpr size_t WS_ROPE = al256(WS_ELIST + (size_t)NEXP * T * 4);
constexpr size_t WS_BIAS = al256(WS_ROPE + (size_t)L * 16 * 4);
constexpr size_t WS_W1T = al256(WS_BIAS + (size_t)2 * NZ * 4);
constexpr size_t WS_WAT = WS_W1T + (size_t)2 * NZ * D * 2;
constexpr size_t WS_WRT = WS_WAT + (size_t)2 * D * C * 2;
constexpr size_t WS_WOT = WS_WRT + (size_t)2 * D * C * 2;
constexpr size_t WS_WRO = WS_WOT + (size_t)2 * D * D * 2;
constexpr size_t WS_LDEC = WS_WRO + (size_t)2 * 80 * D * 2;
constexpr size_t WS_LICL = WS_LDEC + (size_t)2 * C * 64 * 2;
constexpr size_t WS_LGAT = WS_LICL + (size_t)2 * C * 64 * 2;
constexpr size_t WS_LVUP = WS_LGAT + (size_t)2 * C * 64 * 2;
constexpr size_t WS_END = WS_LVUP + (size_t)C * 32 * 2;
constexpr int CW_TMO = 0, CW_BAR = 4096, CW_CNT = 16384;

constexpr int RING_BYTES = 131072, LDSCTL_OFF = RING_BYTES, LDS_BYTES = 147456;
constexpr int LC_BAR = 0, LC_NTILE = 16, LC_TILEE = 32  , LC_PSTART = 32 + 512  , LC_CNT = LC_PSTART + 256  ;

DI unsigned pk2(float a, float b) { f32x2 v = {a, b}; bf16x2_t r = __builtin_convertvector(v, bf16x2_t); return __builtin_bit_cast(unsigned, r); }
DI float bf2f(unsigned short b) { return __builtin_bit_cast(float, (unsigned)b << 16); }
DI float bflo(unsigned u) { return __builtin_bit_cast(float, u << 16); }
DI float bfhi(unsigned u) { return __builtin_bit_cast(float, u & 0xffff0000u); }
DI float wave_sum(float v) {
#pragma unroll
    for (int o = 1; o < 64; o <<= 1) v += __shfl_xor(v, o);
    return v;
}
DI float sigmoidf_(float x) { return 1.f / (1.f + __expf(-x)); }
#define LDS_WAIT() asm volatile("s_waitcnt lgkmcnt(0)" ::: "memory")
#define VM_WAIT() asm volatile("s_waitcnt vmcnt(0)" ::: "memory")

#define XB_TMO      128
#define XB_XCNT(j)  (256  + 64 * (j))
#define XB_XSUB(j)  (1280 + 64 * (j))
#define XB_XGEN(j)  (2304 + 64 * (j))
#define XB_TOP      3328
#define XB_TOPGEN   3392
#define XCD_BAR_WORDS 3456
#define XB_SPIN_CAP (1u << 22)

__device__ __forceinline__ unsigned xb_ld(unsigned* p)              { return __hip_atomic_load(p, __ATOMIC_RELAXED, __HIP_MEMORY_SCOPE_AGENT); }
__device__ __forceinline__ unsigned xb_add(unsigned* p, unsigned v) { return __hip_atomic_fetch_add(p, v, __ATOMIC_RELAXED, __HIP_MEMORY_SCOPE_AGENT); }
__device__ __forceinline__ unsigned xb_xcc_id() { return (unsigned)__builtin_amdgcn_s_getreg((3 << 11) | 20) & 0xFu; }
#define XB_SPIN(cond, bar) do { unsigned _sp = 0; while (cond) { __builtin_amdgcn_s_sleep(1); \
    if ((++_sp & 255u) == 0u) { if (xb_ld(&(bar)[XB_TMO])) break; if (_sp > XB_SPIN_CAP) { atomicAdd(&(bar)[XB_TMO], 1u); break; } } } } while (0)

struct XcdBarrier { unsigned* bar; unsigned x; volatile LAS unsigned* st; };

__device__ __forceinline__ XcdBarrier xcd_barrier_post(unsigned* bar, volatile LAS unsigned* st) {
    XcdBarrier b; b.bar = bar; b.x = xb_xcc_id(); b.st = st;
    if (threadIdx.x == 0) (void)xb_add(&bar[XB_XCNT(b.x)], 1u);
    return b;
}
__device__ __forceinline__ void xcd_barrier_complete(unsigned* bar, unsigned x, unsigned& nloc, unsigned& nx) {
    const unsigned G = gridDim.x * gridDim.y * gridDim.z;
    unsigned sum, cnt, mine, sp = 0u;
    for (;;) {
        sum = 0u; cnt = 0u; mine = 0u;
#pragma unroll
        for (unsigned j = 0; j < 16; ++j) { const unsigned c = xb_ld(&bar[XB_XCNT(j)]); sum += c; cnt += (c > 0u) ? 1u : 0u; mine = (j == x) ? c : mine; }
        if (sum == G) break;
        __builtin_amdgcn_s_sleep(1);
        if ((++sp & 255u) == 0u) { if (xb_ld(&bar[XB_TMO])) break; if (sp > XB_SPIN_CAP) { atomicAdd(&bar[XB_TMO], 1u); break; } }
    }
    nloc = mine > 0u ? mine : 1u; nx = cnt > 0u ? cnt : 1u;
}
__device__ __forceinline__ void xcd_barrier(const XcdBarrier& b) {
    asm volatile("s_waitcnt vmcnt(0)" ::: "memory");
    __syncthreads();
    if (threadIdx.x == 0) {
        unsigned* bar = b.bar;
        __builtin_amdgcn_s_waitcnt(0);
        unsigned nloc = b.st[0], nx = b.st[1];
        if (nloc == 0u) { xcd_barrier_complete(bar, b.x, nloc, nx); b.st[0] = nloc; b.st[1] = nx; }
        const unsigned old = xb_add(&bar[XB_XSUB(b.x)], 1u);
        const unsigned gen = old / nloc;
        if (old + 1u == (gen + 1u) * nloc) {
            __builtin_amdgcn_fence(__ATOMIC_RELEASE, "agent");
            asm volatile("s_waitcnt vmcnt(0)" ::: "memory");
            const unsigned og = xb_add(&bar[XB_TOP], 1u);
            const unsigned tg = og / nx;
            if (og + 1u == (tg + 1u) * nx) xb_add(&bar[XB_TOPGEN], 1u);
            else XB_SPIN(xb_ld(&bar[XB_TOPGEN]) == tg, bar);
            __builtin_amdgcn_fence(__ATOMIC_ACQUIRE, "agent");
            xb_add(&bar[XB_XGEN(b.x)], 1u);
            asm volatile("s_waitcnt vmcnt(0)" ::: "memory");
        } else {
            XB_SPIN(xb_ld(&bar[XB_XGEN(b.x)]) == gen, bar);
            __builtin_amdgcn_fence(__ATOMIC_ACQUIRE, "agent");
            asm volatile("s_waitcnt vmcnt(0)" ::: "memory");
        }
    }
    __syncthreads();
}

DI const float* resid_row(const float* H, const float* x, const float* meta, int m) {
    if (!x) return H + (size_t)m * D;
    const int b = m / L, t = m - b * L; return (t < NMETA) ? meta + (size_t)t * D : x + ((size_t)b * SEQ + (t - NMETA)) * D;
}
namespace pg8 {
constexpr int BM = 256, BK = 64, HALF = 128, HTB = HALF * BK * 2, STAGE_BYTES = 8 * HTB, NXCD = 8, WGM = 8;
__host__ __device__ __forceinline__ int lds_byte(int r, int c) { const int st = (r >> 4) * 2 + (c >> 5), rr = r & 15, cc = c & 31, ob = rr * 64 + cc * 2; return st * 1024 + (ob ^ (((ob >> 9) & 1) << 5)); }
__host__ __device__ __forceinline__ void stage_rc(int b, int& R, int& Cc) { const int st = b / 1024, sb = b % 1024, swz = sb ^ (((sb >> 9) & 1) << 5); R = (st >> 1) * 16 + swz / 64; Cc = (st & 1) * 32 + (swz % 64) / 2; }
__host__ __device__ __forceinline__ int perm32(int rho) { const int n = rho >> 4, i = rho & 15; return 8 * (i >> 2) + 4 * n + (i & 3); }

struct Unit { const char* A; const char* B; int pm, pn; };
struct Dims { int lda, ldb, nt; };

struct RectOrder {
    const char* A; const char* B; int lda, ldb; int nM, nN, nwg, G, c;
    __device__ void init(const void* A_, const void* B_, int lda_, int ldb_, int nM_, int nN_, int G_, int c_) { A = (const char*)A_; B = (const char*)B_; lda = lda_; ldb = ldb_; nM = nM_; nN = nN_; nwg = nM * nN; G = G_; c = c_; }
    __device__ bool next(int i, Unit& u) const {
        const long Lx = (long)i * G + c; if (Lx >= nwg) return false;
        int wgid = (int)Lx; { const int q = nwg / NXCD, r = nwg % NXCD, xcd = wgid % NXCD, off = wgid / NXCD; wgid = (xcd < r ? xcd * (q + 1) : r * (q + 1) + (xcd - r) * q) + off; }
        const int nig = WGM * nN, gid = wgid / nig, fm = gid * WGM, gsz = (nM - fm) < WGM ? (nM - fm) : WGM;
        u.pm = fm + ((wgid % nig) % gsz); u.pn = (wgid % nig) / gsz;
        u.A = A + (size_t)u.pm * BM * lda * 2; u.B = B + (size_t)u.pn * BM * ldb * 2; return true;
    }
};
template <class Epi, class Sched, bool ALIGN_EPI = true, bool SP2 = true>
__device__ __forceinline__ void gemm_phase(LAS unsigned char* lds, const Dims g, const Sched& S, const Epi& E) {
    int tid = threadIdx.x; asm volatile("" : "+v"(tid));
    const int wid = __builtin_amdgcn_readfirstlane(tid >> 6), lane = tid & 63, wr = wid >> 2, wc = wid & 3, fr = lane & 15, fq = lane >> 4;
    const int nt = g.nt;
    unsigned voffA[2], voffB[2];
#pragma unroll
    for (int i = 0; i < 2; ++i) { int R, Cc; stage_rc(tid * 16 + i * 8192, R, Cc); const int Rb = Epi::PERM ? ((R & ~31) + perm32(R & 31)) : R;
        voffA[i] = (unsigned)(R * g.lda + Cc) * 2u; voffB[i] = (unsigned)(Rb * g.ldb + Cc) * 2u; }
    const size_t kstep = (size_t)(BK * 2);
    const size_t hstepA = (size_t)HALF * g.lda * 2, hstepB = (size_t)HALF * g.ldb * 2;
    const unsigned ldsw = (unsigned)wid * 1024u;
    const int aoff = lds_byte(wr * 64 + fr, fq * 8), boff = lds_byte(wc * 32 + fr, fq * 8);
#define PG8_SA(b, h) (((b) * 2 + (h)) * HTB)
#define PG8_SB(b, h) ((4 + (b) * 2 + (h)) * HTB)
#define PG8_STAGE(bufoff, gbase, voff) do { _Pragma("unroll") for (int _i = 0; _i < 2; ++_i) \
        __builtin_amdgcn_global_load_lds((const unsigned*)((const char*)(gbase) + (voff)[_i]), (LAS unsigned*)(lds + (bufoff) + ldsw + _i * 8192), 16, 0, 0); } while (0)
#define PG8_LDA(dst, b, h) do { _Pragma("unroll") for (int m = 0; m < 4; ++m) _Pragma("unroll") for (int k = 0; k < 2; ++k) dst[m][k] = *(const LAS bf16x8*)(lds + PG8_SA(b, h) + aoff + m * 2048 + k * 1024); } while (0)
#define PG8_LDB(dst, b, h) do { _Pragma("unroll") for (int n = 0; n < 2; ++n) _Pragma("unroll") for (int k = 0; k < 2; ++k) dst[n][k] = *(const LAS bf16x8*)(lds + PG8_SB(b, h) + boff + n * 2048 + k * 1024); } while (0)
#define PG8_MMA(ai, bj, At, Bt) do { __builtin_amdgcn_s_setprio(1); _Pragma("unroll") for (int m = 0; m < 4; ++m) _Pragma("unroll") for (int n = 0; n < 2; ++n) _Pragma("unroll") for (int k = 0; k < 2; ++k) \
        acc[ai][bj][m][n] = __builtin_amdgcn_mfma_f32_16x16x32_bf16(Bt[n][k], At[m][k], acc[ai][bj][m][n], 0, 0, 0); __builtin_amdgcn_s_setprio(0); } while (0)
#define PG8_WAIT_V(n) asm volatile("s_waitcnt vmcnt(" #n ")" ::: "memory")
#define PG8_WAIT_L(n) asm volatile("s_waitcnt lgkmcnt(" #n ")" ::: "memory")
#define PG8_BAR __builtin_amdgcn_s_barrier()
#define PG8_SCHED __builtin_amdgcn_sched_barrier(0)
    Unit cur, nxt; int ui = 0;
    if (!S.next(0, cur)) return;
    f32x4 acc[2][2][4][2];
#pragma unroll
    for (int a = 0; a < 2; ++a)
#pragma unroll
        for (int b = 0; b < 2; ++b)
#pragma unroll
            for (int m = 0; m < 4; ++m)
#pragma unroll
                for (int n = 0; n < 2; ++n) acc[a][b][m][n] = (f32x4){0.f, 0.f, 0.f, 0.f};
    bf16x8 At[4][2], B0[2][2], B1[2][2];
    const char* cA = cur.A; const char* cB = cur.B;
    if constexpr (SP2) {
        PG8_STAGE(PG8_SB(0, 0), cB, voffB); PG8_STAGE(PG8_SB(0, 1), cB + hstepB, voffB); PG8_STAGE(PG8_SA(0, 0), cA, voffA); PG8_STAGE(PG8_SA(0, 1), cA + hstepA, voffA);
        if (wr == 1) PG8_BAR;
        PG8_WAIT_V(2); PG8_BAR;
        PG8_STAGE(PG8_SB(1, 0), cB + kstep, voffB); PG8_STAGE(PG8_SA(1, 0), cA + kstep, voffA); PG8_STAGE(PG8_SB(1, 1), cB + hstepB + kstep, voffB);
        PG8_WAIT_V(6); PG8_BAR;
    } else {
        PG8_STAGE(PG8_SB(0, 0), cB, voffB); PG8_STAGE(PG8_SA(0, 0), cA, voffA); PG8_STAGE(PG8_SB(0, 1), cB + hstepB, voffB); PG8_STAGE(PG8_SA(0, 1), cA + hstepA, voffA);
        if (wr == 1) PG8_BAR;
        PG8_WAIT_V(4); PG8_BAR;
        PG8_STAGE(PG8_SB(1, 0), cB + kstep, voffB); PG8_STAGE(PG8_SA(1, 0), cA + kstep, voffA); PG8_STAGE(PG8_SB(1, 1), cB + hstepB + kstep, voffB);
        PG8_WAIT_V(6); PG8_BAR;
    }
    for (;;) {
        const bool has_next = S.next(ui + 1, nxt);
        const char* nA = has_next ? nxt.A : cA; const char* nB = has_next ? nxt.B : cB;
        for (int t = 0; t < nt; t += 2) {
            const bool last = (t == nt - 2);
            const char* a1 = cA + (size_t)(t + 1) * kstep;
            const char* a2 = last ? nA : cA + (size_t)(t + 2) * kstep; const char* b2 = last ? nB : cB + (size_t)(t + 2) * kstep;
            const char* a3 = a2 + kstep; const char* b3 = b2 + kstep;
            if constexpr (SP2) {
            PG8_LDB(B0, 0, 0); PG8_LDB(B1, 0, 1); PG8_SCHED; PG8_LDA(At, 0, 0); PG8_STAGE(PG8_SA(1, 1), a1 + hstepA, voffA);
            PG8_WAIT_V(8); PG8_WAIT_L(0); PG8_BAR; PG8_MMA(0, 0, At, B0); PG8_MMA(0, 1, At, B1); PG8_BAR; PG8_SCHED;
            PG8_LDA(At, 0, 1); PG8_STAGE(PG8_SB(0, 0), b2, voffB); PG8_STAGE(PG8_SB(0, 1), b2 + hstepB, voffB); PG8_STAGE(PG8_SA(0, 0), a2, voffA);
            PG8_WAIT_V(8); PG8_WAIT_L(0); PG8_BAR; PG8_MMA(1, 0, At, B0); PG8_MMA(1, 1, At, B1); PG8_BAR; PG8_SCHED;
            PG8_LDB(B0, 1, 0); PG8_LDB(B1, 1, 1); PG8_SCHED; PG8_LDA(At, 1, 0); PG8_STAGE(PG8_SA(0, 1), a2 + hstepA, voffA);
            PG8_WAIT_V(8); PG8_WAIT_L(0); PG8_BAR; PG8_MMA(0, 0, At, B0); PG8_MMA(0, 1, At, B1); PG8_BAR; PG8_SCHED;
            PG8_LDA(At, 1, 1); PG8_STAGE(PG8_SB(1, 0), b3, voffB); PG8_STAGE(PG8_SB(1, 1), b3 + hstepB, voffB); PG8_STAGE(PG8_SA(1, 0), a3, voffA);
            PG8_WAIT_V(8); PG8_WAIT_L(0); PG8_BAR; PG8_MMA(1, 0, At, B0); PG8_MMA(1, 1, At, B1); PG8_BAR; PG8_SCHED;
            } else {
            PG8_LDB(B0, 0, 0); PG8_SCHED; PG8_LDA(At, 0, 0); PG8_STAGE(PG8_SA(1, 1), a1 + hstepA, voffA);
            PG8_WAIT_L(8); PG8_BAR; PG8_WAIT_L(0); PG8_MMA(0, 0, At, B0); PG8_BAR; PG8_SCHED;
            PG8_LDB(B1, 0, 1); PG8_STAGE(PG8_SB(0, 0), b2, voffB);
            PG8_BAR; PG8_WAIT_L(0); PG8_MMA(0, 1, At, B1); PG8_BAR;
            PG8_LDA(At, 0, 1); PG8_STAGE(PG8_SA(0, 0), a2, voffA);
            PG8_BAR; PG8_WAIT_L(0); PG8_MMA(1, 0, At, B0); PG8_BAR; PG8_SCHED;
            PG8_STAGE(PG8_SB(0, 1), b2 + hstepB, voffB);
            PG8_WAIT_V(6); PG8_BAR; PG8_MMA(1, 1, At, B1); PG8_BAR;
            PG8_LDB(B0, 1, 0); PG8_SCHED; PG8_LDA(At, 1, 0); PG8_STAGE(PG8_SA(0, 1), a2 + hstepA, voffA);
            PG8_WAIT_L(8); PG8_BAR; PG8_WAIT_L(0); PG8_MMA(0, 0, At, B0); PG8_BAR; PG8_SCHED;
            PG8_LDB(B1, 1, 1); PG8_STAGE(PG8_SB(1, 0), b3, voffB);
            PG8_BAR; PG8_WAIT_L(0); PG8_MMA(0, 1, At, B1); PG8_BAR;
            PG8_LDA(At, 1, 1); PG8_STAGE(PG8_SA(1, 0), a3, voffA);
            PG8_BAR; PG8_WAIT_L(0); PG8_MMA(1, 0, At, B0); PG8_BAR; PG8_SCHED;
            PG8_STAGE(PG8_SB(1, 1), b3 + hstepB, voffB);
            PG8_WAIT_V(6); PG8_BAR; PG8_MMA(1, 1, At, B1); PG8_BAR;
            }
        }
        if constexpr (ALIGN_EPI) { if (wr == 0) PG8_BAR; }
        E(acc, cur, wr, wc, fr, fq);
        if (!has_next) break;
#pragma unroll
        for (int a = 0; a < 2; ++a)
#pragma unroll
            for (int b = 0; b < 2; ++b)
#pragma unroll
                for (int m = 0; m < 4; ++m)
#pragma unroll
                    for (int n = 0; n < 2; ++n) acc[a][b][m][n] = (f32x4){0.f, 0.f, 0.f, 0.f};
        cur = nxt; cA = nA; cB = nB; ++ui;
        if constexpr (ALIGN_EPI) { if (wr == 1) PG8_BAR; }
    }
    PG8_WAIT_V(0);
    if constexpr (!ALIGN_EPI) { if (wr == 0) PG8_BAR; }
    PG8_BAR;
#undef PG8_SA
#undef PG8_SB
#undef PG8_STAGE
#undef PG8_LDA
#undef PG8_LDB
#undef PG8_MMA
#undef PG8_WAIT_V
#undef PG8_WAIT_L
#undef PG8_BAR
#undef PG8_SCHED
}

struct EpiBf16 {
    static constexpr bool PERM = true;
    bf16* O; int ldc; const float* bias;
    DI void operator()(const f32x4 (&acc)[2][2][4][2], const Unit& u, int wr, int wc, int fr, int fq) const {
        const int row0 = u.pm * BM + wr * 64 + fr, col0 = u.pn * BM + wc * 32 + 8 * fq;
        f32x4 bv[2][2];
#pragma unroll
        for (int bj = 0; bj < 2; ++bj)
#pragma unroll
            for (int n = 0; n < 2; ++n) bv[bj][n] = bias ? *(const f32x4*)(bias + col0 + bj * HALF + 4 * n) : (f32x4){0.f, 0.f, 0.f, 0.f};
#pragma unroll
        for (int ai = 0; ai < 2; ++ai)
#pragma unroll
            for (int m = 0; m < 4; ++m) { bf16* rowp = O + (size_t)(row0 + ai * HALF + m * 16) * ldc + col0;
#pragma unroll
                for (int bj = 0; bj < 2; ++bj) { const f32x4 v0 = acc[ai][bj][m][0] + bv[bj][0], v1 = acc[ai][bj][m][1] + bv[bj][1];
                    u32x4 w; w.x = pk2(v0[0], v0[1]); w.y = pk2(v0[2], v0[3]); w.z = pk2(v1[0], v1[1]); w.w = pk2(v1[2], v1[3]);
                    *(u32x4*)(rowp + bj * HALF) = w; } }
    }
};
struct EpiGate {
    static constexpr bool PERM = true;
    bf16* O; const bf16* Zg; int goff; const bf16* add;
    DI void operator()(const f32x4 (&acc)[2][2][4][2], const Unit& u, int wr, int wc, int fr, int fq) const {
        const int row0 = u.pm * BM + wr * 64 + fr, col0 = u.pn * BM + wc * 32 + 8 * fq;
#pragma unroll
        for (int ai = 0; ai < 2; ++ai)
#pragma unroll
            for (int m = 0; m < 4; ++m) { const size_t row = (size_t)(row0 + ai * HALF + m * 16);
#pragma unroll
                for (int bj = 0; bj < 2; ++bj) {
                    const int col = col0 + bj * HALF;
                    const u32x4 gz = *(const u32x4*)(Zg + row * NZ + goff + col);
                    float a[8] = {0.f, 0.f, 0.f, 0.f, 0.f, 0.f, 0.f, 0.f};
                    if (add) { const u32x4 t = *(const u32x4*)(add + row * D + col); a[0] = bflo(t.x); a[1] = bfhi(t.x); a[2] = bflo(t.y); a[3] = bfhi(t.y); a[4] = bflo(t.z); a[5] = bfhi(t.z); a[6] = bflo(t.w); a[7] = bfhi(t.w); }
                    const f32x4 v0 = acc[ai][bj][m][0], v1 = acc[ai][bj][m][1];
                    float o[8];
                    o[0] = a[0] + sigmoidf_(bflo(gz.x)) * v0[0]; o[1] = a[1] + sigmoidf_(bfhi(gz.x)) * v0[1];
                    o[2] = a[2] + sigmoidf_(bflo(gz.y)) * v0[2]; o[3] = a[3] + sigmoidf_(bfhi(gz.y)) * v0[3];
                    o[4] = a[4] + sigmoidf_(bflo(gz.z)) * v1[0]; o[5] = a[5] + sigmoidf_(bfhi(gz.z)) * v1[1];
                    o[6] = a[6] + sigmoidf_(bflo(gz.w)) * v1[2]; o[7] = a[7] + sigmoidf_(bfhi(gz.w)) * v1[3];
                    u32x4 w; w.x = pk2(o[0], o[1]); w.y = pk2(o[2], o[3]); w.z = pk2(o[4], o[5]); w.w = pk2(o[6], o[7]);
                    *(u32x4*)(O + row * D + col) = w; } }
    }
};
struct EpiResAdd {
    static constexpr bool PERM = false;
    float* H; const float* x; const float* meta;
    DI void operator()(const f32x4 (&acc)[2][2][4][2], const Unit& u, int wr, int wc, int fr, int fq) const {
        const int row0 = u.pm * BM + wr * 64 + fr, col0 = u.pn * BM + wc * 32 + 4 * fq;
#pragma unroll
        for (int ai = 0; ai < 2; ++ai)
#pragma unroll
            for (int m = 0; m < 4; ++m) { const int row = row0 + ai * HALF + m * 16; float* rowp = H + (size_t)row * D + col0; const float* srcp = resid_row(H, x, meta, row) + col0;
#pragma unroll
                for (int bj = 0; bj < 2; ++bj)
#pragma unroll
                    for (int n = 0; n < 2; ++n) { *(f32x4*)(rowp + bj * HALF + n * 16) = *(const f32x4*)(srcp + bj * HALF + n * 16) + acc[ai][bj][m][n]; } }
    }
};
}

struct SkZ    { bf16* Z; const float* bias; DI void operator()(int row, int col, f32x4 v) const { v = v + *(const f32x4*)(bias + col); *(u32x2*)(Z + (size_t)row * NZ + col) = (u32x2){pk2(v[0], v[1]), pk2(v[2], v[3])}; } };
struct SkGate { bf16* O; const bf16* Zg; int goff; const bf16* add;
    DI void operator()(int row, int col, f32x4 v) const { const u32x2 gz = *(const u32x2*)(Zg + (size_t)row * NZ + goff + col); float a0 = 0.f, a1 = 0.f, a2 = 0.f, a3 = 0.f;
        if (add) { const u32x2 t = *(const u32x2*)(add + (size_t)row * D + col); a0 = bflo(t.x); a1 = bfhi(t.x); a2 = bflo(t.y); a3 = bfhi(t.y); }
        *(u32x2*)(O + (size_t)row * D + col) = (u32x2){pk2(a0 + sigmoidf_(bflo(gz.x)) * v[0], a1 + sigmoidf_(bfhi(gz.x)) * v[1]), pk2(a2 + sigmoidf_(bflo(gz.y)) * v[2], a3 + sigmoidf_(bfhi(gz.y)) * v[3])}; } };
struct SkRes  { float* H; const float* x; const float* meta; DI void operator()(int row, int col, f32x4 v) const { *(f32x4*)(H + (size_t)row * D + col) = *(const f32x4*)(resid_row(H, x, meta, row) + col) + v; } };
template <class Epi>
DI void skinny64(const bf16* A, int lda, const bf16* Bt, int ldb, int N, int K, int r0, LAS unsigned char* lds, const Epi& epi, int wave, int lane, int bid, int G) {
    const int n16 = lane & 15, q = lane >> 4; const int ksw = (K / 32) / 8;
    LAS f32x4* red = (LAS f32x4*)lds;
    for (int nt = bid; nt < N / 16; nt += G) {
        f32x4 acc[4];
#pragma unroll
        for (int mt = 0; mt < 4; ++mt) acc[mt] = (f32x4){0.f, 0.f, 0.f, 0.f};
        const bf16* wp = Bt + (size_t)(16 * nt + n16) * ldb + 8 * q + wave * ksw * 32; const bf16* ap = A + (size_t)(r0 + n16) * lda + 8 * q + wave * ksw * 32;
#pragma unroll 8
        for (int ks = 0; ks < ksw; ++ks) { const bf16x8 wf = *(const bf16x8*)(wp + ks * 32);
#pragma unroll
            for (int mt = 0; mt < 4; ++mt) acc[mt] = __builtin_amdgcn_mfma_f32_16x16x32_bf16(wf, *(const bf16x8*)(ap + (size_t)(16 * mt) * lda + ks * 32), acc[mt], 0, 0, 0); }
        __syncthreads();
#pragma unroll
        for (int mt = 0; mt < 4; ++mt) red[(wave * 4 + mt) * 64 + lane] = acc[mt];
        __syncthreads();
        if (wave < 4) { f32x4 s = red[wave * 64 + lane];
#pragma unroll
            for (int w = 1; w < 8; ++w) s = s + red[(w * 4 + wave) * 64 + lane];
            epi(r0 + 16 * wave + n16, 16 * nt + 4 * q, s); }
    }
    __syncthreads();
}

struct ArgsV { const float* in[33]; float* out; unsigned char* ws; int ph_lo, ph_hi; };
#define CAS __attribute__((address_space(4)))
typedef const CAS ArgsV* ArgsP;
struct Args { ArgsP p; GAS unsigned char* ws; GAS float* out; DI const float* inp(int i) const { return (const float*)(const GAS float*)p->in[i]; } };
enum InIdx { I_X = 0, I_META, I_NORM_MIX, I_W_IN, I_B_QKV, I_SINKS, I_MU, I_W0, I_DEC_UP, I_A0, I_ICLR_UP, I_GATE_UP, I_KK, I_KA, I_RK, I_LNW, I_LNB,
             I_VDOWN, I_VMU, I_V0, I_VUP, I_WBA, I_WBR, I_WOUT, I_NORM_FFN, I_WCOARSE, I_BCOARSE, I_WFINE, I_BFINE, I_WEG, I_WEU, I_WED, I_NORM_FINAL };

DI void tr_item(const float* W, int ldw, int K, int N, bf16* WT, int ldt, int kb, int nb, LAS float* scr, int lane) {
    (void)scr;
    const int k0 = 64 * kb + 8 * (lane >> 3), n0 = 32 * nb + 4 * (lane & 7);
    f32x4 v[8];
#pragma unroll
    for (int r = 0; r < 8; ++r) v[r] = (n0 < N && k0 + r < K) ? *(const f32x4*)(W + (size_t)(k0 + r) * ldw + n0) : (f32x4){0.f, 0.f, 0.f, 0.f};
    if (k0 < K && n0 < N) {
#pragma unroll
        for (int i = 0; i < 4; ++i) {
            u32x4 o; o.x = pk2(v[0][i], v[1][i]); o.y = pk2(v[2][i], v[3][i]); o.z = pk2(v[4][i], v[5][i]); o.w = pk2(v[6][i], v[7][i]);
            *(u32x4*)(WT + (size_t)(n0 + i) * ldt + k0) = o; } }
}

struct TrDesc { const float* W; bf16* WT; int ldw, K, N, ldt, kb, nb; };
DI void tr_load(const TrDesc& d, f32x4 (&v)[8], int lane) {
    const int k0 = 64 * d.kb + 8 * (lane >> 3), n0 = 32 * d.nb + 4 * (lane & 7);
#pragma unroll
    for (int r = 0; r < 8; ++r) v[r] = (n0 < d.N && k0 + r < d.K) ? *(const f32x4*)(d.W + (size_t)(k0 + r) * d.ldw + n0) : (f32x4){0.f, 0.f, 0.f, 0.f};
}
DI void tr_store(const TrDesc& d, const f32x4 (&v)[8], int lane) {
    const int k0 = 64 * d.kb + 8 * (lane >> 3), n0 = 32 * d.nb + 4 * (lane & 7);
    if (k0 < d.K && n0 < d.N) {
#pragma unroll
        for (int i = 0; i < 4; ++i) {
            u32x4 o; o.x = pk2(v[0][i], v[1][i]); o.y = pk2(v[2][i], v[3][i]); o.z = pk2(v[4][i], v[5][i]); o.w = pk2(v[6][i], v[7][i]);
            *(u32x4*)(d.WT + (size_t)(n0 + i) * d.ldt + k0) = o; } }
}
template <int GRP>
DI TrDesc tr_decode(const Args& a, int l, int r) {
    unsigned char* ws = (unsigned char*)a.ws;
    constexpr int NB_IN = NIN / 32;
    constexpr int J1 = 32 * NB_IN, J3 = 16 * 64, J5 = 32 * 64, J9 = 32 * 2, J10 = 32, J11 = 32, J2 = 32;
    if (GRP == 1) {
        if (r < J3) return TrDesc{a.inp(I_WBA) + (size_t)l * C * D, (bf16*)(ws + WS_WAT) + (size_t)l * D * C, D, C, D, C, r / 64, r % 64}; r -= J3;
        if (r < J3) return TrDesc{a.inp(I_WBR) + (size_t)l * C * D, (bf16*)(ws + WS_WRT) + (size_t)l * D * C, D, C, D, C, r / 64, r % 64}; r -= J3;
        if (r < J5) return TrDesc{a.inp(I_WOUT) + (size_t)l * D * D, (bf16*)(ws + WS_WOT) + (size_t)l * D * D, D, D, D, D, r / 64, r % 64}; r -= J5;
        if (r < J9) return TrDesc{a.inp(I_WFINE) + (size_t)l * D * 64, (bf16*)(ws + WS_WRO) + (size_t)l * 80 * D + (size_t)8 * D, 64, D, 64, D, r / 2, r % 2}; r -= J9;
        return TrDesc{a.inp(I_WCOARSE) + (size_t)l * D * 8, (bf16*)(ws + WS_WRO) + (size_t)l * 80 * D, 8, D, 8, D, r, 0};
    }
    if (r < J1) return TrDesc{a.inp(I_W_IN) + (size_t)l * D * NIN, (bf16*)(ws + WS_W1T) + (size_t)l * NZ * D, NIN, D, NIN, D, r / NB_IN, r % NB_IN}; r -= J1;
    if (r < J11) return TrDesc{a.inp(I_DEC_UP) + (size_t)l * 64 * C, (bf16*)(ws + WS_LDEC) + (size_t)l * C * 64, C, 64, C, 64, 0, r}; r -= J11;
    if (r < J11) return TrDesc{a.inp(I_ICLR_UP) + (size_t)l * 64 * C, (bf16*)(ws + WS_LICL) + (size_t)l * C * 64, C, 64, C, 64, 0, r}; r -= J11;
    if (r < J11 || GRP != 2) return TrDesc{a.inp(I_GATE_UP) + (size_t)l * 64 * C, (bf16*)(ws + WS_LGAT) + (size_t)l * C * 64, C, 64, C, 64, 0, r}; r -= J11;
    if (r < J2) return TrDesc{a.inp(I_VDOWN), (bf16*)(ws + WS_W1T) + (size_t)NZ * D + (size_t)ZVD * D, 32, D, 32, D, r, 0}; r -= J2;
    return TrDesc{a.inp(I_VUP), (bf16*)(ws + WS_LVUP), C, 32, C, 32, 0, r};
}
template <int GRP>
DI void phase_convert(const Args& a, int l, LAS unsigned char* lds, int gw, int NGW, int wave, int lane) {
    unsigned char* ws = (unsigned char*)a.ws; (void)lds; (void)wave;
    constexpr int NB_IN = NIN / 32;
    constexpr int NITEMS = (GRP == 1) ? 2 * 16 * 64 + 32 * 64 + 32 * 2 + 32 : 32 * NB_IN + 3 * 32 + (GRP == 2 ? 32 + 32 : 0);
    for (int it = gw; it < NITEMS; it += 2 * NGW) {
        const bool two = it + NGW < NITEMS;
        const TrDesc d0 = tr_decode<GRP>(a, l, it), d1 = tr_decode<GRP>(a, l, two ? it + NGW : it);
        f32x4 v0[8], v1[8];
        tr_load(d0, v0, lane); tr_load(d1, v1, lane);
        tr_store(d0, v0, lane); if (two) tr_store(d1, v1, lane);
    }
    if (GRP != 2) return;
    const size_t gt = (size_t)gw * 64 + lane, NGT = (size_t)NGW * 64;
    { unsigned* U = (unsigned*)(ws + WS_U);
      for (size_t i = gt; i < (size_t)(TP - T) * (D / 2); i += NGT) U[(size_t)T * (D / 2) + i] = 0u; }
    { float* bias = (float*)(ws + WS_BIAS);
      for (size_t i = gt; i < (size_t)2 * NZ; i += NGT) { const int l = (int)(i / NZ), c = (int)(i % NZ); bias[i] = (c < 1536) ? a.inp(I_B_QKV)[l * 1536 + c] : 0.f; } }
    { float* rope = (float*)(ws + WS_ROPE);
      for (size_t i = gt; i < (size_t)L * 8; i += NGT) { const int t = (int)(i / 8), k = (int)(i % 8);
          const float invf = (float)exp2(-(double)k * 0.125 * 18.931568569324174  );
          const float ang = (float)t * invf;
          const double rev = (double)ang * 0.15915494309189535; const float fr = (float)(rev - floor(rev));
          rope[i * 2 + 0] = __builtin_amdgcn_cosf(fr); rope[i * 2 + 1] = __builtin_amdgcn_sinf(fr); } }
    { unsigned* wro = (unsigned*)(ws + WS_WRO);
      for (size_t i = gt; i < (size_t)2 * 8 * (D / 2); i += NGT) { const int l = (int)(i / (8 * (D / 2))), rr = (int)(i % (8 * (D / 2))); wro[(size_t)l * 80 * (D / 2) + (size_t)72 * (D / 2) + rr] = 0u; } }
}

DI void moe_tables(const unsigned* cnt, LAS int* lc, int tid) {
    __syncthreads();
    if (tid < 64) {
        const int c = (int)__hip_atomic_load(cnt + tid * 16, RLX_AGENT); const int pad = (c + 15) & ~15; int inc = pad;
#pragma unroll
        for (int o = 1; o < 64; o <<= 1) { const int v = __shfl_up(inc, o); if (tid >= o) inc += v; }
        lc[LC_PSTART / 4 + tid] = inc - pad; lc[LC_CNT / 4 + tid] = c; }
    __syncthreads();
}
template <int MODE>
DI void phase_norm(const Args& a, const float* gain, bool comb, int lprev, LAS unsigned char* lds, int tid, int gw, int NGW, int lane, const float* x0 = nullptr, const float* meta0 = nullptr) {
    unsigned char* ws = (unsigned char*)a.ws; float* H = (float*)(ws + WS_H); bf16* U = (bf16*)(ws + WS_U);
    const bf16* YR = (const bf16*)(ws + WS_YR); const int* toke = (const int*)(ws + WS_TOKE); const int* toks = (const int*)(ws + WS_TOKS); const float* tokw = (const float*)(ws + WS_TOKW);
    LAS int* lc = (LAS int*)(lds + LDSCTL_OFF);
    if (comb) moe_tables((const unsigned*)(ws + WS_CTL) + CW_CNT + lprev * 64 * 16, lc, tid);
    f32x4 g[8];
#pragma unroll
    for (int j = 0; j < 8; ++j) g[j] = *(const f32x4*)(gain + lane * 4 + 256 * j);
    for (int m = gw; m < T; m += 2 * NGW) {
        const int mm[2] = {m, (m + NGW < T) ? m + NGW : m}; const bool two = m + NGW < T;
        f32x4 v[2][8];
#pragma unroll
        for (int rr = 0; rr < 2; ++rr)
#pragma unroll
            for (int j = 0; j < 8; ++j) v[rr][j] = *(const f32x4*)(resid_row(H, x0, meta0, mm[rr]) + lane * 4 + 256 * j);
        if (comb) {
            int p[2][2]; float w[2][2];
#pragma unroll
            for (int rr = 0; rr < 2; ++rr)
#pragma unroll
                for (int k = 0; k < 2; ++k) { p[rr][k] = lc[LC_PSTART / 4 + toke[2 * mm[rr] + k]] + toks[2 * mm[rr] + k]; w[rr][k] = tokw[2 * mm[rr] + k]; }
            u32x2 y[2][2][8];
#pragma unroll
            for (int rr = 0; rr < 2; ++rr)
#pragma unroll
                for (int k = 0; k < 2; ++k)
#pragma unroll
                    for (int j = 0; j < 8; ++j) y[rr][k][j] = *(const u32x2*)(YR + (size_t)p[rr][k] * D + lane * 4 + 256 * j);
#pragma unroll
            for (int rr = 0; rr < 2; ++rr)
#pragma unroll
                for (int j = 0; j < 8; ++j) { const u32x2 a0 = y[rr][0][j], a1 = y[rr][1][j]; const float w0 = w[rr][0], w1 = w[rr][1];
                    v[rr][j][0] += w0 * bflo(a0.x) + w1 * bflo(a1.x); v[rr][j][1] += w0 * bfhi(a0.x) + w1 * bfhi(a1.x);
                    v[rr][j][2] += w0 * bflo(a0.y) + w1 * bflo(a1.y); v[rr][j][3] += w0 * bfhi(a0.y) + w1 * bfhi(a1.y);
                    if (MODE == 0 && (rr == 0 || two)) *(f32x4*)(H + (size_t)mm[rr] * D + lane * 4 + 256 * j) = v[rr][j]; }
        }
#pragma unroll
        for (int rr = 0; rr < 2; ++rr) {
            if (rr == 1 && !two) break;
            float ss = 0.f;
#pragma unroll
            for (int j = 0; j < 8; ++j) ss += (v[rr][j][0] * v[rr][j][0] + v[rr][j][1] * v[rr][j][1]) + (v[rr][j][2] * v[rr][j][2] + v[rr][j][3] * v[rr][j][3]);
            float rstd = rsqrtf(wave_sum(ss) * (1.f / D) + NORM_EPS);
#if defined(CHUNK_TEST)
            if (MODE == 1 && ((const unsigned*)(ws + WS_CTL))[40000] != 0u) rstd = __builtin_nanf("");
#endif
            if (MODE == 0) {
                bf16* ur = U + (size_t)mm[rr] * D + lane * 4;
#pragma unroll
                for (int j = 0; j < 8; ++j) { const f32x4 o = v[rr][j] * rstd * g[j]; u32x2 wv; wv.x = pk2(o[0], o[1]); wv.y = pk2(o[2], o[3]); *(u32x2*)(ur + 256 * j) = wv; }
            } else {
                const int b = mm[rr] / L, t = mm[rr] % L;
                if (t >= NMETA) { float* orow = (float*)a.out + ((size_t)b * SEQ + (t - NMETA)) * D + lane * 4;
#pragma unroll
                    for (int j = 0; j < 8; ++j) *(f32x4*)(orow + 256 * j) = v[rr][j] * rstd * g[j]; }
            }
        }
    }
}

DI void phase_rope(const Args& a, int gw, int NGW, int lane) {
    unsigned char* ws = (unsigned char*)a.ws; bf16* Z = (bf16*)(ws + WS_Z); const float* rope = (const float*)(ws + WS_ROPE);
    const int r = lane / 20, hs = lane % 20; const int cb = (hs < 16) ? ZQ + hs * 64 : ZK + (hs - 16) * 64;
    for (int m0 = 3 * gw; m0 < T; m0 += 3 * NGW) { const int m = m0 + r;
        if (lane < 60 && m < T) { const int t = m % L; bf16* zp = Z + (size_t)m * NZ + cb;
            const u32x4 a1 = *(const u32x4*)zp, a2 = *(const u32x4*)(zp + 8);
            const f32x4* rt = (const f32x4*)(rope + (size_t)t * 16);
            unsigned o1[4], o2[4];
#pragma unroll
            for (int w = 0; w < 4; ++w) { const f32x4 cs = rt[w];
                const unsigned w1 = (w == 0) ? a1.x : (w == 1) ? a1.y : (w == 2) ? a1.z : a1.w, w2 = (w == 0) ? a2.x : (w == 1) ? a2.y : (w == 2) ? a2.z : a2.w;
                const float x1a = bflo(w1), x1b = bfhi(w1), x2a = bflo(w2), x2b = bfhi(w2);
                o1[w] = pk2(x1a * cs[0] - x2a * cs[1], x1b * cs[2] - x2b * cs[3]); o2[w] = pk2(x2a * cs[0] + x1a * cs[1], x2b * cs[2] + x1b * cs[3]); }
            *(u32x4*)zp = (u32x4){o1[0], o1[1], o1[2], o1[3]}; *(u32x4*)(zp + 8) = (u32x4){o2[0], o2[1], o2[2], o2[3]}; } }
}
DI void phase_vt(const Args& a, int gw, int NGW, int lane) {
    unsigned char* ws = (unsigned char*)a.ws; const bf16* Z = (const bf16*)(ws + WS_Z); bf16* VT = (bf16*)(ws + WS_VT);
    const int tgl = lane >> 3, cgl = lane & 7; constexpr int NTG = (LPAD + 63) / 64;
    for (int u = gw; u < NB * NTG * 4; u += NGW) { const int kvh = u & 3, tg8 = (u >> 2) % NTG, b = (u >> 2) / NTG; const int t0 = 64 * tg8 + 8 * tgl;
        u32x4 x[8];
#pragma unroll
        for (int j = 0; j < 8; ++j) { const int t = t0 + j; x[j] = (t < L) ? *(const u32x4*)(Z + (size_t)(b * L + t) * NZ + ZV + kvh * 64 + 8 * cgl) : (u32x4){0u, 0u, 0u, 0u}; }
        if (t0 < LPAD) {
#pragma unroll
            for (int ch = 0; ch < 8; ++ch) { unsigned o[4];
#pragma unroll
                for (int w = 0; w < 4; ++w) { const unsigned lo = (ch >> 1) == 0 ? x[2 * w].x : (ch >> 1) == 1 ? x[2 * w].y : (ch >> 1) == 2 ? x[2 * w].z : x[2 * w].w;
                    const unsigned hi = (ch >> 1) == 0 ? x[2 * w + 1].x : (ch >> 1) == 1 ? x[2 * w + 1].y : (ch >> 1) == 2 ? x[2 * w + 1].z : x[2 * w + 1].w;
                    o[w] = (ch & 1) ? ((lo >> 16) | (hi & 0xffff0000u)) : ((lo & 0xffffu) | (hi << 16)); }
                *(u32x4*)(VT + ((size_t)(b * 4 + kvh) * HD + 8 * cgl + ch) * LPAD + t0) = (u32x4){o[0], o[1], o[2], o[3]}; } }
    }
}
template <int MODE> DI bf16x8 lora_in8(const u32x4 c, const u32x4 p, const f32x4 m0, const f32x4 m1) {
    float o[8];
#pragma unroll
    for (int j = 0; j < 8; ++j) { const unsigned cw = (j < 2) ? c.x : (j < 4) ? c.y : (j < 6) ? c.z : c.w, pw = (j < 2) ? p.x : (j < 4) ? p.y : (j < 6) ? p.z : p.w;
        const float cv = (j & 1) ? bfhi(cw) : bflo(cw), pv = (j & 1) ? bfhi(pw) : bflo(pw); const float mm = (j < 4) ? m0[j & 3] : m1[j & 3];
        const float zs = cv + (pv - cv) * mm;
        if (MODE == 0) { const float e = __expf(2.f * zs); o[j] = 1.f - 2.f / (e + 1.f); } else if (MODE == 1) o[j] = zs; else o[j] = sigmoidf_(zs); }
    u32x4 w; w.x = pk2(o[0], o[1]); w.y = pk2(o[2], o[3]); w.z = pk2(o[4], o[5]); w.w = pk2(o[6], o[7]);
    return __builtin_bit_cast(bf16x8, w);
}
DI void phase_rwkvprep(const Args& a, int l, LAS unsigned char* lds, int tid, int gw, int NGW, int lane) {
    unsigned char* ws = (unsigned char*)a.ws; const bf16* Z = (const bf16*)(ws + WS_Z);
    const float* mu = a.inp(I_MU) + (size_t)l * 3264; const float* vmu = a.inp(I_VMU);
    const bf16* WdT = (const bf16*)(ws + WS_LDEC) + (size_t)l * C * 64; const bf16* WiT = (const bf16*)(ws + WS_LICL) + (size_t)l * C * 64; const bf16* WgT = (const bf16*)(ws + WS_LGAT) + (size_t)l * C * 64;
    const bf16* WvT = (const bf16*)(ws + WS_LVUP);
    bf16* Rr = (bf16*)(ws + WS_R); float* Ww = (float*)(ws + WS_W); bf16* Kk = (bf16*)(ws + WS_K); bf16* Vv = (bf16*)(ws + WS_V); bf16* KKn = (bf16*)(ws + WS_KK); bf16* Bb = (bf16*)(ws + WS_B);
    bf16* VF = (bf16*)(ws + WS_VF); bf16* Gg = (bf16*)(ws + WS_G); float* RK = (float*)(ws + WS_RK);
    LAS float* par = (LAS float*)lds;
    __syncthreads();
    for (int i = tid; i < 9 * C; i += NTHR) { const int wch = i / C, ch = i % C; float v;
        if (wch < 3) v = mu[wch * C + ch]; else if (wch == 3) v = a.inp(I_W0)[(size_t)l * C + ch]; else if (wch == 4) v = a.inp(I_A0)[(size_t)l * C + ch]; else if (wch == 5) v = a.inp(I_KK)[(size_t)l * C + ch];
        else if (wch == 6) v = a.inp(I_KA)[(size_t)l * C + ch]; else if (wch == 7) v = a.inp(I_RK)[(size_t)l * C + ch]; else v = (l > 0) ? a.inp(I_V0)[ch] : 0.f;
        par[i] = v; }
    __syncthreads();
    const int tk = lane & 15, q = lane >> 4;
    for (int u = gw; u < (T / 16) * NH; u += NGW) {
        const int hd = u & 15, tile = u >> 4; const int b = tile / (L / 16), t0 = (tile % (L / 16)) * 16; const int row = b * L + t0 + tk, t = t0 + tk;
        const bf16* zrow = Z + (size_t)row * NZ; const bf16* prow = zrow - NZ; const bool hp = t > 0;
        const bf16* zc = zrow + ZR0; const bf16* zp = prow + ZR0;
        struct CtIn { bf16x8 wd[2], wi[2], wg[2], wv; u32x2 zr, zk, zv, pr, pk, pv, vf; };
#define RP_LOAD(dst, ct) do { const int chA_ = hd * 64 + (ct) * 16 + (lane & 15), c0_ = hd * 64 + (ct) * 16 + 4 * q; \
            _Pragma("unroll") for (int ks = 0; ks < 2; ++ks) { dst.wd[ks] = *(const bf16x8*)(WdT + (size_t)chA_ * 64 + ks * 32 + 8 * q); dst.wi[ks] = *(const bf16x8*)(WiT + (size_t)chA_ * 64 + ks * 32 + 8 * q); dst.wg[ks] = *(const bf16x8*)(WgT + (size_t)chA_ * 64 + ks * 32 + 8 * q); } \
            dst.wv = (l > 0) ? *(const bf16x8*)(WvT + (size_t)chA_ * 32 + 8 * q) : (bf16x8){0, 0, 0, 0, 0, 0, 0, 0}; \
            dst.zr = *(const u32x2*)(zc + c0_); dst.zk = *(const u32x2*)(zc + 1024 + c0_); dst.zv = *(const u32x2*)(zc + 2048 + c0_); \
            dst.pr = (u32x2){0u, 0u}; dst.pk = dst.pr; dst.pv = dst.pr; if (hp) { dst.pr = *(const u32x2*)(zp + c0_); dst.pk = *(const u32x2*)(zp + 1024 + c0_); dst.pv = *(const u32x2*)(zp + 2048 + c0_); } \
            dst.vf = (l > 0) ? *(const u32x2*)(VF + (size_t)row * C + c0_) : (u32x2){0u, 0u}; } while (0)
        CtIn in[2];
        RP_LOAD(in[0], 0);
        bf16x8 bw[2], ba[2], bg[2], bs = {0, 0, 0, 0, 0, 0, 0, 0};
#pragma unroll
        for (int ks = 0; ks < 2; ++ks) { const int ko = ks * 32 + 8 * q; const u32x4 z4 = {0u, 0u, 0u, 0u};
            const u32x4 cw = *(const u32x4*)(zrow + ZR0 + 3072 + ko), ca = *(const u32x4*)(zrow + ZR0 + 3136 + ko), cg = *(const u32x4*)(zrow + ZR0 + 3200 + ko);
            const u32x4 pw = hp ? *(const u32x4*)(prow + ZR0 + 3072 + ko) : z4, pa = hp ? *(const u32x4*)(prow + ZR0 + 3136 + ko) : z4, pg = hp ? *(const u32x4*)(prow + ZR0 + 3200 + ko) : z4;
            bw[ks] = lora_in8<0>(cw, pw, *(const f32x4*)(mu + 3072 + ko), *(const f32x4*)(mu + 3072 + ko + 4));
            ba[ks] = lora_in8<1>(ca, pa, *(const f32x4*)(mu + 3136 + ko), *(const f32x4*)(mu + 3136 + ko + 4));
            bg[ks] = lora_in8<2>(cg, pg, *(const f32x4*)(mu + 3200 + ko), *(const f32x4*)(mu + 3200 + ko + 4)); }
        if (l > 0) { const u32x4 z4 = {0u, 0u, 0u, 0u}; const u32x4 cs = *(const u32x4*)(zrow + ZVD + 8 * q); const u32x4 ps = hp ? *(const u32x4*)(prow + ZVD + 8 * q) : z4;
            bs = lora_in8<1>(cs, ps, *(const f32x4*)(vmu + 8 * q), *(const f32x4*)(vmu + 8 * q + 4)); }
        float kkv[4][4], av[4][4]; float ss = 0.f, rks = 0.f;
#pragma unroll
        for (int ct = 0; ct < 4; ++ct) { const int ch0 = hd * 64 + ct * 16;
            if (ct + 1 < 4) RP_LOAD(in[(ct + 1) & 1], ct + 1);
            __builtin_amdgcn_sched_barrier(0);
            const CtIn& I = in[ct & 1];
            f32x4 aw = {0.f, 0.f, 0.f, 0.f}, aa = aw, ag = aw, avr = aw;
#pragma unroll
            for (int ks = 0; ks < 2; ++ks) {
                aw = __builtin_amdgcn_mfma_f32_16x16x32_bf16(I.wd[ks], bw[ks], aw, 0, 0, 0);
                aa = __builtin_amdgcn_mfma_f32_16x16x32_bf16(I.wi[ks], ba[ks], aa, 0, 0, 0);
                ag = __builtin_amdgcn_mfma_f32_16x16x32_bf16(I.wg[ks], bg[ks], ag, 0, 0, 0); }
            if (l > 0) avr = __builtin_amdgcn_mfma_f32_16x16x32_bf16(I.wv, bs, avr, 0, 0, 0);
            const int c0 = ch0 + 4 * q;
            const u32x2 zr_ = I.zr, zk_ = I.zk, zv_ = I.zv, pr_ = I.pr, pk_ = I.pk, pv_ = I.pv, vfw = I.vf;
            const f32x4 mr = *(const LAS f32x4*)(par + c0), mk = *(const LAS f32x4*)(par + C + c0), mv = *(const LAS f32x4*)(par + 2 * C + c0);
            const f32x4 w0v = *(const LAS f32x4*)(par + 3 * C + c0), a0v = *(const LAS f32x4*)(par + 4 * C + c0), kkw = *(const LAS f32x4*)(par + 5 * C + c0), kaw = *(const LAS f32x4*)(par + 6 * C + c0), rkw = *(const LAS f32x4*)(par + 7 * C + c0);
            const f32x4 v0v = *(const LAS f32x4*)(par + 8 * C + c0);
            f32x4 ro, wo, ko, vo, go;
#pragma unroll
            for (int j = 0; j < 4; ++j) {
                const float rc = (j & 1) ? bfhi(j < 2 ? zr_.x : zr_.y) : bflo(j < 2 ? zr_.x : zr_.y), rp = (j & 1) ? bfhi(j < 2 ? pr_.x : pr_.y) : bflo(j < 2 ? pr_.x : pr_.y);
                const float kc = (j & 1) ? bfhi(j < 2 ? zk_.x : zk_.y) : bflo(j < 2 ? zk_.x : zk_.y), kp = (j & 1) ? bfhi(j < 2 ? pk_.x : pk_.y) : bflo(j < 2 ? pk_.x : pk_.y);
                const float vc = (j & 1) ? bfhi(j < 2 ? zv_.x : zv_.y) : bflo(j < 2 ? zv_.x : zv_.y), vp = (j & 1) ? bfhi(j < 2 ? pv_.x : pv_.y) : bflo(j < 2 ? pv_.x : pv_.y);
                const float vfj = (j & 1) ? bfhi(j < 2 ? vfw.x : vfw.y) : bflo(j < 2 ? vfw.x : vfw.y);
                const float r = rc + (rp - rc) * mr[j]; float k = kc + (kp - kc) * mk[j]; float v = vc + (vp - vc) * mv[j];
                const float xw = -(w0v[j] + aw[j]);
                const float sp = fmaxf(xw, 0.f) + __logf(1.f + __expf(-fabsf(xw)));
                const float wlog = -sp - 0.5f; const float dec = __expf(-__expf(wlog));
                const float aval = sigmoidf_(a0v[j] + aa[j]);
                if (l > 0) v = v + (vfj - v) * sigmoidf_(v0v[j] + avr[j]);
                const float kk = k * kkw[j]; ss += kk * kk;
                k = k * (1.f + (aval - 1.f) * kaw[j]);
                rks += r * k * rkw[j];
                kkv[ct][j] = kk; av[ct][j] = aval;
                ro[j] = r; wo[j] = dec; ko[j] = k; vo[j] = v; go[j] = ag[j]; }
            const size_t o = (size_t)row * C + c0;
            *(u32x2*)(Rr + o) = (u32x2){pk2(ro[0], ro[1]), pk2(ro[2], ro[3])}; *(f32x4*)(Ww + o) = wo; *(u32x2*)(Kk + o) = (u32x2){pk2(ko[0], ko[1]), pk2(ko[2], ko[3])};
            const u32x2 vpk = {pk2(vo[0], vo[1]), pk2(vo[2], vo[3])}; *(u32x2*)(Vv + o) = vpk; *(u32x2*)(Gg + o) = (u32x2){pk2(go[0], go[1]), pk2(go[2], go[3])};
            if (l == 0) *(u32x2*)(VF + o) = vpk; }
#undef RP_LOAD
        ss += __shfl_xor(ss, 16); ss += __shfl_xor(ss, 32); rks += __shfl_xor(rks, 16); rks += __shfl_xor(rks, 32);
        const float inv = 1.f / fmaxf(sqrtf(ss), 1e-12f);
#pragma unroll
        for (int ct = 0; ct < 4; ++ct) { const size_t o = (size_t)row * C + hd * 64 + ct * 16 + 4 * q;
            float kn[4], bo[4];
#pragma unroll
            for (int j = 0; j < 4; ++j) { kn[j] = kkv[ct][j] * inv; bo[j] = kn[j] * av[ct][j]; }
            *(u32x2*)(KKn + o) = (u32x2){pk2(kn[0], kn[1]), pk2(kn[2], kn[3])}; *(u32x2*)(Bb + o) = (u32x2){pk2(bo[0], bo[1]), pk2(bo[2], bo[3])}; }
        if (q == 0) RK[(size_t)row * NH + hd] = rks;
    }
}

DI void phase_attn(const Args& a, int l, int gw, int NGW, int lane) {
    unsigned char* ws = (unsigned char*)a.ws; const bf16* Z = (const bf16*)(ws + WS_Z); const bf16* VT = (const bf16*)(ws + WS_VT); bf16* O = (bf16*)(ws + WS_OATT);
    const float* sinks = a.inp(I_SINKS) + l * NH;
    constexpr int NMAIN = NB * NH * (SEQ / 32), NUNITS = NMAIN + NB * NH;
    const int c = lane & 31, h = lane >> 5;
    const int kperm = (c & ~12) | ((c & 8) >> 1) | ((c & 4) << 1);
    constexpr float SCL = 0.125f * 1.44269504088896f;
    for (int u = gw; u < NUNITS; u += NGW) {
        const bool metaq = u >= NMAIN; const int uu = metaq ? u - NMAIN : u;
        const int hq4 = uu & 3, rest = uu >> 2; const int qb = metaq ? -8 : (rest & 63), bk = metaq ? rest : (rest >> 6); const int kvh = bk & 3, b = bk >> 2; const int hq = kvh * 4 + hq4;
        const int qpos = metaq ? c : NMETA + 32 * qb + c;
        const bf16* zb = Z + (size_t)(b * L) * NZ; const bf16* vb = VT + ((size_t)(b * 4 + kvh) * HD + c) * LPAD + 8 * h;
#define AT_KBASE(s) (((s) == 0) ? 0 : NMETA + 32 * (qb - 5 + (s)))
#define AT_VALID(s) (((s) == 0) || (qb - 5 + (s) >= 0))
#define AT_KLOAD(dst, s) do { if (AT_VALID(s)) { const bf16* kp_ = zb + (size_t)(AT_KBASE(s) + kperm) * NZ + ZK + kvh * 64 + 8 * h; _Pragma("unroll") for (int ks = 0; ks < 4; ++ks) dst[ks] = *(const bf16x8*)(kp_ + 16 * ks); } } while (0)
#define AT_VLOAD(dst, s) do { if (AT_VALID(s)) { const bf16* vp_ = vb + AT_KBASE(s); dst[0] = *(const bf16x8*)(vp_); dst[1] = *(const bf16x8*)(vp_ + 16); dst[2] = *(const bf16x8*)(vp_ + (size_t)32 * LPAD); dst[3] = *(const bf16x8*)(vp_ + (size_t)32 * LPAD + 16); } } while (0)
        bf16x8 qf[4], fr[2][4];
#pragma unroll
        for (int ks = 0; ks < 4; ++ks) qf[ks] = *(const bf16x8*)(zb + (size_t)qpos * NZ + ZQ + hq * 64 + 16 * ks + 8 * h);
        AT_KLOAD(fr[0], 0);
        f32x16 sc[6];
        float mx = sinks[hq] * 1.44269504088896f;
#pragma unroll
        for (int s = 0; s < 6; ++s) {
            const bool valid = AT_VALID(s); const int kbase = AT_KBASE(s);
            if (s + 1 < 6) AT_KLOAD(fr[(s + 1) & 1], s + 1);
            __builtin_amdgcn_sched_barrier(0);
#pragma unroll
            for (int i = 0; i < 16; ++i) sc[s][i] = 0.f;
            if (valid) {
#pragma unroll
                for (int ks = 0; ks < 4; ++ks) sc[s] = __builtin_amdgcn_mfma_f32_32x32x16_bf16(fr[s & 1][ks], qf[ks], sc[s], 0, 0, 0);
            }
#pragma unroll
            for (int i = 0; i < 16; ++i) { const int kpos = kbase + 16 * (i >> 3) + 8 * h + 4 * ((i >> 2) & 1) + (i & 3);
                const int dist = qpos - kpos;
                const bool vis = valid && ((s == 0) ? (kpos < NMETA && kpos <= qpos) : (s >= 2 && s <= 4) ? true : (dist >= 0 && dist < 128));
                sc[s][i] = vis ? sc[s][i] * SCL : -1e30f; mx = fmaxf(mx, sc[s][i]); }
        }
        AT_VLOAD(fr[0], 0);
        mx = fmaxf(mx, __shfl_xor(mx, 32));
        float sum = 0.f;
#pragma unroll
        for (int s = 0; s < 6; ++s)
#pragma unroll
            for (int i = 0; i < 16; ++i) { const float p = __builtin_amdgcn_exp2f(sc[s][i] - mx); sc[s][i] = p; sum += p; }
        sum += __shfl_xor(sum, 32);
        sum += __builtin_amdgcn_exp2f(sinks[hq] * 1.44269504088896f - mx);
        f32x16 o0, o1;
#pragma unroll
        for (int i = 0; i < 16; ++i) { o0[i] = 0.f; o1[i] = 0.f; }
#pragma unroll
        for (int s = 0; s < 6; ++s) {
            const bool valid = AT_VALID(s);
            if (s + 1 < 6) AT_VLOAD(fr[(s + 1) & 1], s + 1);
            __builtin_amdgcn_sched_barrier(0);
            if (valid) {
#pragma unroll
                for (int s2 = 0; s2 < 2; ++s2) {
                    u32x4 pw; pw.x = pk2(sc[s][8 * s2 + 0], sc[s][8 * s2 + 1]); pw.y = pk2(sc[s][8 * s2 + 2], sc[s][8 * s2 + 3]); pw.z = pk2(sc[s][8 * s2 + 4], sc[s][8 * s2 + 5]); pw.w = pk2(sc[s][8 * s2 + 6], sc[s][8 * s2 + 7]);
                    const bf16x8 pf = __builtin_bit_cast(bf16x8, pw);
                    o0 = __builtin_amdgcn_mfma_f32_32x32x16_bf16(fr[s & 1][s2], pf, o0, 0, 0, 0);
                    o1 = __builtin_amdgcn_mfma_f32_32x32x16_bf16(fr[s & 1][2 + s2], pf, o1, 0, 0, 0); }
            }
        }
#undef AT_KBASE
#undef AT_VALID
#undef AT_KLOAD
#undef AT_VLOAD
        if (!metaq || c < NMETA) { const float inv = 1.f / sum; bf16* orow = O + (size_t)(b * L + qpos) * C + hq * 64 + 4 * h;
#pragma unroll
            for (int g4 = 0; g4 < 4; ++g4) { u32x2 w0, w1;
                w0.x = pk2(o0[4 * g4] * inv, o0[4 * g4 + 1] * inv); w0.y = pk2(o0[4 * g4 + 2] * inv, o0[4 * g4 + 3] * inv);
                w1.x = pk2(o1[4 * g4] * inv, o1[4 * g4 + 1] * inv); w1.y = pk2(o1[4 * g4 + 2] * inv, o1[4 * g4 + 3] * inv);
                *(u32x2*)(orow + 8 * g4) = w0; *(u32x2*)(orow + 32 + 8 * g4) = w1; } }
    }
}

constexpr int CK = 64, NCK = (L + CK - 1) / CK  , NCHUNK = NB * NH * NCK  ;
constexpr size_t CH_P = WS_XR, CH_Q = CH_P + (size_t)NCHUNK * 4096 * 2, CH_RH = CH_Q + (size_t)NCHUNK * 4096 * 4, CH_YL = CH_RH + (size_t)NCHUNK * 4096 * 2, CH_ZS = CH_YL + (size_t)NCHUNK * 4096 * 4;
static_assert(CH_ZS + (size_t)NCHUNK * 4096 * 2 <= WS_HID, "chunk buffers fit the free XR region");
constexpr int CP = 72, CMS = 64 * CP * 2;
struct CkF { bf16x8 a[2], b[2][2]; };
DI void ck_ld(CkF& f, const LAS bf16* A, const LAS bf16* Bt, int wave, int lane) {
    const int mt = wave >> 1, nt0 = 2 * (wave & 1), r = lane & 15, q = lane >> 4;
#pragma unroll
    for (int ks = 0; ks < 2; ++ks) { f.a[ks] = *(const LAS bf16x8*)(A + (16 * mt + r) * CP + 32 * ks + 8 * q);
#pragma unroll
        for (int j = 0; j < 2; ++j) f.b[j][ks] = *(const LAS bf16x8*)(Bt + (16 * (nt0 + j) + r) * CP + 32 * ks + 8 * q); }
}
DI void ck_mma(f32x4 (&acc)[2], const CkF& f) {
#pragma unroll
    for (int ks = 0; ks < 2; ++ks)
#pragma unroll
        for (int j = 0; j < 2; ++j) acc[j] = __builtin_amdgcn_mfma_f32_16x16x32_bf16(f.a[ks], f.b[j][ks], acc[j], 0, 0, 0);
}
template <class F> DI void ck_epi(const f32x4 (&acc)[2], int wave, int lane, const F& epi) {
    const int mt = wave >> 1, nt0 = 2 * (wave & 1), r = lane & 15, q = lane >> 4;
#pragma unroll
    for (int j = 0; j < 2; ++j) epi(16 * mt + 4 * q, 16 * (nt0 + j) + r, acc[j]);
}
template <class F>
DI void ck_mm(const LAS bf16* A, const LAS bf16* Bt, const LAS bf16* A2, const LAS bf16* Bt2, int wave, int lane, const F& epi) {
    CkF f; ck_ld(f, A, Bt, wave, lane); f32x4 acc[2] = {{0.f, 0.f, 0.f, 0.f}, {0.f, 0.f, 0.f, 0.f}}; ck_mma(acc, f);
    if (A2) { CkF g; ck_ld(g, A2, Bt2, wave, lane); ck_mma(acc, g); }
    ck_epi(acc, wave, lane, epi);
}
#define CK_Z2 {{0.f, 0.f, 0.f, 0.f}, {0.f, 0.f, 0.f, 0.f}}
DI void ck_wr_row(LAS bf16* X, int m, int n, f32x4 v) {
#pragma unroll
    for (int g = 0; g < 4; ++g) X[(m + g) * CP + n] = (bf16)(pk2(v[g], 0.f) & 0xffffu);
}
DI void ck_wr_tr(LAS bf16* XT, int m, int n, f32x4 v) { *(LAS u32x2*)(XT + n * CP + m) = (u32x2){pk2(v[0], v[1]), pk2(v[2], v[3])}; }

DI void phase_chunkA(const Args& a, LAS unsigned char* lds, int wave, int lane, int tid, int bid, int G) {
    unsigned char* ws = (unsigned char*)a.ws;
    const float* Ww = (const float*)(ws + WS_W); const bf16* KKn = (const bf16*)(ws + WS_KK); const bf16* Bb = (const bf16*)(ws + WS_B);
    const bf16* Kk = (const bf16*)(ws + WS_K); const bf16* Rr = (const bf16*)(ws + WS_R); const bf16* Vv = (const bf16*)(ws + WS_V);
#define SL(i) ((LAS bf16*)(lds + (i) * CMS))
#define CK_BAR() do { asm volatile("s_waitcnt lgkmcnt(0)" ::: "memory"); __builtin_amdgcn_s_barrier(); asm volatile("" ::: "memory"); } while (0)
    LAS float* Gf = (LAS float*)(lds + 8 * CMS);
    LAS float* gC = (LAS float*)(lds + 14 * CMS);
    f32x4 nw0, nw1; u32x4 nr8, nk8, nv8, nkk8, nb8;
#define CK_LOADIN(cc, hh, bb) do { const int t_ = tid >> 3, c8_ = (tid & 7) * 8; const bool ok_ = CK * (cc) + t_ < L; const size_t ro_ = (size_t)((bb) * L + CK * (cc) + t_) * C + (hh) * 64 + c8_; \
        const f32x4 one_ = {1.f, 1.f, 1.f, 1.f}; const u32x4 z_ = {0u, 0u, 0u, 0u}; \
        nw0 = ok_ ? *(const f32x4*)(Ww + ro_) : one_; nw1 = ok_ ? *(const f32x4*)(Ww + ro_ + 4) : one_; \
        nr8 = ok_ ? *(const u32x4*)(Rr + ro_) : z_; nk8 = ok_ ? *(const u32x4*)(Kk + ro_) : z_; nv8 = ok_ ? *(const u32x4*)(Vv + ro_) : z_; nkk8 = ok_ ? *(const u32x4*)(KKn + ro_) : z_; nb8 = ok_ ? *(const u32x4*)(Bb + ro_) : z_; } while (0)
    if (bid < NCHUNK) { const int c0_ = bid % NCK, bh0_ = bid / NCK; CK_LOADIN(c0_, bh0_ & 15, bh0_ >> 4); }
    for (int cid = bid; cid < NCHUNK; cid += G) {
        const int c = cid % NCK, bh = cid / NCK, hd = bh & 15, b = bh >> 4; const int tok0 = CK * c; (void)tok0; (void)hd; (void)b;
        CK_BAR();
        const int t = tid >> 3, c8 = (tid & 7) * 8;
        float wv[8], gv[8], gp[8];
#pragma unroll
        for (int e = 0; e < 4; ++e) { wv[e] = nw0[e]; wv[4 + e] = nw1[e]; }
        const u32x4 r8 = nr8, k8 = nk8, v8 = nv8, kk8 = nkk8, b8 = nb8;
        { const int cid2 = cid + G; if (cid2 < NCHUNK) { const int c2 = cid2 % NCK, bh2 = cid2 / NCK; CK_LOADIN(c2, bh2 & 15, bh2 >> 4); } }
        { const int tl = lane >> 3;
#pragma unroll
          for (int e = 0; e < 8; ++e) { float x = wv[e];
              float y = __shfl_up(x, 8); if (tl >= 1) x *= y;
              y = __shfl_up(x, 16); if (tl >= 2) x *= y;
              y = __shfl_up(x, 32); if (tl >= 4) x *= y;
              gv[e] = x; }
          if (tl == 7) {
#pragma unroll
              for (int e = 0; e < 8; ++e) Gf[wave * 64 + c8 + e] = gv[e]; } }
        CK_BAR();
        {
#pragma unroll 1
          for (int w2 = 0; w2 < wave; ++w2) {
#pragma unroll
              for (int e = 0; e < 8; ++e) gv[e] *= Gf[w2 * 64 + c8 + e]; }
#pragma unroll
          for (int e = 0; e < 8; ++e) gp[e] = gv[e] / wv[e];
          if (t == CK - 1) {
#pragma unroll
              for (int e = 0; e < 8; ++e) gC[c8 + e] = gv[e]; } }
        {
          float rt[8], at[8], kt[8], bt[8], vv[8];
#pragma unroll
          for (int e = 0; e < 8; ++e) { const unsigned rw = (e < 2) ? r8.x : (e < 4) ? r8.y : (e < 6) ? r8.z : r8.w, kw = (e < 2) ? k8.x : (e < 4) ? k8.y : (e < 6) ? k8.z : k8.w, vw = (e < 2) ? v8.x : (e < 4) ? v8.y : (e < 6) ? v8.z : v8.w,
                  qw = (e < 2) ? kk8.x : (e < 4) ? kk8.y : (e < 6) ? kk8.z : kk8.w, bw = (e < 2) ? b8.x : (e < 4) ? b8.y : (e < 6) ? b8.z : b8.w;
              const float rv = (e & 1) ? bfhi(rw) : bflo(rw), kv = (e & 1) ? bfhi(kw) : bflo(kw), vx = (e & 1) ? bfhi(vw) : bflo(vw), qv = (e & 1) ? bfhi(qw) : bflo(qw), bv = (e & 1) ? bfhi(bw) : bflo(bw);
              const float ig = 1.f / gv[e];
              rt[e] = rv * gv[e]; at[e] = -qv * gp[e]; kt[e] = kv * ig; bt[e] = bv * ig; vv[e] = vx; }
          *(LAS u32x4*)(SL(6) + t * CP + c8) = (u32x4){pk2(rt[0], rt[1]), pk2(rt[2], rt[3]), pk2(rt[4], rt[5]), pk2(rt[6], rt[7])};
          *(LAS u32x4*)(SL(0) + t * CP + c8) = (u32x4){pk2(at[0], at[1]), pk2(at[2], at[3]), pk2(at[4], at[5]), pk2(at[6], at[7])};
          *(LAS u32x4*)(SL(4) + t * CP + c8) = (u32x4){pk2(kt[0], kt[1]), pk2(kt[2], kt[3]), pk2(kt[4], kt[5]), pk2(kt[6], kt[7])};
          *(LAS u32x4*)(SL(2) + t * CP + c8) = (u32x4){pk2(bt[0], bt[1]), pk2(bt[2], bt[3]), pk2(bt[4], bt[5]), pk2(bt[6], bt[7])};
          *(LAS u32x4*)(SL(10) + t * CP + c8) = (u32x4){pk2(vv[0], vv[1]), pk2(vv[2], vv[3]), pk2(vv[4], vv[5]), pk2(vv[6], vv[7])};
          { unsigned iw[4];
#pragma unroll
            for (int e = 0; e < 4; ++e) iw[e] = ((c8 + 2 * e == t) ? 0x3f80u : 0u) | ((c8 + 2 * e + 1 == t) ? 0x3f800000u : 0u);
            *(LAS u32x4*)(SL(11) + t * CP + c8) = (u32x4){iw[0], iw[1], iw[2], iw[3]}; } }
        CK_BAR();
#define CK_RUN2(A1, B1, E1, A2, B2, E2) do { CkF f1_, f2_; ck_ld(f1_, A1, B1, wave, lane); ck_ld(f2_, A2, B2, wave, lane); __builtin_amdgcn_sched_barrier(0); \
            f32x4 c1_[2] = CK_Z2, c2_[2] = CK_Z2; ck_mma(c1_, f1_); ck_mma(c2_, f2_); ck_epi(c1_, wave, lane, E1); ck_epi(c2_, wave, lane, E2); } while (0)
#define CK_RUN3(A1, B1, E1, A2, B2, E2, A3, B3, E3) do { CkF f1_, f2_, f3_; ck_ld(f1_, A1, B1, wave, lane); ck_ld(f2_, A2, B2, wave, lane); ck_ld(f3_, A3, B3, wave, lane); __builtin_amdgcn_sched_barrier(0); \
            f32x4 c1_[2] = CK_Z2, c2_[2] = CK_Z2, c3_[2] = CK_Z2; ck_mma(c1_, f1_); ck_mma(c2_, f2_); ck_mma(c3_, f3_); ck_epi(c1_, wave, lane, E1); ck_epi(c2_, wave, lane, E2); ck_epi(c3_, wave, lane, E3); } while (0)
        { auto t1 = [&](int m, int n, f32x4 v) { ck_wr_tr(SL(1), m, n, v); }; auto t3 = [&](int m, int n, f32x4 v) { ck_wr_tr(SL(3), m, n, v); };
          auto t5 = [&](int m, int n, f32x4 v) { ck_wr_tr(SL(5), m, n, v); }; auto t7 = [&](int m, int n, f32x4 v) { ck_wr_tr(SL(7), m, n, v); };
          CK_RUN2(SL(0), SL(11), t1, SL(2), SL(11), t3); CK_RUN2(SL(4), SL(11), t5, SL(10), SL(11), t7); }
        CK_BAR();
        { auto ePT = [&](int m, int n, f32x4 v) {
#pragma unroll
              for (int g = 0; g < 4; ++g) v[g] = (n < m + g) ? v[g] : 0.f;
              ck_wr_tr(SL(13), m, n, v); };
          auto ePA = [&](int m, int n, f32x4 v) { f32x4 tt;
#pragma unroll
              for (int g = 0; g < 4; ++g) { v[g] = (m + g < n) ? v[g] : 0.f; tt[g] = (m + g == n) ? 1.f : v[g]; }
              ck_wr_tr(SL(12), m, n, v); ck_wr_tr(SL(8), m, n, tt); };
          auto eMak = [&](int m, int n, f32x4 v) {
#pragma unroll
              for (int g = 0; g < 4; ++g) v[g] = (m + g < n) ? v[g] : 0.f;
              ck_wr_tr(SL(9), m, n, v); };
          CK_RUN3(SL(0), SL(2), ePT, SL(2), SL(0), ePA, SL(4), SL(0), eMak); }
        { auto eNrb = [&](int m, int n, f32x4 v) {
#pragma unroll
              for (int g = 0; g < 4; ++g) v[g] = (m + g <= n) ? v[g] : 0.f;
              ck_wr_tr(SL(10), m, n, v); };
          auto eNrk = [&](int m, int n, f32x4 v) {
#pragma unroll
              for (int g = 0; g < 4; ++g) v[g] = (m + g <= n) ? v[g] : 0.f;
              ck_wr_tr(SL(11), m, n, v); };
          CK_RUN2(SL(2), SL(6), eNrb, SL(4), SL(6), eNrk); }
        CK_BAR();
#define CK_NEU(TA, TB, PA_, PT_, PAN, PTN) do { \
            auto eT_ = [&](int m, int n, f32x4 v) { const u32x2 o = *(const LAS u32x2*)(SL(TA) + n * CP + m); v[0] += bflo(o.x); v[1] += bfhi(o.x); v[2] += bflo(o.y); v[3] += bfhi(o.y); ck_wr_tr(SL(TB), m, n, v); }; \
            auto eS1_ = [&](int m, int n, f32x4 v) { ck_wr_tr(SL(PTN), m, n, v); }; auto eS2_ = [&](int m, int n, f32x4 v) { ck_wr_tr(SL(PAN), m, n, v); }; \
            CK_RUN3(SL(PT_), SL(TA), eT_, SL(PA_), SL(PT_), eS1_, SL(PT_), SL(PA_), eS2_); CK_BAR(); } while (0)
        { auto eS1 = [&](int m, int n, f32x4 v) { ck_wr_tr(SL(2), m, n, v); }; auto eS2 = [&](int m, int n, f32x4 v) { ck_wr_tr(SL(0), m, n, v); };
          CK_RUN2(SL(12), SL(13), eS1, SL(13), SL(12), eS2); }
        CK_BAR();
        CK_NEU(8, 4, 0, 2, 12, 13);
        CK_NEU(4, 8, 12, 13, 0, 2);
        CK_NEU(8, 4, 0, 2, 12, 13);
        CK_NEU(4, 8, 12, 13, 0, 2);
        ck_mm(SL(2), SL(8), nullptr, nullptr, wave, lane, [&](int m, int n, f32x4 v) { const u32x2 o = *(const LAS u32x2*)(SL(8) + n * CP + m);
            v[0] += bflo(o.x); v[1] += bfhi(o.x); v[2] += bflo(o.y); v[3] += bfhi(o.y); ck_wr_tr(SL(4), m, n, v); });
        CK_BAR();
#undef CK_NEU
        { auto e12 = [&](int m, int n, f32x4 v) { ck_wr_tr(SL(12), m, n, v); }; auto e0 = [&](int m, int n, f32x4 v) { ck_wr_tr(SL(0), m, n, v); };
          CK_RUN2(SL(9), SL(7), e12, SL(4), SL(1), e0); }
        CK_BAR();
        { bf16* Pg = (bf16*)(ws + CH_P) + (size_t)cid * 4096; bf16* Rg = (bf16*)(ws + CH_RH) + (size_t)cid * 4096;
          auto e13 = [&](int m, int n, f32x4 v) { ck_wr_tr(SL(13), m, n, v); };
          auto eP = [&](int m, int n, f32x4 v) { const float gc = gC[n];
#pragma unroll
              for (int g = 0; g < 4; ++g) v[g] = gc * (((m + g == n) ? 1.f : 0.f) + v[g]);
              *(u32x2*)(Pg + n * 64 + m) = (u32x2){pk2(v[0], v[1]), pk2(v[2], v[3])}; };
          auto eR = [&](int m, int n, f32x4 v) { const u32x2 o = *(const LAS u32x2*)(SL(6) + n * CP + m);
              v[0] += bflo(o.x); v[1] += bfhi(o.x); v[2] += bflo(o.y); v[3] += bfhi(o.y);
              *(u32x2*)(Rg + n * 64 + m) = (u32x2){pk2(v[0], v[1]), pk2(v[2], v[3])}; };
          CK_RUN3(SL(4), SL(12), e13, SL(0), SL(3), eP, SL(0), SL(10), eR); }
        CK_BAR();
        { float* Qg = (float*)(ws + CH_Q) + (size_t)cid * 4096; float* Yg = (float*)(ws + CH_YL) + (size_t)cid * 4096;
          CkF f1, f2, f3, f4; ck_ld(f1, SL(13), SL(3), wave, lane); ck_ld(f2, SL(7), SL(5), wave, lane); ck_ld(f3, SL(13), SL(10), wave, lane); ck_ld(f4, SL(7), SL(11), wave, lane); __builtin_amdgcn_sched_barrier(0);
          f32x4 cq[2] = CK_Z2, cy[2] = CK_Z2; ck_mma(cq, f1); ck_mma(cq, f2); ck_mma(cy, f3); ck_mma(cy, f4);
          ck_epi(cq, wave, lane, [&](int m, int n, f32x4 v) { *(f32x4*)(Qg + n * 64 + m) = v * gC[n]; });
          ck_epi(cy, wave, lane, [&](int m, int n, f32x4 v) { *(f32x4*)(Yg + n * 64 + m) = v; }); }
#undef CK_RUN2
#undef CK_RUN3
    }
#undef SL
#undef CK_BAR
#undef CK_LOADIN
}
DI void phase_chunkB(const Args& a, LAS unsigned char* lds, int wave, int lane, int bid, int G) {
    unsigned char* ws = (unsigned char*)a.ws; LAS bf16* Zb = (LAS bf16*)lds;
    const int r = lane & 15, q = lane >> 4;
    if (wave != 0) return;
    for (int u = bid; u < NB * NH * 4; u += G) { const int iq = u & 3, bh = u >> 2;
        bf16x8 pf[4][2]; f32x4 qv[4];
#define CB_LOAD(cc) do { const size_t cid_ = (size_t)bh * NCK + (cc); const bf16* Pg_ = (const bf16*)(ws + CH_P) + cid_ * 4096; const float* Qg_ = (const float*)(ws + CH_Q) + cid_ * 4096; \
            _Pragma("unroll") for (int mt = 0; mt < 4; ++mt) { _Pragma("unroll") for (int ks = 0; ks < 2; ++ks) pf[mt][ks] = *(const bf16x8*)(Pg_ + (16 * mt + r) * 64 + 32 * ks + 8 * q); \
            _Pragma("unroll") for (int g = 0; g < 4; ++g) qv[mt][g] = Qg_[(16 * mt + 4 * q + g) * 64 + 16 * iq + r]; } } while (0)
        asm volatile("s_waitcnt lgkmcnt(0)" ::: "memory");
#pragma unroll
        for (int mt = 0; mt < 4; ++mt) { *(LAS u32x2*)(Zb + r * CP + 16 * mt + 4 * q) = (u32x2){0u, 0u};
            *(u32x2*)((bf16*)(ws + CH_ZS) + ((size_t)bh * NCK) * 4096 + (16 * iq + r) * 64 + 16 * mt + 4 * q) = (u32x2){0u, 0u}; }
        CB_LOAD(0);
        for (int c = 0; c < NCK - 1; ++c) { const size_t cid = (size_t)bh * NCK + c;
            asm volatile("s_waitcnt lgkmcnt(0)" ::: "memory");
            bf16x8 zf[2];
#pragma unroll
            for (int ks = 0; ks < 2; ++ks) zf[ks] = *(const LAS bf16x8*)(Zb + r * CP + 32 * ks + 8 * q);
            f32x4 z[4];
#pragma unroll
            for (int mt = 0; mt < 4; ++mt) { z[mt] = qv[mt];
#pragma unroll
                for (int ks = 0; ks < 2; ++ks) z[mt] = __builtin_amdgcn_mfma_f32_16x16x32_bf16(pf[mt][ks], zf[ks], z[mt], 0, 0, 0); }
            if (c + 1 < NCK - 1) CB_LOAD(c + 1);
#pragma unroll
            for (int mt = 0; mt < 4; ++mt) { const u32x2 zw = {pk2(z[mt][0], z[mt][1]), pk2(z[mt][2], z[mt][3])}; *(LAS u32x2*)(Zb + r * CP + 16 * mt + 4 * q) = zw;
                *(u32x2*)((bf16*)(ws + CH_ZS) + (cid + 1) * 4096 + (16 * iq + r) * 64 + 16 * mt + 4 * q) = zw; }
        }
    }
#undef CB_LOAD
}
DI void phase_chunkC(const Args& a, int l, int gw, int NGW, int lane) {
    unsigned char* ws = (unsigned char*)a.ws; const int r = lane & 15, q = lane >> 4;
    const bf16* Vv = (const bf16*)(ws + WS_V); const bf16* Gg = (const bf16*)(ws + WS_G); const float* RK = (const float*)(ws + WS_RK); bf16* ORW = (bf16*)(ws + WS_ORW);
    const float* lnw = a.inp(I_LNW) + (size_t)l * C; const float* lnb = a.inp(I_LNB) + (size_t)l * C;
    for (int u = gw; u < NCHUNK * 4; u += NGW) { const int tt = u & 3, cid = u >> 2; const int c = cid % NCK, bh = cid / NCK, hd = bh & 15, b = bh >> 4;
        const bf16* Zg = (const bf16*)(ws + CH_ZS) + (size_t)cid * 4096; const bf16* Rg = (const bf16*)(ws + CH_RH) + (size_t)cid * 4096; const float* Yg = (const float*)(ws + CH_YL) + (size_t)cid * 4096;
        const int t = 16 * tt + r, tok = CK * c + t; const bool ok = tok < L; const size_t ro = (size_t)(b * L + (ok ? tok : 0)) * C + hd * 64;
        bf16x8 bfr[2];
#pragma unroll
        for (int ks = 0; ks < 2; ++ks) bfr[ks] = *(const bf16x8*)(Rg + t * 64 + 32 * ks + 8 * q);
        f32x4 y[4]; float s = 0.f;
#pragma unroll
        for (int it = 0; it < 4; ++it) { f32x4 acc = *(const f32x4*)(Yg + t * 64 + 16 * it + 4 * q);
#pragma unroll
            for (int ks = 0; ks < 2; ++ks) acc = __builtin_amdgcn_mfma_f32_16x16x32_bf16(*(const bf16x8*)(Zg + (16 * it + r) * 64 + 32 * ks + 8 * q), bfr[ks], acc, 0, 0, 0);
            y[it] = acc; s += (acc[0] + acc[1]) + (acc[2] + acc[3]); }
        s += __shfl_xor(s, 16); s += __shfl_xor(s, 32); const float mean = s * (1.f / 64.f); float qs = 0.f;
#pragma unroll
        for (int it = 0; it < 4; ++it) { y[it] = y[it] - mean; qs += (y[it][0] * y[it][0] + y[it][1] * y[it][1]) + (y[it][2] * y[it][2] + y[it][3] * y[it][3]); }
        qs += __shfl_xor(qs, 16); qs += __shfl_xor(qs, 32); const float rstd = rsqrtf(qs * (1.f / 64.f) + GN_EPS);
        const float rk = RK[(size_t)(b * L + (ok ? tok : 0)) * NH + hd];
#pragma unroll
        for (int it = 0; it < 4; ++it) { const int ch = 16 * it + 4 * q; const u32x2 vw = *(const u32x2*)(Vv + ro + ch), gw_ = *(const u32x2*)(Gg + ro + ch);
            const f32x4 v = {bflo(vw.x), bfhi(vw.x), bflo(vw.y), bfhi(vw.y)}, g = {bflo(gw_.x), bfhi(gw_.x), bflo(gw_.y), bfhi(gw_.y)};
            const f32x4 lw = *(const f32x4*)(lnw + hd * 64 + ch), lb = *(const f32x4*)(lnb + hd * 64 + ch);
            const f32x4 o = (y[it] * rstd * lw + lb + rk * v) * g;
            if (ok) *(u32x2*)(ORW + ro + ch) = (u32x2){pk2(o[0], o[1]), pk2(o[2], o[3])}; }
    }
}
DI void phase_router(const Args& a, int l, LAS unsigned char* lds, int wave, int lane, int bid, int G, bool dummy = false) {
    unsigned char* ws = (unsigned char*)a.ws; const float* H = (const float*)(ws + WS_H); bf16* U = (bf16*)(ws + WS_U); const bf16* WRO = (const bf16*)(ws + WS_WRO) + (size_t)l * 80 * D;
    const float* gain = a.inp(I_NORM_FFN) + (size_t)l * D; const float* bco = a.inp(I_BCOARSE) + l * 8; const float* bfi = a.inp(I_BFINE) + l * 64;
    int* toke = (int*)(ws + WS_TOKE); int* toks = (int*)(ws + WS_TOKS); float* tokw = (float*)(ws + WS_TOKW); unsigned* cnt = (unsigned*)(ws + WS_CTL) + CW_CNT + l * 64 * 16;
    int* elist = (int*)(ws + WS_ELIST);
    if (dummy) { toke = (int*)(ws + WS_XR); toks = toke + 2 * T; tokw = (float*)(toks + 2 * T); cnt += 8192; U = (bf16*)(ws + WS_XR) + (size_t)8 * T; elist = (int*)(ws + WS_XR) + (size_t)(8 + 2048) * T; }
    LAS float* red = (LAS float*)lds;
    LAS float* ssp = red + 8 * 16 * 80;
    LAS float* lg = ssp + 8 * 16;
    LAS float* rs = lg + 16 * 72;
    const int tid = wave * 64 + lane;
    const int n = lane & 15, q = lane >> 4;
    for (int tile = bid; tile < T / 16; tile += G) { const int row0 = tile * 16;
        __syncthreads();
        f32x4 hv[8][2];
        const float* hp = H + (size_t)(row0 + n) * D + wave * 256 + 8 * q; const float* gp = gain + wave * 256 + 8 * q;
#pragma unroll
        for (int ks = 0; ks < 8; ++ks) { hv[ks][0] = *(const f32x4*)(hp + ks * 32); hv[ks][1] = *(const f32x4*)(hp + ks * 32 + 4); }
        f32x4 acc[5];
#pragma unroll
        for (int nt = 0; nt < 5; ++nt) acc[nt] = (f32x4){0.f, 0.f, 0.f, 0.f};
        float ss = 0.f;
#pragma unroll
        for (int ks = 0; ks < 8; ++ks) { const int k0 = wave * 256 + ks * 32 + 8 * q;
            const f32x4 g0 = *(const f32x4*)(gp + ks * 32), g1 = *(const f32x4*)(gp + ks * 32 + 4); const f32x4 x0 = hv[ks][0], x1 = hv[ks][1];
            ss += (x0[0] * x0[0] + x0[1] * x0[1]) + (x0[2] * x0[2] + x0[3] * x0[3]) + (x1[0] * x1[0] + x1[1] * x1[1]) + (x1[2] * x1[2] + x1[3] * x1[3]);
            const f32x4 y0 = x0 * g0, y1 = x1 * g1; u32x4 aw; aw.x = pk2(y0[0], y0[1]); aw.y = pk2(y0[2], y0[3]); aw.z = pk2(y1[0], y1[1]); aw.w = pk2(y1[2], y1[3]);
            const bf16x8 af = __builtin_bit_cast(bf16x8, aw);
#pragma unroll
            for (int nt = 0; nt < 5; ++nt) acc[nt] = __builtin_amdgcn_mfma_f32_16x16x32_bf16(af, *(const bf16x8*)(WRO + (size_t)(nt * 16 + n) * D + k0), acc[nt], 0, 0, 0); }
        ss += __shfl_xor(ss, 16); ss += __shfl_xor(ss, 32);
        if (q == 0) ssp[wave * 16 + n] = ss;
#pragma unroll
        for (int nt = 0; nt < 5; ++nt)
#pragma unroll
            for (int j = 0; j < 4; ++j) red[(wave * 16 + 4 * q + j) * 80 + nt * 16 + n] = acc[nt][j];
        __syncthreads();
        if (tid < 16) { float s = 0.f;
#pragma unroll
            for (int w = 0; w < 8; ++w) s += ssp[w * 16 + tid];
            rs[tid] = rsqrtf(s * (1.f / D) + NORM_EPS); }
        __syncthreads();
        for (int i = tid; i < 16 * 72; i += NTHR) { const int tk = i / 72, nn = i % 72; float s = 0.f;
#pragma unroll
            for (int w = 0; w < 8; ++w) s += red[(w * 16 + tk) * 80 + nn];
            lg[tk * 72 + nn] = s * rs[tk] + ((nn < 8) ? bco[nn] : bfi[nn - 8]); }
        { const float rstd = rs[n]; bf16* up = U + (size_t)(row0 + n) * D + wave * 256 + 8 * q;
#pragma unroll
          for (int ks = 0; ks < 8; ++ks) { const f32x4 g0 = *(const f32x4*)(gp + ks * 32), g1 = *(const f32x4*)(gp + ks * 32 + 4); const f32x4 y0 = hv[ks][0] * rstd * g0, y1 = hv[ks][1] * rstd * g1;
              *(u32x4*)(up + ks * 32) = (u32x4){pk2(y0[0], y0[1]), pk2(y0[2], y0[3]), pk2(y1[0], y1[1]), pk2(y1[2], y1[3])}; } }
        __syncthreads();
        if (tid < 16) { const int m = row0 + tid; const LAS float* p = lg + tid * 72;
            int gi = 0; float gm = p[0];
#pragma unroll
            for (int j = 1; j < 8; ++j) if (p[j] > gm) { gm = p[j]; gi = j; }
            float se = 0.f;
#pragma unroll
            for (int j = 0; j < 8; ++j) se += __expf(p[j] - gm);
            const float pgrp = 1.f / se;
            const LAS float* f = p + 8 + gi * 8;
            int i0 = 0; float f0 = f[0];
#pragma unroll
            for (int j = 1; j < 8; ++j) if (f[j] > f0) { f0 = f[j]; i0 = j; }
            int i1 = -1; float f1 = -3.0e38f;
#pragma unroll
            for (int j = 0; j < 8; ++j) if (j != i0 && f[j] > f1) { f1 = f[j]; i1 = j; }
            const float e1 = __expf(f1 - f0), den = 1.f / (1.f + e1);
            const int e0x = gi * 8 + i0, e1x = gi * 8 + i1;
            toke[2 * m] = e0x; toke[2 * m + 1] = e1x; tokw[2 * m] = den * pgrp; tokw[2 * m + 1] = e1 * den * pgrp;
            const int s0 = (int)__hip_atomic_fetch_add(cnt + e0x * 16, 1u, RLX_AGENT), s1 = (int)__hip_atomic_fetch_add(cnt + e1x * 16, 1u, RLX_AGENT);
            toks[2 * m] = s0; toks[2 * m + 1] = s1; elist[(size_t)e0x * T + s0] = m; elist[(size_t)e1x * T + s1] = m; }
    }
}
constexpr int MS_TILE = 128 * 128;
template <int MODE, int VAR = 0>
DI void moe_stream_phase(const Args& a, int l, LAS unsigned char* lds, int wave, int lane, int tid, int bid, int G, int lw = -1, size_t out_off = 0) {
    unsigned char* ws = (unsigned char*)a.ws; LAS int* lc = (LAS int*)(lds + LDSCTL_OFF);
    moe_tables((const unsigned*)(ws + WS_CTL) + CW_CNT + l * 64 * 16, lc, tid);
    if (lw >= 0) l = lw;
    const size_t o_hid = out_off ? out_off : WS_HID, o_yr = out_off ? out_off : WS_YR;
    constexpr int KD = (MODE == 0) ? D : DEXP, NT = KD / 64, NSLAB = (MODE == 0) ? 8 : 16, LDW = (MODE == 0) ? DEXP : D, LDX = KD;
    const int half = wave & 1, nb16 = lane & 15, kb = 4 * (wave >> 1) + (lane >> 4);
    const int tk = lane & 15, q = lane >> 4;
    const GAS char* wmat = (const GAS char*)((MODE == 0) ? (half ? a.inp(I_WEU) : a.inp(I_WEG)) : a.inp(I_WED));
    const unsigned wvo = (unsigned)((4 * kb * LDW + 4 * nb16) * 4);
    int lds_wr[4];
#pragma unroll
    for (int i = 0; i < 4; ++i) { const int n = 64 * half + 4 * nb16 + i; lds_wr[i] = n * 128 + (((kb >> 1) ^ ((n >> 1) & 7)) << 4) + (kb & 1) * 8; }
    const int rd_g = (tk >> 1) & 7;
    for (int vb = bid; vb < NEXP * NSLAB; vb += G) {
        const int xcd = vb & 7, idx = vb >> 3; const int e = xcd * 8 + idx / NSLAB, slab = idx % NSLAB;
        const int M = __builtin_amdgcn_readfirstlane(lc[LC_CNT / 4 + e]), row0 = __builtin_amdgcn_readfirstlane(lc[LC_PSTART / 4 + e]);
        const size_t wuo = (MODE == 0) ? ((size_t)(l * NEXP + e) * D * DEXP + slab * 64) * 4 : ((size_t)(l * NEXP + e) * DEXP * D + slab * 128 + 64 * half) * 4;
        const __amdgpu_buffer_rsrc_t wrs = __builtin_amdgcn_make_buffer_rsrc((void*)(wmat + wuo), 0, KD * LDW * 4, 0x00020000);
        const __amdgpu_buffer_rsrc_t xrs = __builtin_amdgcn_make_buffer_rsrc((MODE == 0) ? (void*)(ws + WS_U) : (void*)((const GAS char*)(ws + WS_HID) + (size_t)row0 * LDX * 2), 0, 0x7fffffff, 0x00020000);
        const int* el = (const int*)(ws + WS_ELIST) + (size_t)e * T;
        for (int rp = 0; rp < M; rp += 384) {
            unsigned xvo[3];
#pragma unroll
            for (int mt = 0; mt < 3; ++mt) { int tok = rp + wave * 48 + mt * 16 + tk; tok = min(tok, M - 1); if (VAR == 5) tok &= 15; if (MODE == 0) tok = el[tok]; xvo[mt] = (unsigned)((tok * LDX + 8 * q) * 2); }
            f32x4 acc[3][8];
#pragma unroll
            for (int mt = 0; mt < 3; ++mt)
#pragma unroll
                for (int j = 0; j < 8; ++j) acc[mt][j] = (f32x4){0.f, 0.f, 0.f, 0.f};
            f32x4 wr[2][4];
            bf16x8 xf[3][2], xn[3][2];
#define MS_WLOAD(set, t) do { _Pragma("unroll") for (int r_ = 0; r_ < 4; ++r_) wr[set][r_] = __builtin_bit_cast(f32x4, __builtin_amdgcn_raw_buffer_load_b128(wrs, (int)wvo + r_ * LDW * 4, (t) * (64 * LDW * 4), 0)); } while (0)
#define MS_WCOMMIT(set, bufi) do { LAS unsigned char* wb_ = lds + (bufi) * MS_TILE; _Pragma("unroll") for (int i_ = 0; i_ < 4; ++i_) { \
            u32x2 p_; p_.x = pk2(wr[set][0][i_], wr[set][1][i_]); p_.y = pk2(wr[set][2][i_], wr[set][3][i_]); \
            *(LAS u32x2*)(wb_ + lds_wr[i_]) = p_; } } while (0)
#define MS_XLOAD(dst, t) do { _Pragma("unroll") for (int mt = 0; mt < 3; ++mt) _Pragma("unroll") for (int ks = 0; ks < 2; ++ks) dst[mt][ks] = __builtin_bit_cast(bf16x8, __builtin_amdgcn_raw_buffer_load_b128(xrs, (int)xvo[mt] + ks * 64, (t) * 128, 0)); } while (0)
#define MS_WF(dst, bufi, g) do { const LAS unsigned char* wb_ = lds + (bufi) * MS_TILE + tk * 128; _Pragma("unroll") for (int jj = 0; jj < 4; ++jj) \
            dst[jj] = *(const LAS bf16x8*)(wb_ + (16 * (4 * ((g) & 1) + jj)) * 128 + (((4 * ((g) >> 1) + q) ^ rd_g) << 4)); } while (0)
#define MS_MM(wf, XF, g) do { _Pragma("unroll") for (int jj = 0; jj < 4; ++jj) _Pragma("unroll") for (int mt = 0; mt < 3; ++mt) \
            acc[mt][4 * ((g) & 1) + jj] = __builtin_amdgcn_mfma_f32_16x16x32_bf16(wf[jj], XF[mt][(g) >> 1], acc[mt][4 * ((g) & 1) + jj], 0, 0, 0); } while (0)
#define MS_COMPUTE(bufi, XF) do { bf16x8 wfa_[4], wfb_[4]; MS_WF(wfa_, bufi, 0); MS_WF(wfb_, bufi, 1); __builtin_amdgcn_sched_barrier(0); MS_MM(wfa_, XF, 0); \
            MS_WF(wfa_, bufi, 2); __builtin_amdgcn_sched_barrier(0); MS_MM(wfb_, XF, 1); MS_WF(wfb_, bufi, 3); __builtin_amdgcn_sched_barrier(0); MS_MM(wfa_, XF, 2); \
            __builtin_amdgcn_sched_barrier(0); MS_MM(wfb_, XF, 3); } while (0)
            __syncthreads();
            MS_XLOAD(xf, 0); MS_WLOAD(0, 0); MS_WLOAD(1, 1);
            MS_WCOMMIT(0, 0); MS_WLOAD(0, 2);
            __syncthreads();
#pragma unroll 1
            for (int t = 0; t < NT; t += 2) {
                MS_WCOMMIT(1, 1); MS_XLOAD(xn, t + 1); { const int t3 = (t + 3 < NT) ? t + 3 : NT - 1; MS_WLOAD(1, t3); }
                MS_COMPUTE(0, xf);
                __syncthreads();
                MS_WCOMMIT(0, 0); { const int t4 = (t + 4 < NT) ? t + 4 : NT - 1, t2 = (t + 2 < NT) ? t + 2 : NT - 1; MS_XLOAD(xf, t2); MS_WLOAD(0, t4); }
                MS_COMPUTE(1, xn);
                __syncthreads();
            }
#pragma unroll
            for (int mt = 0; mt < 3; ++mt) { const int tok = rp + wave * 48 + mt * 16 + tk;
                if (tok < M) {
                    if (MODE == 0) { bf16* o = (bf16*)(ws + o_hid) + (size_t)(row0 + tok) * DEXP + slab * 64 + 4 * q;
#pragma unroll
                        for (int j = 0; j < 4; ++j) { float h[4];
#pragma unroll
                            for (int i = 0; i < 4; ++i) { const float gt = acc[mt][j][i]; h[i] = gt * sigmoidf_(gt) * acc[mt][j + 4][i]; }
                            *(u32x2*)(o + 16 * j) = (u32x2){pk2(h[0], h[1]), pk2(h[2], h[3])}; }
                    } else { bf16* o = (bf16*)(ws + o_yr) + (size_t)(row0 + tok) * D + slab * 128 + 4 * q;
#pragma unroll
                        for (int j = 0; j < 8; ++j) *(u32x2*)(o + 16 * j) = (u32x2){pk2(acc[mt][j][0], acc[mt][j][1]), pk2(acc[mt][j][2], acc[mt][j][3])}; } } }
#undef MS_WLOAD
#undef MS_WCOMMIT
#undef MS_XLOAD
#undef MS_COMPUTE
#undef MS_WF
#undef MS_MM
        }
    }
}

constexpr int PH_PER_LAYER = 10, NPHASE = 1 + 2 * PH_PER_LAYER + 1;
__global__ void __launch_bounds__(NTHR, 2) mk_fwd(ArgsV argsv) {
    extern __shared__ __attribute__((aligned(16))) unsigned char lds_raw[];
    LAS unsigned char* lds = (LAS unsigned char*)lds_raw;
    Args args; args.p = (ArgsP)__builtin_amdgcn_kernarg_segment_ptr(); args.ws = (GAS unsigned char*)args.p->ws; args.out = (GAS float*)args.p->out;
    { const int tid0 = threadIdx.x; for (int u = tid0; u < (LDS_BYTES - LDSCTL_OFF) / 4; u += NTHR) ((LAS unsigned*)(lds + LDSCTL_OFF))[u] = 0u; }
    __syncthreads();
    XcdBarrier bar; bar.bar = (unsigned*)(args.ws + WS_CTL) + CW_BAR; bar.x = 0; bar.st = nullptr;
    const int lo = args.p->ph_lo, hi = args.p->ph_hi;
    if (hi - lo > 1) bar = xcd_barrier_post((unsigned*)(args.ws + WS_CTL) + CW_BAR, (volatile LAS unsigned*)(lds + LDSCTL_OFF + LC_BAR));
#ifndef PHMASK
#define PHMASK 0xffffffffu
#endif
#define PHBIT(k) ((k) == 0 ? 0 : ((k) == NPHASE - 1 ? 12 : 1 + ((k) - 1) % PH_PER_LAYER))
#define IN(k) (((PHMASK >> PHBIT(k)) & 1u) && lo <= (k) && (k) < hi)
#define SEAM(k) do { if (IN(k) && IN((k) + 1)) xcd_barrier(bar); } while (0)
#define PH_BEGIN() int tid = threadIdx.x; asm volatile("" : "+v"(tid)); Args a = args; asm volatile("" : "+s"(a.p), "+s"(a.ws), "+s"(a.out)); unsigned char* ws = (unsigned char*)a.ws; \
    const int lane = tid & 63, wave = __builtin_amdgcn_readfirstlane(tid >> 6); int G = gridDim.x, bid = blockIdx.x; asm volatile("" : "+s"(G), "+s"(bid)); const int gw = bid * NWAVES + wave, NGW = G * NWAVES; (void)lane; (void)gw; (void)NGW; (void)ws

#ifndef PROBE_DUP
#define PROBE_DUP 0u
#endif
#define DUP(bit) if constexpr (((PROBE_DUP >> (bit)) & 1u) != 0u)
    enum { PB_CONVERT = 0, PB_NORM0, PB_GEMM1, PB_VT, PB_RWKVPREP, PB_SCAN, PB_ATTN, PB_POST, PB_BRANCH, PB_GATHER, PB_MOEK, PB_MOEL, PB_FINAL, PB_WOUT, PB_ROUTER, PB_MOEK_COLD, PB_MOEL_COLD, PB_MK5, PB_CKA, PB_CKB, PB_CKC };

    if (IN(0)) { { PH_BEGIN(); phase_convert<2>(a, 0, lds, gw, NGW, wave, lane); } DUP(PB_CONVERT) { PH_BEGIN(); phase_convert<2>(a, 0, lds, gw, NGW, wave, lane); } }

#pragma unroll 1
    for (int l = 0; l < 2; ++l) {
        const int pb = 1 + l * PH_PER_LAYER;
        if (IN(pb + 0)) { { PH_BEGIN(); phase_norm<0>(a, a.inp(I_NORM_MIX) + (size_t)l * D, l > 0, l - 1, lds, tid, gw, NGW, lane, (l == 0) ? a.inp(I_X) : nullptr, a.inp(I_META)); }
            DUP(PB_NORM0) { if (l == 0) { PH_BEGIN(); phase_norm<0>(a, a.inp(I_NORM_MIX) + (size_t)l * D, false, 0, lds, tid, gw, NGW, lane, a.inp(I_X), a.inp(I_META)); } } } SEAM(pb + 0);
#define RUN_GEMM1() { PH_BEGIN(); pg8::RectOrder S; S.init(ws + WS_U, (const bf16*)(ws + WS_W1T) + (size_t)l * NZ * D, D, D, TP / 256, NZ / 256, G, bid); \
            pg8::EpiBf16 E{(bf16*)(ws + WS_Z), NZ, (const float*)(ws + WS_BIAS) + (size_t)l * NZ}; \
            pg8::gemm_phase<pg8::EpiBf16, pg8::RectOrder>(lds, pg8::Dims{D, D, D / 64}, S, E); }
        if (IN(pb + 1)) { RUN_GEMM1(); DUP(PB_GEMM1) RUN_GEMM1();
            if (l == 0) { PH_BEGIN(); const int nfull = (TP / 256) * (NZ / 256) % G; if (nfull != 0 && bid >= nfull) phase_convert<0>(a, 1, lds, (bid - nfull) * NWAVES + wave, (G - nfull) * NWAVES, wave, lane);
                          else if (nfull == 0) phase_convert<0>(a, 1, lds, gw, NGW, wave, lane); } } SEAM(pb + 1);
        if (IN(pb + 2)) { { PH_BEGIN(); phase_rope(a, gw, NGW, lane); } { PH_BEGIN(); phase_vt(a, gw, NGW, lane); } DUP(PB_VT) { PH_BEGIN(); phase_vt(a, gw, NGW, lane); }
            { PH_BEGIN(); phase_rwkvprep(a, l, lds, tid, gw, NGW, lane); } DUP(PB_RWKVPREP) { PH_BEGIN(); phase_rwkvprep(a, l, lds, tid, gw, NGW, lane); } } SEAM(pb + 2);
        if (IN(pb + 3)) { { PH_BEGIN(); phase_chunkA(a, lds, wave, lane, tid, bid, G); } DUP(PB_CKA) { PH_BEGIN(); phase_chunkA(a, lds, wave, lane, tid, bid, G); }
            { PH_BEGIN(); phase_attn(a, l, gw, NGW, lane); } DUP(PB_ATTN) { PH_BEGIN(); phase_attn(a, l, gw, NGW, lane); }
            xcd_barrier(bar);
            { PH_BEGIN(); phase_chunkB(a, lds, wave, lane, bid, G); if (wave != 0) phase_convert<1>(a, l, lds, bid * (NWAVES - 1) + wave - 1, G * (NWAVES - 1), wave, lane); }
            DUP(PB_CKB) { PH_BEGIN(); phase_chunkB(a, lds, wave, lane, bid, G); } xcd_barrier(bar);
            { PH_BEGIN(); phase_chunkC(a, l, gw, NGW, lane); } DUP(PB_CKC) { PH_BEGIN(); phase_chunkC(a, l, gw, NGW, lane); } }
        SEAM(pb + 3);
#define RUN_BRANCH() { \
            { PH_BEGIN(); pg8::RectOrder S; S.init(ws + WS_OATT, (const bf16*)(ws + WS_WAT) + (size_t)l * D * C, C, C, MBIG / 256, D / 256, G, bid); \
              pg8::EpiGate E{(bf16*)(ws + WS_T1), (const bf16*)(ws + WS_Z), ZGA, nullptr}; \
              pg8::gemm_phase<pg8::EpiGate, pg8::RectOrder>(lds, pg8::Dims{C, C, C / 64}, S, E); \
              skinny64((const bf16*)(ws + WS_OATT), C, (const bf16*)(ws + WS_WAT) + (size_t)l * D * C, C, D, C, MBIG, lds, SkGate{(bf16*)(ws + WS_T1), (const bf16*)(ws + WS_Z), ZGA, nullptr}, wave, lane, bid, G); } \
            { PH_BEGIN(); pg8::RectOrder S; S.init(ws + WS_ORW, (const bf16*)(ws + WS_WRT) + (size_t)l * D * C, C, C, MBIG / 256, D / 256, G, bid); \
              pg8::EpiGate E{(bf16*)(ws + WS_MIX), (const bf16*)(ws + WS_Z), ZGR, (const bf16*)(ws + WS_T1)}; \
              pg8::gemm_phase<pg8::EpiGate, pg8::RectOrder>(lds, pg8::Dims{C, C, C / 64}, S, E); \
              skinny64((const bf16*)(ws + WS_ORW), C, (const bf16*)(ws + WS_WRT) + (size_t)l * D * C, C, D, C, MBIG, lds, SkGate{(bf16*)(ws + WS_MIX), (const bf16*)(ws + WS_Z), ZGR, (const bf16*)(ws + WS_T1)}, wave, lane, bid, G); } }
        if (IN(pb + 5)) { RUN_BRANCH(); DUP(PB_BRANCH) RUN_BRANCH(); } SEAM(pb + 5);
#define RUN_WOUT(HP) { PH_BEGIN(); pg8::RectOrder S; S.init(ws + WS_MIX, (const bf16*)(ws + WS_WOT) + (size_t)l * D * D, D, D, MBIG / 256, D / 256, G, bid); \
            pg8::EpiResAdd E{(float*)(ws + (HP)), (l == 0) ? a.inp(I_X) : nullptr, a.inp(I_META)}; \
            pg8::gemm_phase<pg8::EpiResAdd, pg8::RectOrder>(lds, pg8::Dims{D, D, D / 64}, S, E); \
            skinny64((const bf16*)(ws + WS_MIX), D, (const bf16*)(ws + WS_WOT) + (size_t)l * D * D, D, D, D, MBIG, lds, SkRes{(float*)(ws + (HP)), (l == 0) ? a.inp(I_X) : nullptr, a.inp(I_META)}, wave, lane, bid, G); }
        if (IN(pb + 6)) { RUN_WOUT(WS_H); DUP(PB_WOUT) RUN_WOUT(WS_YR); } SEAM(pb + 6);
        if (IN(pb + 7)) { { PH_BEGIN(); phase_router(a, l, lds, wave, lane, bid, G); } DUP(PB_ROUTER) { PH_BEGIN(); phase_router(a, l, lds, wave, lane, bid, G, true); } } SEAM(pb + 7);
        if (IN(pb + 8)) { { PH_BEGIN(); moe_stream_phase<0>(a, l, lds, wave, lane, tid, bid, G); } DUP(PB_MOEK) { PH_BEGIN(); moe_stream_phase<0>(a, l, lds, wave, lane, tid, bid, G); }
            DUP(PB_MOEK_COLD) { PH_BEGIN(); moe_stream_phase<0>(a, l, lds, wave, lane, tid, bid, G, 1 - l, WS_T1); }
            DUP(PB_MK5) { PH_BEGIN(); moe_stream_phase<0, 5>(a, l, lds, wave, lane, tid, bid, G, 1 - l, WS_T1); } } SEAM(pb + 8);
        if (IN(pb + 9)) { { PH_BEGIN(); moe_stream_phase<1>(a, l, lds, wave, lane, tid, bid, G); } DUP(PB_MOEL) { PH_BEGIN(); moe_stream_phase<1>(a, l, lds, wave, lane, tid, bid, G); }
            DUP(PB_MOEL_COLD) { PH_BEGIN(); moe_stream_phase<1>(a, l, lds, wave, lane, tid, bid, G, 1 - l, WS_XR); } } SEAM(pb + 9);
    }
    if (IN(NPHASE - 1)) { { PH_BEGIN(); phase_norm<1>(a, a.inp(I_NORM_FINAL), true, 1, lds, tid, gw, NGW, lane); } DUP(PB_FINAL) { PH_BEGIN(); phase_norm<1>(a, a.inp(I_NORM_FINAL), true, 1, lds, tid, gw, NGW, lane); } }
#undef IN
#undef SEAM
}

extern "C" void kernel_launch(void* const* d_in, const int* in_sizes, int n_in, void* d_out, int out_size, void* d_ws, size_t ws_size, hipStream_t stream) {
    static int grid = 0;
    if (grid == 0) {
        if (n_in != 33 || ws_size < WS_END) { fprintf(stderr, "kernel_launch: need 33 inputs and %zu bytes of workspace (got %d, %zu)\n", (size_t)WS_END, n_in, ws_size); grid = -1; return; }
        int dev = 0, cus = 0, per_cu = 0;
        if (hipGetDevice(&dev) != hipSuccess || hipDeviceGetAttribute(&cus, hipDeviceAttributeMultiprocessorCount, dev) != hipSuccess) { grid = -1; return; }
        if (hipFuncSetAttribute((const void*)mk_fwd, hipFuncAttributeMaxDynamicSharedMemorySize, LDS_BYTES) != hipSuccess) { fprintf(stderr, "kernel_launch: hipFuncSetAttribute failed\n"); grid = -1; return; }
        if (hipOccupancyMaxActiveBlocksPerMultiprocessor(&per_cu, (const void*)mk_fwd, NTHR, LDS_BYTES) != hipSuccess || per_cu < 1) fprintf(stderr, "kernel_launch: occupancy query says %d\n", per_cu);
        (void)hipGetLastError();
        grid = cus;
    }
    if (grid < 0) return;
    (void)hipMemsetAsync((char*)d_ws + WS_CTL, 0, 128 * 1024, stream);
    ArgsV a{};
    for (int i = 0; i < 33; ++i) a.in[i] = (const float*)d_in[i];
    a.out = (float*)d_out; a.ws = (unsigned char*)d_ws;
#if MK_N_LAUNCHES == 1
    a.ph_lo = 0; a.ph_hi = NPHASE;
    hipLaunchKernelGGL(mk_fwd, dim3(grid), dim3(NTHR), LDS_BYTES, stream, a);
#else
    for (int p = 0; p < NPHASE; ++p) { a.ph_lo = p; a.ph_hi = p + 1; hipLaunchKernelGGL(mk_fwd, dim3(grid), dim3(NTHR), LDS_BYTES, stream, a); }
#endif
}
```

```cpp
#include <hip/hip_runtime.h>
#include <cstdio>
#include <cstdint>

#ifndef MK_N_LAUNCHES
#define MK_N_LAUNCHES 1
#endif

#define GAS __attribute__((address_space(1)))
#define LAS __attribute__((address_space(3)))
typedef unsigned short bf16;
typedef short bf16x8 __attribute__((ext_vector_type(8)));
typedef float f32x4 __attribute__((ext_vector_type(4)));
typedef float f32x2 __attribute__((ext_vector_type(2)));
typedef float f32x16 __attribute__((ext_vector_type(16)));
typedef unsigned u32x4 __attribute__((ext_vector_type(4)));
typedef unsigned u32x2 __attribute__((ext_vector_type(2)));
typedef __bf16 bf16x2_t __attribute__((ext_vector_type(2)));
typedef GAS unsigned gu32;
#define RLX_AGENT __ATOMIC_RELAXED, __HIP_MEMORY_SCOPE_AGENT
#define DI __device__ __forceinline__

constexpr int D = 2048, NB = 4, SEQ = 2048, NMETA = 16, L = SEQ + NMETA, T = NB * L  , TP = 8448  ;
constexpr int NIN = 8896, NZ = 8960  ;
constexpr int ZQ = 0, ZK = 1024, ZV = 1280, ZGA = 1536, ZGR = 3584, ZR0 = 5632, ZVD = 8896;
constexpr int C = 1024, NH = 16, HD = 64;
constexpr int NEXP = 64, DEXP = 512, PR = 128 * 256;
constexpr int LPAD = 2080;
constexpr float NORM_EPS = 1e-5f, GN_EPS = 64e-5f;
constexpr int NWAVES = 8, NTHR = 512;
constexpr int MBIG = 8192;
static_assert(T - MBIG == 64, "skinny64 covers exactly 64 rows");

constexpr size_t al256(size_t x) { return (x + 255) & ~(size_t)255; }
constexpr size_t WS_CTL = 0, CTL_BYTES = 1u << 20;
constexpr size_t WS_H = WS_CTL + CTL_BYTES;
constexpr size_t WS_U = WS_H + (size_t)TP * D * 4;
constexpr size_t WS_Z = WS_U + (size_t)TP * D * 2;
constexpr size_t WS_R = WS_Z + (size_t)TP * NZ * 2;
constexpr size_t SZ_TC = (size_t)T * C * 4;
constexpr size_t WS_W = WS_R + SZ_TC, WS_K = WS_W + SZ_TC, WS_V = WS_K + SZ_TC, WS_KK = WS_V + SZ_TC, WS_B = WS_KK + SZ_TC;
constexpr size_t WS_Y = WS_B + SZ_TC, WS_VF = WS_Y + SZ_TC, WS_G = WS_VF + SZ_TC;
constexpr size_t WS_RK = WS_G + SZ_TC;
constexpr size_t WS_VT = al256(WS_RK + (size_t)T * NH * 4);
constexpr size_t WS_OATT = al256(WS_VT + (size_t)NB * 4 * HD * LPAD * 2);
constexpr size_t WS_ORW = WS_OATT + (size_t)TP * C * 2;
constexpr size_t WS_T1 = WS_ORW + (size_t)TP * C * 2;
constexpr size_t WS_MIX = WS_T1 + (size_t)TP * D * 2;
constexpr size_t WS_XR = WS_MIX + (size_t)TP * D * 2;
constexpr size_t WS_HID = WS_XR + (size_t)PR * D * 2;
constexpr size_t WS_YR = WS_HID + (size_t)PR * DEXP * 2;
constexpr size_t WS_TOKE = WS_YR + (size_t)PR * D * 2;
constexpr size_t WS_TOKS = al256(WS_TOKE + (size_t)T * 2 * 4);
constexpr size_t WS_TOKW = al256(WS_TOKS + (size_t)T * 2 * 4);
constexpr size_t WS_ELIST = al256(WS_TOKW + (size_t)T * 2 * 4);
constexpr size_t WS_ROPE = al256(WS_ELIST + (size_t)NEXP * T * 4);
constexpr size_t WS_BIAS = al256(WS_ROPE + (size_t)L * 16 * 4);
constexpr size_t WS_W1T = al256(WS_BIAS + (size_t)2 * NZ * 4);
constexpr size_t WS_WAT = WS_W1T + (size_t)2 * NZ * D * 2;
constexpr size_t WS_WRT = WS_WAT + (size_t)2 * D * C * 2;
constexpr size_t WS_WOT = WS_WRT + (size_t)2 * D * C * 2;
constexpr size_t WS_WRO = WS_WOT + (size_t)2 * D * D * 2;
constexpr size_t WS_LDEC = WS_WRO + (size_t)2 * 80 * D * 2;
constexpr size_t WS_LICL = WS_LDEC + (size_t)2 * C * 64 * 2;
constexpr size_t WS_LGAT = WS_LICL + (size_t)2 * C * 64 * 2;
constexpr size_t WS_LVUP = WS_LGAT + (size_t)2 * C * 64 * 2;
constexpr size_t WS_END = WS_LVUP + (size_t)C * 32 * 2;
constexpr int CW_TMO = 0, CW_BAR = 4096, CW_CNT = 16384;

constexpr int RING_BYTES = 131072, LDSCTL_OFF = RING_BYTES, LDS_BYTES = 147456;
constexpr int LC_BAR = 0, LC_NTILE = 16, LC_TILEE = 32  , LC_PSTART = 32 + 512  , LC_CNT = LC_PSTART + 256  ;

DI unsigned pk2(float a, float b) { f32x2 v = {a, b}; bf16x2_t r = __builtin_convertvector(v, bf16x2_t); return __builtin_bit_cast(unsigned, r); }
DI float bf2f(unsigned short b) { return __builtin_bit_cast(float, (unsigned)b << 16); }
DI float bflo(unsigned u) { return __builtin_bit_cast(float, u << 16); }
DI float bfhi(unsigned u) { return __builtin_bit_cast(float, u & 0xffff0000u); }
DI float wave_sum(float v) {
#pragma unroll
    for (int o = 1; o < 64; o <<= 1) v += __shfl_xor(v, o);
    return v;
}
DI float sigmoidf_(float x) { return 1.f / (1.f + __expf(-x)); }
#define LDS_WAIT() asm volatile("s_waitcnt lgkmcnt(0)" ::: "memory")
#define VM_WAIT() asm volatile("s_waitcnt vmcnt(0)" ::: "memory")

#define XB_TMO      128
#define XB_XCNT(j)  (256  + 64 * (j))
#define XB_XSUB(j)  (1280 + 64 * (j))
#define XB_XGEN(j)  (2304 + 64 * (j))
#define XB_TOP      3328
#define XB_TOPGEN   3392
#define XCD_BAR_WORDS 3456
#define XB_SPIN_CAP (1u << 22)

__device__ __forceinline__ unsigned xb_ld(unsigned* p)              { return __hip_atomic_load(p, __ATOMIC_RELAXED, __HIP_MEMORY_SCOPE_AGENT); }
__device__ __forceinline__ unsigned xb_add(unsigned* p, unsigned v) { return __hip_atomic_fetch_add(p, v, __ATOMIC_RELAXED, __HIP_MEMORY_SCOPE_AGENT); }
__device__ __forceinline__ unsigned xb_xcc_id() { return (unsigned)__builtin_amdgcn_s_getreg((3 << 11) | 20) & 0xFu; }
#define XB_SPIN(cond, bar) do { unsigned _sp = 0; while (cond) { __builtin_amdgcn_s_sleep(1); \
    if ((++_sp & 255u) == 0u) { if (xb_ld(&(bar)[XB_TMO])) break; if (_sp > XB_SPIN_CAP) { atomicAdd(&(bar)[XB_TMO], 1u); break; } } } } while (0)

struct XcdBarrier { unsigned* bar; unsigned x; volatile LAS unsigned* st; };

__device__ __forceinline__ XcdBarrier xcd_barrier_post(unsigned* bar, volatile LAS unsigned* st) {
    XcdBarrier b; b.bar = bar; b.x = xb_xcc_id(); b.st = st;
    if (threadIdx.x == 0) (void)xb_add(&bar[XB_XCNT(b.x)], 1u);
    return b;
}
__device__ __forceinline__ void xcd_barrier_complete(unsigned* bar, unsigned x, unsigned& nloc, unsigned& nx) {
    const unsigned G = gridDim.x * gridDim.y * gridDim.z;
    unsigned sum, cnt, mine, sp = 0u;
    for (;;) {
        sum = 0u; cnt = 0u; mine = 0u;
#pragma unroll
        for (unsigned j = 0; j < 16; ++j) { const unsigned c = xb_ld(&bar[XB_XCNT(j)]); sum += c; cnt += (c > 0u) ? 1u : 0u; mine = (j == x) ? c : mine; }
        if (sum == G) break;
        __builtin_amdgcn_s_sleep(1);
        if ((++sp & 255u) == 0u) { if (xb_ld(&bar[XB_TMO])) break; if (sp > XB_SPIN_CAP) { atomicAdd(&bar[XB_TMO], 1u); break; } }
    }
    nloc = mine > 0u ? mine : 1u; nx = cnt > 0u ? cnt : 1u;
}
__device__ __forceinline__ void xcd_barrier(const XcdBarrier& b) {
    asm volatile("s_waitcnt vmcnt(0)" ::: "memory");
    __syncthreads();
    if (threadIdx.x == 0) {
        unsigned* bar = b.bar;
        __builtin_amdgcn_s_waitcnt(0);
        unsigned nloc = b.st[0], nx = b.st[1];
        if (nloc == 0u) { xcd_barrier_complete(bar, b.x, nloc, nx); b.st[0] = nloc; b.st[1] = nx; }
        const unsigned old = xb_add(&bar[XB_XSUB(b.x)], 1u);
        const unsigned gen = old / nloc;
        if (old + 1u == (gen + 1u) * nloc) {
            __builtin_amdgcn_fence(__ATOMIC_RELEASE, "agent");
            asm volatile("s_waitcnt vmcnt(0)" ::: "memory");
            const unsigned og = xb_add(&bar[XB_TOP], 1u);
            const unsigned tg = og / nx;
            if (og + 1u == (tg + 1u) * nx) xb_add(&bar[XB_TOPGEN], 1u);
            else XB_SPIN(xb_ld(&bar[XB_TOPGEN]) == tg, bar);
            __builtin_amdgcn_fence(__ATOMIC_ACQUIRE, "agent");
            xb_add(&bar[XB_XGEN(b.x)], 1u);
            asm volatile("s_waitcnt vmcnt(0)" ::: "memory");
        } else {
            XB_SPIN(xb_ld(&bar[XB_XGEN(b.x)]) == gen, bar);
            __builtin_amdgcn_fence(__ATOMIC_ACQUIRE, "agent");
            asm volatile("s_waitcnt vmcnt(0)" ::: "memory");
        }
    }
    __syncthreads();
}

DI const float* resid_row(const float* H, const float* x, const float* meta, int m) {
    if (!x) return H + (size_t)m * D;
    const int b = m / L, t = m - b * L; return (t < NMETA) ? meta + (size_t)t * D : x + ((size_t)b * SEQ + (t - NMETA)) * D;
}
namespace pg8 {
constexpr int BM = 256, BK = 64, HALF = 128, HTB = HALF * BK * 2, STAGE_BYTES = 8 * HTB, NXCD = 8, WGM = 8;
__host__ __device__ __forceinline__ int lds_byte(int r, int c) { const int st = (r >> 4) * 2 + (c >> 5), rr = r & 15, cc = c & 31, ob = rr * 64 + cc * 2; return st * 1024 + (ob ^ (((ob >> 9) & 1) << 5)); }
__host__ __device__ __forceinline__ void stage_rc(int b, int& R, int& Cc) { const int st = b / 1024, sb = b % 1024, swz = sb ^ (((sb >> 9) & 1) << 5); R = (st >> 1) * 16 + swz / 64; Cc = (st & 1) * 32 + (swz % 64) / 2; }
__host__ __device__ __forceinline__ int perm32(int rho) { const int n = rho >> 4, i = rho & 15; return 8 * (i >> 2) + 4 * n + (i & 3); }

struct Unit { const char* A; const char* B; int pm, pn; };
struct Dims { int lda, ldb, nt; };

struct RectOrder {
    const char* A; const char* B; int lda, ldb; int nM, nN, nwg, G, c;
    __device__ void init(const void* A_, const void* B_, int lda_, int ldb_, int nM_, int nN_, int G_, int c_) { A = (const char*)A_; B = (const char*)B_; lda = lda_; ldb = ldb_; nM = nM_; nN = nN_; nwg = nM * nN; G = G_; c = c_; }
    __device__ bool next(int i, Unit& u) const {
        const long Lx = (long)i * G + c; if (Lx >= nwg) return false;
        int wgid = (int)Lx; { const int q = nwg / NXCD, r = nwg % NXCD, xcd = wgid % NXCD, off = wgid / NXCD; wgid = (xcd < r ? xcd * (q + 1) : r * (q + 1) + (xcd - r) * q) + off; }
        const int nig = WGM * nN, gid = wgid / nig, fm = gid * WGM, gsz = (nM - fm) < WGM ? (nM - fm) : WGM;
        u.pm = fm + ((wgid % nig) % gsz); u.pn = (wgid % nig) / gsz;
        u.A = A + (size_t)u.pm * BM * lda * 2; u.B = B + (size_t)u.pn * BM * ldb * 2; return true;
    }
};
template <class Epi, class Sched, bool ALIGN_EPI = true, bool SP2 = true>
__device__ __forceinline__ void gemm_phase(LAS unsigned char* lds, const Dims g, const Sched& S, const Epi& E) {
    int tid = threadIdx.x; asm volatile("" : "+v"(tid));
    const int wid = __builtin_amdgcn_readfirstlane(tid >> 6), lane = tid & 63, wr = wid >> 2, wc = wid & 3, fr = lane & 15, fq = lane >> 4;
    const int nt = g.nt;
    unsigned voffA[2], voffB[2];
#pragma unroll
    for (int i = 0; i < 2; ++i) { int R, Cc; stage_rc(tid * 16 + i * 8192, R, Cc); const int Rb = Epi::PERM ? ((R & ~31) + perm32(R & 31)) : R;
        voffA[i] = (unsigned)(R * g.lda + Cc) * 2u; voffB[i] = (unsigned)(Rb * g.ldb + Cc) * 2u; }
    const size_t kstep = (size_t)(BK * 2);
    const size_t hstepA = (size_t)HALF * g.lda * 2, hstepB = (size_t)HALF * g.ldb * 2;
    const unsigned ldsw = (unsigned)wid * 1024u;
    const int aoff = lds_byte(wr * 64 + fr, fq * 8), boff = lds_byte(wc * 32 + fr, fq * 8);
#define PG8_SA(b, h) (((b) * 2 + (h)) * HTB)
#define PG8_SB(b, h) ((4 + (b) * 2 + (h)) * HTB)
#define PG8_STAGE(bufoff, gbase, voff) do { _Pragma("unroll") for (int _i = 0; _i < 2; ++_i) \
        __builtin_amdgcn_global_load_lds((const unsigned*)((const char*)(gbase) + (voff)[_i]), (LAS unsigned*)(lds + (bufoff) + ldsw + _i * 8192), 16, 0, 0); } while (0)
#define PG8_LDA(dst, b, h) do { _Pragma("unroll") for (int m = 0; m < 4; ++m) _Pragma("unroll") for (int k = 0; k < 2; ++k) dst[m][k] = *(const LAS bf16x8*)(lds + PG8_SA(b, h) + aoff + m * 2048 + k * 1024); } while (0)
#define PG8_LDB(dst, b, h) do { _Pragma("unroll") for (int n = 0; n < 2; ++n) _Pragma("unroll") for (int k = 0; k < 2; ++k) dst[n][k] = *(const LAS bf16x8*)(lds + PG8_SB(b, h) + boff + n * 2048 + k * 1024); } while (0)
#define PG8_MMA(ai, bj, At, Bt) do { __builtin_amdgcn_s_setprio(1); _Pragma("unroll") for (int m = 0; m < 4; ++m) _Pragma("unroll") for (int n = 0; n < 2; ++n) _Pragma("unroll") for (int k = 0; k < 2; ++k) \
        acc[ai][bj][m][n] = __builtin_amdgcn_mfma_f32_16x16x32_bf16(Bt[n][k], At[m][k], acc[ai][bj][m][n], 0, 0, 0); __builtin_amdgcn_s_setprio(0); } while (0)
#define PG8_WAIT_V(n) asm volatile("s_waitcnt vmcnt(" #n ")" ::: "memory")
#define PG8_WAIT_L(n) asm volatile("s_waitcnt lgkmcnt(" #n ")" ::: "memory")
#define PG8_BAR __builtin_amdgcn_s_barrier()
#define PG8_SCHED __builtin_amdgcn_sched_barrier(0)
    Unit cur, nxt; int ui = 0;
    if (!S.next(0, cur)) return;
    f32x4 acc[2][2][4][2];
#pragma unroll
    for (int a = 0; a < 2; ++a)
#pragma unroll
        for (int b = 0; b < 2; ++b)
#pragma unroll
            for (int m = 0; m < 4; ++m)
#pragma unroll
                for (int n = 0; n < 2; ++n) acc[a][b][m][n] = (f32x4){0.f, 0.f, 0.f, 0.f};
    bf16x8 At[4][2], B0[2][2], B1[2][2];
    const char* cA = cur.A; const char* cB = cur.B;
    if constexpr (SP2) {
        PG8_STAGE(PG8_SB(0, 0), cB, voffB); PG8_STAGE(PG8_SB(0, 1), cB + hstepB, voffB); PG8_STAGE(PG8_SA(0, 0), cA, voffA); PG8_STAGE(PG8_SA(0, 1), cA + hstepA, voffA);
        if (wr == 1) PG8_BAR;
        PG8_WAIT_V(2); PG8_BAR;
        PG8_STAGE(PG8_SB(1, 0), cB + kstep, voffB); PG8_STAGE(PG8_SA(1, 0), cA + kstep, voffA); PG8_STAGE(PG8_SB(1, 1), cB + hstepB + kstep, voffB);
        PG8_WAIT_V(6); PG8_BAR;
    } else {
        PG8_STAGE(PG8_SB(0, 0), cB, voffB); PG8_STAGE(PG8_SA(0, 0), cA, voffA); PG8_STAGE(PG8_SB(0, 1), cB + hstepB, voffB); PG8_STAGE(PG8_SA(0, 1), cA + hstepA, voffA);
        if (wr == 1) PG8_BAR;
        PG8_WAIT_V(4); PG8_BAR;
        PG8_STAGE(PG8_SB(1, 0), cB + kstep, voffB); PG8_STAGE(PG8_SA(1, 0), cA + kstep, voffA); PG8_STAGE(PG8_SB(1, 1), cB + hstepB + kstep, voffB);
        PG8_WAIT_V(6); PG8_BAR;
    }
    for (;;) {
        const bool has_next = S.next(ui + 1, nxt);
        const char* nA = has_next ? nxt.A : cA; const char* nB = has_next ? nxt.B : cB;
        for (int t = 0; t < nt; t += 2) {
            const bool last = (t == nt - 2);
            const char* a1 = cA + (size_t)(t + 1) * kstep;
            const char* a2 = last ? nA : cA + (size_t)(t + 2) * kstep; const char* b2 = last ? nB : cB + (size_t)(t + 2) * kstep;
            const char* a3 = a2 + kstep; const char* b3 = b2 + kstep;
            if constexpr (SP2) {
            PG8_LDB(B0, 0, 0); PG8_LDB(B1, 0, 1); PG8_SCHED; PG8_LDA(At, 0, 0); PG8_STAGE(PG8_SA(1, 1), a1 + hstepA, voffA);
            PG8_WAIT_V(8); PG8_WAIT_L(0); PG8_BAR; PG8_MMA(0, 0, At, B0); PG8_MMA(0, 1, At, B1); PG8_BAR; PG8_SCHED;
            PG8_LDA(At, 0, 1); PG8_STAGE(PG8_SB(0, 0), b2, voffB); PG8_STAGE(PG8_SB(0, 1), b2 + hstepB, voffB); PG8_STAGE(PG8_SA(0, 0), a2, voffA);
            PG8_WAIT_V(8); PG8_WAIT_L(0); PG8_BAR; PG8_MMA(1, 0, At, B0); PG8_MMA(1, 1, At, B1); PG8_BAR; PG8_SCHED;
            PG8_LDB(B0, 1, 0); PG8_LDB(B1, 1, 1); PG8_SCHED; PG8_LDA(At, 1, 0); PG8_STAGE(PG8_SA(0, 1), a2 + hstepA, voffA);
            PG8_WAIT_V(8); PG8_WAIT_L(0); PG8_BAR; PG8_MMA(0, 0, At, B0); PG8_MMA(0, 1, At, B1); PG8_BAR; PG8_SCHED;
            PG8_LDA(At, 1, 1); PG8_STAGE(PG8_SB(1, 0), b3, voffB); PG8_STAGE(PG8_SB(1, 1), b3 + hstepB, voffB); PG8_STAGE(PG8_SA(1, 0), a3, voffA);
            PG8_WAIT_V(8); PG8_WAIT_L(0); PG8_BAR; PG8_MMA(1, 0, At, B0); PG8_MMA(1, 1, At, B1); PG8_BAR; PG8_SCHED;
            } else {
            PG8_LDB(B0, 0, 0); PG8_SCHED; PG8_LDA(At, 0, 0); PG8_STAGE(PG8_SA(1, 1), a1 + hstepA, voffA);
            PG8_WAIT_L(8); PG8_BAR; PG8_WAIT_L(0); PG8_MMA(0, 0, At, B0); PG8_BAR; PG8_SCHED;
            PG8_LDB(B1, 0, 1); PG8_STAGE(PG8_SB(0, 0), b2, voffB);
            PG8_BAR; PG8_WAIT_L(0); PG8_MMA(0, 1, At, B1); PG8_BAR;
            PG8_LDA(At, 0, 1); PG8_STAGE(PG8_SA(0, 0), a2, voffA);
            PG8_BAR; PG8_WAIT_L(0); PG8_MMA(1, 0, At, B0); PG8_BAR; PG8_SCHED;
            PG8_STAGE(PG8_SB(0, 1), b2 + hstepB, voffB);
            PG8_WAIT_V(6); PG8_BAR; PG8_MMA(1, 1, At, B1); PG8_BAR;
            PG8_LDB(B0, 1, 0); PG8_SCHED; PG8_LDA(At, 1, 0); PG8_STAGE(PG8_SA(0, 1), a2 + hstepA, voffA);
            PG8_WAIT_L(8); PG8_BAR; PG8_WAIT_L(0); PG8_MMA(0, 0, At, B0); PG8_BAR; PG8_SCHED;
            PG8_LDB(B1, 1, 1); PG8_STAGE(PG8_SB(1, 0), b3, voffB);
            PG8_BAR; PG8_WAIT_L(0); PG8_MMA(0, 1, At, B1); PG8_BAR;
            PG8_LDA(At, 1, 1); PG8_STAGE(PG8_SA(1, 0), a3, voffA);
            PG8_BAR; PG8_WAIT_L(0); PG8_MMA(1, 0, At, B0); PG8_BAR; PG8_SCHED;
            PG8_STAGE(PG8_SB(1, 1), b3 + hstepB, voffB);
            PG8_WAIT_V(6); PG8_BAR; PG8_MMA(1, 1, At, B1); PG8_BAR;
            }
        }
        if constexpr (ALIGN_EPI) { if (wr == 0) PG8_BAR; }
        E(acc, cur, wr, wc, fr, fq);
        if (!has_next) break;
#pragma unroll
        for (int a = 0; a < 2; ++a)
#pragma unroll
            for (int b = 0; b < 2; ++b)
#pragma unroll
                for (int m = 0; m < 4; ++m)
#pragma unroll
                    for (int n = 0; n < 2; ++n) acc[a][b][m][n] = (f32x4){0.f, 0.f, 0.f, 0.f};
        cur = nxt; cA = nA; cB = nB; ++ui;
        if constexpr (ALIGN_EPI) { if (wr == 1) PG8_BAR; }
    }
    PG8_WAIT_V(0);
    if constexpr (!ALIGN_EPI) { if (wr == 0) PG8_BAR; }
    PG8_BAR;
#undef PG8_SA
#undef PG8_SB
#undef PG8_STAGE
#undef PG8_LDA
#undef PG8_LDB
#undef PG8_MMA
#undef PG8_WAIT_V
#undef PG8_WAIT_L
#undef PG8_BAR
#undef PG8_SCHED
}

struct EpiBf16 {
    static constexpr bool PERM = true;
    bf16* O; int ldc; const float* bias;
    DI void operator()(const f32x4 (&acc)[2][2][4][2], const Unit& u, int wr, int wc, int fr, int fq) const {
        const int row0 = u.pm * BM + wr * 64 + fr, col0 = u.pn * BM + wc * 32 + 8 * fq;
        f32x4 bv[2][2];
#pragma unroll
        for (int bj = 0; bj < 2; ++bj)
#pragma unroll
            for (int n = 0; n < 2; ++n) bv[bj][n] = bias ? *(const f32x4*)(bias + col0 + bj * HALF + 4 * n) : (f32x4){0.f, 0.f, 0.f, 0.f};
#pragma unroll
        for (int ai = 0; ai < 2; ++ai)
#pragma unroll
            for (int m = 0; m < 4; ++m) { bf16* rowp = O + (size_t)(row0 + ai * HALF + m * 16) * ldc + col0;
#pragma unroll
                for (int bj = 0; bj < 2; ++bj) { const f32x4 v0 = acc[ai][bj][m][0] + bv[bj][0], v1 = acc[ai][bj][m][1] + bv[bj][1];
                    u32x4 w; w.x = pk2(v0[0], v0[1]); w.y = pk2(v0[2], v0[3]); w.z = pk2(v1[0], v1[1]); w.w = pk2(v1[2], v1[3]);
                    *(u32x4*)(rowp + bj * HALF) = w; } }
    }
};
struct EpiGate {
    static constexpr bool PERM = true;
    bf16* O; const bf16* Zg; int goff; const bf16* add;
    DI void operator()(const f32x4 (&acc)[2][2][4][2], const Unit& u, int wr, int wc, int fr, int fq) const {
        const int row0 = u.pm * BM + wr * 64 + fr, col0 = u.pn * BM + wc * 32 + 8 * fq;
#pragma unroll
        for (int ai = 0; ai < 2; ++ai)
#pragma unroll
            for (int m = 0; m < 4; ++m) { const size_t row = (size_t)(row0 + ai * HALF + m * 16);
#pragma unroll
                for (int bj = 0; bj < 2; ++bj) {
                    const int col = col0 + bj * HALF;
                    const u32x4 gz = *(const u32x4*)(Zg + row * NZ + goff + col);
                    float a[8] = {0.f, 0.f, 0.f, 0.f, 0.f, 0.f, 0.f, 0.f};
                    if (add) { const u32x4 t = *(const u32x4*)(add + row * D + col); a[0] = bflo(t.x); a[1] = bfhi(t.x); a[2] = bflo(t.y); a[3] = bfhi(t.y); a[4] = bflo(t.z); a[5] = bfhi(t.z); a[6] = bflo(t.w); a[7] = bfhi(t.w); }
                    const f32x4 v0 = acc[ai][bj][m][0], v1 = acc[ai][bj][m][1];
                    float o[8];
                    o[0] = a[0] + sigmoidf_(bflo(gz.x)) * v0[0]; o[1] = a[1] + sigmoidf_(bfhi(gz.x)) * v0[1];
                    o[2] = a[2] + sigmoidf_(bflo(gz.y)) * v0[2]; o[3] = a[3] + sigmoidf_(bfhi(gz.y)) * v0[3];
                    o[4] = a[4] + sigmoidf_(bflo(gz.z)) * v1[0]; o[5] = a[5] + sigmoidf_(bfhi(gz.z)) * v1[1];
                    o[6] = a[6] + sigmoidf_(bflo(gz.w)) * v1[2]; o[7] = a[7] + sigmoidf_(bfhi(gz.w)) * v1[3];
                    u32x4 w; w.x = pk2(o[0], o[1]); w.y = pk2(o[2], o[3]); w.z = pk2(o[4], o[5]); w.w = pk2(o[6], o[7]);
                    *(u32x4*)(O + row * D + col) = w; } }
    }
};
struct EpiResAdd {
    static constexpr bool PERM = false;
    float* H; const float* x; const float* meta;
    DI void operator()(const f32x4 (&acc)[2][2][4][2], const Unit& u, int wr, int wc, int fr, int fq) const {
        const int row0 = u.pm * BM + wr * 64 + fr, col0 = u.pn * BM + wc * 32 + 4 * fq;
#pragma unroll
        for (int ai = 0; ai < 2; ++ai)
#pragma unroll
            for (int m = 0; m < 4; ++m) { const int row = row0 + ai * HALF + m * 16; float* rowp = H + (size_t)row * D + col0; const float* srcp = resid_row(H, x, meta, row) + col0;
#pragma unroll
                for (int bj = 0; bj < 2; ++bj)
#pragma unroll
                    for (int n = 0; n < 2; ++n) { *(f32x4*)(rowp + bj * HALF + n * 16) = *(const f32x4*)(srcp + bj * HALF + n * 16) + acc[ai][bj][m][n]; } }
    }
};
}

struct SkZ    { bf16* Z; const float* bias; DI void operator()(int row, int col, f32x4 v) const { v = v + *(const f32x4*)(bias + col); *(u32x2*)(Z + (size_t)row * NZ + col) = (u32x2){pk2(v[0], v[1]), pk2(v[2], v[3])}; } };
struct SkGate { bf16* O; const bf16* Zg; int goff; const bf16* add;
    DI void operator()(int row, int col, f32x4 v) const { const u32x2 gz = *(const u32x2*)(Zg + (size_t)row * NZ + goff + col); float a0 = 0.f, a1 = 0.f, a2 = 0.f, a3 = 0.f;
        if (add) { const u32x2 t = *(const u32x2*)(add + (size_t)row * D + col); a0 = bflo(t.x); a1 = bfhi(t.x); a2 = bflo(t.y); a3 = bfhi(t.y); }
        *(u32x2*)(O + (size_t)row * D + col) = (u32x2){pk2(a0 + sigmoidf_(bflo(gz.x)) * v[0], a1 + sigmoidf_(bfhi(gz.x)) * v[1]), pk2(a2 + sigmoidf_(bflo(gz.y)) * v[2], a3 + sigmoidf_(bfhi(gz.y)) * v[3])}; } };
struct SkRes  { float* H; const float* x; const float* meta; DI void operator()(int row, int col, f32x4 v) const { *(f32x4*)(H + (size_t)row * D + col) = *(const f32x4*)(resid_row(H, x, meta, row) + col) + v; } };
template <class Epi>
DI void skinny64(const bf16* A, int lda, const bf16* Bt, int ldb, int N, int K, int r0, LAS unsigned char* lds, const Epi& epi, int wave, int lane, int bid, int G) {
    const int n16 = lane & 15, q = lane >> 4; const int ksw = (K / 32) / 8;
    LAS f32x4* red = (LAS f32x4*)lds;
    for (int nt = bid; nt < N / 16; nt += G) {
        f32x4 acc[4];
#pragma unroll
        for (int mt = 0; mt < 4; ++mt) acc[mt] = (f32x4){0.f, 0.f, 0.f, 0.f};
        const bf16* wp = Bt + (size_t)(16 * nt + n16) * ldb + 8 * q + wave * ksw * 32; const bf16* ap = A + (size_t)(r0 + n16) * lda + 8 * q + wave * ksw * 32;
#pragma unroll 8
        for (int ks = 0; ks < ksw; ++ks) { const bf16x8 wf = *(const bf16x8*)(wp + ks * 32);
#pragma unroll
            for (int mt = 0; mt < 4; ++mt) acc[mt] = __builtin_amdgcn_mfma_f32_16x16x32_bf16(wf, *(const bf16x8*)(ap + (size_t)(16 * mt) * lda + ks * 32), acc[mt], 0, 0, 0); }
        __syncthreads();
#pragma unroll
        for (int mt = 0; mt < 4; ++mt) red[(wave * 4 + mt) * 64 + lane] = acc[mt];
        __syncthreads();
        if (wave < 4) { f32x4 s = red[wave * 64 + lane];
#pragma unroll
            for (int w = 1; w < 8; ++w) s = s + red[(w * 4 + wave) * 64 + lane];
            epi(r0 + 16 * wave + n16, 16 * nt + 4 * q, s); }
    }
    __syncthreads();
}

struct ArgsV { const float* in[33]; float* out; unsigned char* ws; int ph_lo, ph_hi; };
#define CAS __attribute__((address_space(4)))
typedef const CAS ArgsV* ArgsP;
struct Args { ArgsP p; GAS unsigned char* ws; GAS float* out; DI const float* inp(int i) const { return (const float*)(const GAS float*)p->in[i]; } };
enum InIdx { I_X = 0, I_META, I_NORM_MIX, I_W_IN, I_B_QKV, I_SINKS, I_MU, I_W0, I_DEC_UP, I_A0, I_ICLR_UP, I_GATE_UP, I_KK, I_KA, I_RK, I_LNW, I_LNB,
             I_VDOWN, I_VMU, I_V0, I_VUP, I_WBA, I_WBR, I_WOUT, I_NORM_FFN, I_WCOARSE, I_BCOARSE, I_WFINE, I_BFINE, I_WEG, I_WEU, I_WED, I_NORM_FINAL };

DI void tr_item(const float* W, int ldw, int K, int N, bf16* WT, int ldt, int kb, int nb, LAS float* scr, int lane) {
    (void)scr;
    const int k0 = 64 * kb + 8 * (lane >> 3), n0 = 32 * nb + 4 * (lane & 7);
    f32x4 v[8];
#pragma unroll
    for (int r = 0; r < 8; ++r) v[r] = (n0 < N && k0 + r < K) ? *(const f32x4*)(W + (size_t)(k0 + r) * ldw + n0) : (f32x4){0.f, 0.f, 0.f, 0.f};
    if (k0 < K && n0 < N) {
#pragma unroll
        for (int i = 0; i < 4; ++i) {
            u32x4 o; o.x = pk2(v[0][i], v[1][i]); o.y = pk2(v[2][i], v[3][i]); o.z = pk2(v[4][i], v[5][i]); o.w = pk2(v[6][i], v[7][i]);
            *(u32x4*)(WT + (size_t)(n0 + i) * ldt + k0) = o; } }
}

struct TrDesc { const float* W; bf16* WT; int ldw, K, N, ldt, kb, nb; };
DI void tr_load(const TrDesc& d, f32x4 (&v)[8], int lane) {
    const int k0 = 64 * d.kb + 8 * (lane >> 3), n0 = 32 * d.nb + 4 * (lane & 7);
#pragma unroll
    for (int r = 0; r < 8; ++r) v[r] = (n0 < d.N && k0 + r < d.K) ? *(const f32x4*)(d.W + (size_t)(k0 + r) * d.ldw + n0) : (f32x4){0.f, 0.f, 0.f, 0.f};
}
DI void tr_store(const TrDesc& d, const f32x4 (&v)[8], int lane) {
    const int k0 = 64 * d.kb + 8 * (lane >> 3), n0 = 32 * d.nb + 4 * (lane & 7);
    if (k0 < d.K && n0 < d.N) {
#pragma unroll
        for (int i = 0; i < 4; ++i) {
            u32x4 o; o.x = pk2(v[0][i], v[1][i]); o.y = pk2(v[2][i], v[3][i]); o.z = pk2(v[4][i], v[5][i]); o.w = pk2(v[6][i], v[7][i]);
            *(u32x4*)(d.WT + (size_t)(n0 + i) * d.ldt + k0) = o; } }
}
template <int GRP>
DI TrDesc tr_decode(const Args& a, int l, int r) {
    unsigned char* ws = (unsigned char*)a.ws;
    constexpr int NB_IN = NIN / 32;
    constexpr int J1 = 32 * NB_IN, J3 = 16 * 64, J5 = 32 * 64, J9 = 32 * 2, J10 = 32, J11 = 32, J2 = 32;
    if (GRP == 1) {
        if (r < J3) return TrDesc{a.inp(I_WBA) + (size_t)l * C * D, (bf16*)(ws + WS_WAT) + (size_t)l * D * C, D, C, D, C, r / 64, r % 64}; r -= J3;
        if (r < J3) return TrDesc{a.inp(I_WBR) + (size_t)l * C * D, (bf16*)(ws + WS_WRT) + (size_t)l * D * C, D, C, D, C, r / 64, r % 64}; r -= J3;
        if (r < J5) return TrDesc{a.inp(I_WOUT) + (size_t)l * D * D, (bf16*)(ws + WS_WOT) + (size_t)l * D * D, D, D, D, D, r / 64, r % 64}; r -= J5;
        if (r < J9) return TrDesc{a.inp(I_WFINE) + (size_t)l * D * 64, (bf16*)(ws + WS_WRO) + (size_t)l * 80 * D + (size_t)8 * D, 64, D, 64, D, r / 2, r % 2}; r -= J9;
        return TrDesc{a.inp(I_WCOARSE) + (size_t)l * D * 8, (bf16*)(ws + WS_WRO) + (size_t)l * 80 * D, 8, D, 8, D, r, 0};
    }
    if (r < J1) return TrDesc{a.inp(I_W_IN) + (size_t)l * D * NIN, (bf16*)(ws + WS_W1T) + (size_t)l * NZ * D, NIN, D, NIN, D, r / NB_IN, r % NB_IN}; r -= J1;
    if (r < J11) return TrDesc{a.inp(I_DEC_UP) + (size_t)l * 64 * C, (bf16*)(ws + WS_LDEC) + (size_t)l * C * 64, C, 64, C, 64, 0, r}; r -= J11;
    if (r < J11) return TrDesc{a.inp(I_ICLR_UP) + (size_t)l * 64 * C, (bf16*)(ws + WS_LICL) + (size_t)l * C * 64, C, 64, C, 64, 0, r}; r -= J11;
    if (r < J11 || GRP != 2) return TrDesc{a.inp(I_GATE_UP) + (size_t)l * 64 * C, (bf16*)(ws + WS_LGAT) + (size_t)l * C * 64, C, 64, C, 64, 0, r}; r -= J11;
    if (r < J2) return TrDesc{a.inp(I_VDOWN), (bf16*)(ws + WS_W1T) + (size_t)NZ * D + (size_t)ZVD * D, 32, D, 32, D, r, 0}; r -= J2;
    return TrDesc{a.inp(I_VUP), (bf16*)(ws + WS_LVUP), C, 32, C, 32, 0, r};
}
template <int GRP>
DI void phase_convert(const Args& a, int l, LAS unsigned char* lds, int gw, int NGW, int wave, int lane) {
    unsigned char* ws = (unsigned char*)a.ws; (void)lds; (void)wave;
    constexpr int NB_IN = NIN / 32;
    constexpr int NITEMS = (GRP == 1) ? 2 * 16 * 64 + 32 * 64 + 32 * 2 + 32 : 32 * NB_IN + 3 * 32 + (GRP == 2 ? 32 + 32 : 0);
    for (int it = gw; it < NITEMS; it += 2 * NGW) {
        const bool two = it + NGW < NITEMS;
        const TrDesc d0 = tr_decode<GRP>(a, l, it), d1 = tr_decode<GRP>(a, l, two ? it + NGW : it);
        f32x4 v0[8], v1[8];
        tr_load(d0, v0, lane); tr_load(d1, v1, lane);
        tr_store(d0, v0, lane); if (two) tr_store(d1, v1, lane);
    }
    if (GRP != 2) return;
    const size_t gt = (size_t)gw * 64 + lane, NGT = (size_t)NGW * 64;
    { unsigned* U = (unsigned*)(ws + WS_U);
      for (size_t i = gt; i < (size_t)(TP - T) * (D / 2); i += NGT) U[(size_t)T * (D / 2) + i] = 0u; }
    { float* bias = (float*)(ws + WS_BIAS);
      for (size_t i = gt; i < (size_t)2 * NZ; i += NGT) { const int l = (int)(i / NZ), c = (int)(i % NZ); bias[i] = (c < 1536) ? a.inp(I_B_QKV)[l * 1536 + c] : 0.f; } }
    { float* rope = (float*)(ws + WS_ROPE);
      for (size_t i = gt; i < (size_t)L * 8; i += NGT) { const int t = (int)(i / 8), k = (int)(i % 8);
          const float invf = (float)exp2(-(double)k * 0.125 * 18.931568569324174  );
          const float ang = (float)t * invf;
          const double rev = (double)ang * 0.15915494309189535; const float fr = (float)(rev - floor(rev));
          rope[i * 2 + 0] = __builtin_amdgcn_cosf(fr); rope[i * 2 + 1] = __builtin_amdgcn_sinf(fr); } }
    { unsigned* wro = (unsigned*)(ws + WS_WRO);
      for (size_t i = gt; i < (size_t)2 * 8 * (D / 2); i += NGT) { const int l = (int)(i / (8 * (D / 2))), rr = (int)(i % (8 * (D / 2))); wro[(size_t)l * 80 * (D / 2) + (size_t)72 * (D / 2) + rr] = 0u; } }
}

DI void moe_tables(const unsigned* cnt, LAS int* lc, int tid) {
    __syncthreads();
    if (tid < 64) {
        const int c = (int)__hip_atomic_load(cnt + tid * 16, RLX_AGENT); const int pad = (c + 15) & ~15; int inc = pad;
#pragma unroll
        for (int o = 1; o < 64; o <<= 1) { const int v = __shfl_up(inc, o); if (tid >= o) inc += v; }
        lc[LC_PSTART / 4 + tid] = inc - pad; lc[LC_CNT / 4 + tid] = c; }
    __syncthreads();
}
template <int MODE>
DI void phase_norm(const Args& a, const float* gain, bool comb, int lprev, LAS unsigned char* lds, int tid, int gw, int NGW, int lane, const float* x0 = nullptr, const float* meta0 = nullptr) {
    unsigned char* ws = (unsigned char*)a.ws; float* H = (float*)(ws + WS_H); bf16* U = (bf16*)(ws + WS_U);
    const bf16* YR = (const bf16*)(ws + WS_YR); const int* toke = (const int*)(ws + WS_TOKE); const int* toks = (const int*)(ws + WS_TOKS); const float* tokw = (const float*)(ws + WS_TOKW);
    LAS int* lc = (LAS int*)(lds + LDSCTL_OFF);
    if (comb) moe_tables((const unsigned*)(ws + WS_CTL) + CW_CNT + lprev * 64 * 16, lc, tid);
    f32x4 g[8];
#pragma unroll
    for (int j = 0; j < 8; ++j) g[j] = *(const f32x4*)(gain + lane * 4 + 256 * j);
    for (int m = gw; m < T; m += 2 * NGW) {
        const int mm[2] = {m, (m + NGW < T) ? m + NGW : m}; const bool two = m + NGW < T;
        f32x4 v[2][8];
#pragma unroll
        for (int rr = 0; rr < 2; ++rr)
#pragma unroll
            for (int j = 0; j < 8; ++j) v[rr][j] = *(const f32x4*)(resid_row(H, x0, meta0, mm[rr]) + lane * 4 + 256 * j);
        if (comb) {
            int p[2][2]; float w[2][2];
#pragma unroll
            for (int rr = 0; rr < 2; ++rr)
#pragma unroll
                for (int k = 0; k < 2; ++k) { p[rr][k] = lc[LC_PSTART / 4 + toke[2 * mm[rr] + k]] + toks[2 * mm[rr] + k]; w[rr][k] = tokw[2 * mm[rr] + k]; }
            u32x2 y[2][2][8];
#pragma unroll
            for (int rr = 0; rr < 2; ++rr)
#pragma unroll
                for (int k = 0; k < 2; ++k)
#pragma unroll
                    for (int j = 0; j < 8; ++j) y[rr][k][j] = *(const u32x2*)(YR + (size_t)p[rr][k] * D + lane * 4 + 256 * j);
#pragma unroll
            for (int rr = 0; rr < 2; ++rr)
#pragma unroll
                for (int j = 0; j < 8; ++j) { const u32x2 a0 = y[rr][0][j], a1 = y[rr][1][j]; const float w0 = w[rr][0], w1 = w[rr][1];
                    v[rr][j][0] += w0 * bflo(a0.x) + w1 * bflo(a1.x); v[rr][j][1] += w0 * bfhi(a0.x) + w1 * bfhi(a1.x);
                    v[rr][j][2] += w0 * bflo(a0.y) + w1 * bflo(a1.y); v[rr][j][3] += w0 * bfhi(a0.y) + w1 * bfhi(a1.y);
                    if (MODE == 0 && (rr == 0 || two)) *(f32x4*)(H + (size_t)mm[rr] * D + lane * 4 + 256 * j) = v[rr][j]; }
        }
#pragma unroll
        for (int rr = 0; rr < 2; ++rr) {
            if (rr == 1 && !two) break;
            float ss = 0.f;
#pragma unroll
            for (int j = 0; j < 8; ++j) ss += (v[rr][j][0] * v[rr][j][0] + v[rr][j][1] * v[rr][j][1]) + (v[rr][j][2] * v[rr][j][2] + v[rr][j][3] * v[rr][j][3]);
            float rstd = rsqrtf(wave_sum(ss) * (1.f / D) + NORM_EPS);
#if defined(CHUNK_TEST)
            if (MODE == 1 && ((const unsigned*)(ws + WS_CTL))[40000] != 0u) rstd = __builtin_nanf("");
#endif
            if (MODE == 0) {
                bf16* ur = U + (size_t)mm[rr] * D + lane * 4;
#pragma unroll
                for (int j = 0; j < 8; ++j) { const f32x4 o = v[rr][j] * rstd * g[j]; u32x2 wv; wv.x = pk2(o[0], o[1]); wv.y = pk2(o[2], o[3]); *(u32x2*)(ur + 256 * j) = wv; }
            } else {
                const int b = mm[rr] / L, t = mm[rr] % L;
                if (t >= NMETA) { float* orow = (float*)a.out + ((size_t)b * SEQ + (t - NMETA)) * D + lane * 4;
#pragma unroll
                    for (int j = 0; j < 8; ++j) *(f32x4*)(orow + 256 * j) = v[rr][j] * rstd * g[j]; }
            }
        }
    }
}

DI void phase_rope(const Args& a, int gw, int NGW, int lane) {
    unsigned char* ws = (unsigned char*)a.ws; bf16* Z = (bf16*)(ws + WS_Z); const float* rope = (const float*)(ws + WS_ROPE);
    const int r = lane / 20, hs = lane % 20; const int cb = (hs < 16) ? ZQ + hs * 64 : ZK + (hs - 16) * 64;
    for (int m0 = 3 * gw; m0 < T; m0 += 3 * NGW) { const int m = m0 + r;
        if (lane < 60 && m < T) { const int t = m % L; bf16* zp = Z + (size_t)m * NZ + cb;
            const u32x4 a1 = *(const u32x4*)zp, a2 = *(const u32x4*)(zp + 8);
            const f32x4* rt = (const f32x4*)(rope + (size_t)t * 16);
            unsigned o1[4], o2[4];
#pragma unroll
            for (int w = 0; w < 4; ++w) { const f32x4 cs = rt[w];
                const unsigned w1 = (w == 0) ? a1.x : (w == 1) ? a1.y : (w == 2) ? a1.z : a1.w, w2 = (w == 0) ? a2.x : (w == 1) ? a2.y : (w == 2) ? a2.z : a2.w;
                const float x1a = bflo(w1), x1b = bfhi(w1), x2a = bflo(w2), x2b = bfhi(w2);
                o1[w] = pk2(x1a * cs[0] - x2a * cs[1], x1b * cs[2] - x2b * cs[3]); o2[w] = pk2(x2a * cs[0] + x1a * cs[1], x2b * cs[2] + x1b * cs[3]); }
            *(u32x4*)zp = (u32x4){o1[0], o1[1], o1[2], o1[3]}; *(u32x4*)(zp + 8) = (u32x4){o2[0], o2[1], o2[2], o2[3]}; } }
}
DI void phase_vt(const Args& a, int gw, int NGW, int lane) {
    unsigned char* ws = (unsigned char*)a.ws; const bf16* Z = (const bf16*)(ws + WS_Z); bf16* VT = (bf16*)(ws + WS_VT);
    const int tgl = lane >> 3, cgl = lane & 7; constexpr int NTG = (LPAD + 63) / 64;
    for (int u = gw; u < NB * NTG * 4; u += NGW) { const int kvh = u & 3, tg8 = (u >> 2) % NTG, b = (u >> 2) / NTG; const int t0 = 64 * tg8 + 8 * tgl;
        u32x4 x[8];
#pragma unroll
        for (int j = 0; j < 8; ++j) { const int t = t0 + j; x[j] = (t < L) ? *(const u32x4*)(Z + (size_t)(b * L + t) * NZ + ZV + kvh * 64 + 8 * cgl) : (u32x4){0u, 0u, 0u, 0u}; }
        if (t0 < LPAD) {
#pragma unroll
            for (int ch = 0; ch < 8; ++ch) { unsigned o[4];
#pragma unroll
                for (int w = 0; w < 4; ++w) { const unsigned lo = (ch >> 1) == 0 ? x[2 * w].x : (ch >> 1) == 1 ? x[2 * w].y : (ch >> 1) == 2 ? x[2 * w].z : x[2 * w].w;
                    const unsigned hi = (ch >> 1) == 0 ? x[2 * w + 1].x : (ch >> 1) == 1 ? x[2 * w + 1].y : (ch >> 1) == 2 ? x[2 * w + 1].z : x[2 * w + 1].w;
                    o[w] = (ch & 1) ? ((lo >> 16) | (hi & 0xffff0000u)) : ((lo & 0xffffu) | (hi << 16)); }
                *(u32x4*)(VT + ((size_t)(b * 4 + kvh) * HD + 8 * cgl + ch) * LPAD + t0) = (u32x4){o[0], o[1], o[2], o[3]}; } }
    }
}
template <int MODE> DI bf16x8 lora_in8(const u32x4 c, const u32x4 p, const f32x4 m0, const f32x4 m1) {
    float o[8];
#pragma unroll
    for (int j = 0; j < 8; ++j) { const unsigned cw = (j < 2) ? c.x : (j < 4) ? c.y : (j < 6) ? c.z : c.w, pw = (j < 2) ? p.x : (j < 4) ? p.y : (j < 6) ? p.z : p.w;
        const float cv = (j & 1) ? bfhi(cw) : bflo(cw), pv = (j & 1) ? bfhi(pw) : bflo(pw); const float mm = (j < 4) ? m0[j & 3] : m1[j & 3];
        const float zs = cv + (pv - cv) * mm;
        if (MODE == 0) { const float e = __expf(2.f * zs); o[j] = 1.f - 2.f / (e + 1.f); } else if (MODE == 1) o[j] = zs; else o[j] = sigmoidf_(zs); }
    u32x4 w; w.x = pk2(o[0], o[1]); w.y = pk2(o[2], o[3]); w.z = pk2(o[4], o[5]); w.w = pk2(o[6], o[7]);
    return __builtin_bit_cast(bf16x8, w);
}
DI void phase_rwkvprep(const Args& a, int l, LAS unsigned char* lds, int tid, int gw, int NGW, int lane) {
    unsigned char* ws = (unsigned char*)a.ws; const bf16* Z = (const bf16*)(ws + WS_Z);
    const float* mu = a.inp(I_MU) + (size_t)l * 3264; const float* vmu = a.inp(I_VMU);
    const bf16* WdT = (const bf16*)(ws + WS_LDEC) + (size_t)l * C * 64; const bf16* WiT = (const bf16*)(ws + WS_LICL) + (size_t)l * C * 64; const bf16* WgT = (const bf16*)(ws + WS_LGAT) + (size_t)l * C * 64;
    const bf16* WvT = (const bf16*)(ws + WS_LVUP);
    bf16* Rr = (bf16*)(ws + WS_R); float* Ww = (float*)(ws + WS_W); bf16* Kk = (bf16*)(ws + WS_K); bf16* Vv = (bf16*)(ws + WS_V); bf16* KKn = (bf16*)(ws + WS_KK); bf16* Bb = (bf16*)(ws + WS_B);
    bf16* VF = (bf16*)(ws + WS_VF); bf16* Gg = (bf16*)(ws + WS_G); float* RK = (float*)(ws + WS_RK);
    LAS float* par = (LAS float*)lds;
    __syncthreads();
    for (int i = tid; i < 9 * C; i += NTHR) { const int wch = i / C, ch = i % C; float v;
        if (wch < 3) v = mu[wch * C + ch]; else if (wch == 3) v = a.inp(I_W0)[(size_t)l * C + ch]; else if (wch == 4) v = a.inp(I_A0)[(size_t)l * C + ch]; else if (wch == 5) v = a.inp(I_KK)[(size_t)l * C + ch];
        else if (wch == 6) v = a.inp(I_KA)[(size_t)l * C + ch]; else if (wch == 7) v = a.inp(I_RK)[(size_t)l * C + ch]; else v = (l > 0) ? a.inp(I_V0)[ch] : 0.f;
        par[i] = v; }
    __syncthreads();
    const int tk = lane & 15, q = lane >> 4;
    for (int u = gw; u < (T / 16) * NH; u += NGW) {
        const int hd = u & 15, tile = u >> 4; const int b = tile / (L / 16), t0 = (tile % (L / 16)) * 16; const int row = b * L + t0 + tk, t = t0 + tk;
        const bf16* zrow = Z + (size_t)row * NZ; const bf16* prow = zrow - NZ; const bool hp = t > 0;
        const bf16* zc = zrow + ZR0; const bf16* zp = prow + ZR0;
        struct CtIn { bf16x8 wd[2], wi[2], wg[2], wv; u32x2 zr, zk, zv, pr, pk, pv, vf; };
#define RP_LOAD(dst, ct) do { const int chA_ = hd * 64 + (ct) * 16 + (lane & 15), c0_ = hd * 64 + (ct) * 16 + 4 * q; \
            _Pragma("unroll") for (int ks = 0; ks < 2; ++ks) { dst.wd[ks] = *(const bf16x8*)(WdT + (size_t)chA_ * 64 + ks * 32 + 8 * q); dst.wi[ks] = *(const bf16x8*)(WiT + (size_t)chA_ * 64 + ks * 32 + 8 * q); dst.wg[ks] = *(const bf16x8*)(WgT + (size_t)chA_ * 64 + ks * 32 + 8 * q); } \
            dst.wv = (l > 0) ? *(const bf16x8*)(WvT + (size_t)chA_ * 32 + 8 * q) : (bf16x8){0, 0, 0, 0, 0, 0, 0, 0}; \
            dst.zr = *(const u32x2*)(zc + c0_); dst.zk = *(const u32x2*)(zc + 1024 + c0_); dst.zv = *(const u32x2*)(zc + 2048 + c0_); \
            dst.pr = (u32x2){0u, 0u}; dst.pk = dst.pr; dst.pv = dst.pr; if (hp) { dst.pr = *(const u32x2*)(zp + c0_); dst.pk = *(const u32x2*)(zp + 1024 + c0_); dst.pv = *(const u32x2*)(zp + 2048 + c0_); } \
            dst.vf = (l > 0) ? *(const u32x2*)(VF + (size_t)row * C + c0_) : (u32x2){0u, 0u}; } while (0)
        CtIn in[2];
        RP_LOAD(in[0], 0);
        bf16x8 bw[2], ba[2], bg[2], bs = {0, 0, 0, 0, 0, 0, 0, 0};
#pragma unroll
        for (int ks = 0; ks < 2; ++ks) { const int ko = ks * 32 + 8 * q; const u32x4 z4 = {0u, 0u, 0u, 0u};
            const u32x4 cw = *(const u32x4*)(zrow + ZR0 + 3072 + ko), ca = *(const u32x4*)(zrow + ZR0 + 3136 + ko), cg = *(const u32x4*)(zrow + ZR0 + 3200 + ko);
            const u32x4 pw = hp ? *(const u32x4*)(prow + ZR0 + 3072 + ko) : z4, pa = hp ? *(const u32x4*)(prow + ZR0 + 3136 + ko) : z4, pg = hp ? *(const u32x4*)(prow + ZR0 + 3200 + ko) : z4;
            bw[ks] = lora_in8<0>(cw, pw, *(const f32x4*)(mu + 3072 + ko), *(const f32x4*)(mu + 3072 + ko + 4));
            ba[ks] = lora_in8<1>(ca, pa, *(const f32x4*)(mu + 3136 + ko), *(const f32x4*)(mu + 3136 + ko + 4));
            bg[ks] = lora_in8<2>(cg, pg, *(const f32x4*)(mu + 3200 + ko), *(const f32x4*)(mu + 3200 + ko + 4)); }
        if (l > 0) { const u32x4 z4 = {0u, 0u, 0u, 0u}; const u32x4 cs = *(const u32x4*)(zrow + ZVD + 8 * q); const u32x4 ps = hp ? *(const u32x4*)(prow + ZVD + 8 * q) : z4;
            bs = lora_in8<1>(cs, ps, *(const f32x4*)(vmu + 8 * q), *(const f32x4*)(vmu + 8 * q + 4)); }
        float kkv[4][4], av[4][4]; float ss = 0.f, rks = 0.f;
#pragma unroll
        for (int ct = 0; ct < 4; ++ct) { const int ch0 = hd * 64 + ct * 16;
            if (ct + 1 < 4) RP_LOAD(in[(ct + 1) & 1], ct + 1);
            __builtin_amdgcn_sched_barrier(0);
            const CtIn& I = in[ct & 1];
            f32x4 aw = {0.f, 0.f, 0.f, 0.f}, aa = aw, ag = aw, avr = aw;
#pragma unroll
            for (int ks = 0; ks < 2; ++ks) {
                aw = __builtin_amdgcn_mfma_f32_16x16x32_bf16(I.wd[ks], bw[ks], aw, 0, 0, 0);
                aa = __builtin_amdgcn_mfma_f32_16x16x32_bf16(I.wi[ks], ba[ks], aa, 0, 0, 0);
                ag = __builtin_amdgcn_mfma_f32_16x16x32_bf16(I.wg[ks], bg[ks], ag, 0, 0, 0); }
            if (l > 0) avr = __builtin_amdgcn_mfma_f32_16x16x32_bf16(I.wv, bs, avr, 0, 0, 0);
            const int c0 = ch0 + 4 * q;
            const u32x2 zr_ = I.zr, zk_ = I.zk, zv_ = I.zv, pr_ = I.pr, pk_ = I.pk, pv_ = I.pv, vfw = I.vf;
            const f32x4 mr = *(const LAS f32x4*)(par + c0), mk = *(const LAS f32x4*)(par + C + c0), mv = *(const LAS f32x4*)(par + 2 * C + c0);
            const f32x4 w0v = *(const LAS f32x4*)(par + 3 * C + c0), a0v = *(const LAS f32x4*)(par + 4 * C + c0), kkw = *(const LAS f32x4*)(par + 5 * C + c0), kaw = *(const LAS f32x4*)(par + 6 * C + c0), rkw = *(const LAS f32x4*)(par + 7 * C + c0);
            const f32x4 v0v = *(const LAS f32x4*)(par + 8 * C + c0);
            f32x4 ro, wo, ko, vo, go;
#pragma unroll
            for (int j = 0; j < 4; ++j) {
                const float rc = (j & 1) ? bfhi(j < 2 ? zr_.x : zr_.y) : bflo(j < 2 ? zr_.x : zr_.y), rp = (j & 1) ? bfhi(j < 2 ? pr_.x : pr_.y) : bflo(j < 2 ? pr_.x : pr_.y);
                const float kc = (j & 1) ? bfhi(j < 2 ? zk_.x : zk_.y) : bflo(j < 2 ? zk_.x : zk_.y), kp = (j & 1) ? bfhi(j < 2 ? pk_.x : pk_.y) : bflo(j < 2 ? pk_.x : pk_.y);
                const float vc = (j & 1) ? bfhi(j < 2 ? zv_.x : zv_.y) : bflo(j < 2 ? zv_.x : zv_.y), vp = (j & 1) ? bfhi(j < 2 ? pv_.x : pv_.y) : bflo(j < 2 ? pv_.x : pv_.y);
                const float vfj = (j & 1) ? bfhi(j < 2 ? vfw.x : vfw.y) : bflo(j < 2 ? vfw.x : vfw.y);
                const float r = rc + (rp - rc) * mr[j]; float k = kc + (kp - kc) * mk[j]; float v = vc + (vp - vc) * mv[j];
                const float xw = -(w0v[j] + aw[j]);
                const float sp = fmaxf(xw, 0.f) + __logf(1.f + __expf(-fabsf(xw)));
                const float wlog = -sp - 0.5f; const float dec = __expf(-__expf(wlog));
                const float aval = sigmoidf_(a0v[j] + aa[j]);
                if (l > 0) v = v + (vfj - v) * sigmoidf_(v0v[j] + avr[j]);
                const float kk = k * kkw[j]; ss += kk * kk;
                k = k * (1.f + (aval - 1.f) * kaw[j]);
                rks += r * k * rkw[j];
                kkv[ct][j] = kk; av[ct][j] = aval;
                ro[j] = r; wo[j] = dec; ko[j] = k; vo[j] = v; go[j] = ag[j]; }
            const size_t o = (size_t)row * C + c0;
            *(u32x2*)(Rr + o) = (u32x2){pk2(ro[0], ro[1]), pk2(ro[2], ro[3])}; *(f32x4*)(Ww + o) = wo; *(u32x2*)(Kk + o) = (u32x2){pk2(ko[0], ko[1]), pk2(ko[2], ko[3])};
            const u32x2 vpk = {pk2(vo[0], vo[1]), pk2(vo[2], vo[3])}; *(u32x2*)(Vv + o) = vpk; *(u32x2*)(Gg + o) = (u32x2){pk2(go[0], go[1]), pk2(go[2], go[3])};
            if (l == 0) *(u32x2*)(VF + o) = vpk; }
#undef RP_LOAD
        ss += __shfl_xor(ss, 16); ss += __shfl_xor(ss, 32); rks += __shfl_xor(rks, 16); rks += __shfl_xor(rks, 32);
        const float inv = 1.f / fmaxf(sqrtf(ss), 1e-12f);
#pragma unroll
        for (int ct = 0; ct < 4; ++ct) { const size_t o = (size_t)row * C + hd * 64 + ct * 16 + 4 * q;
            float kn[4], bo[4];
#pragma unroll
            for (int j = 0; j < 4; ++j) { kn[j] = kkv[ct][j] * inv; bo[j] = kn[j] * av[ct][j]; }
            *(u32x2*)(KKn + o) = (u32x2){pk2(kn[0], kn[1]), pk2(kn[2], kn[3])}; *(u32x2*)(Bb + o) = (u32x2){pk2(bo[0], bo[1]), pk2(bo[2], bo[3])}; }
        if (q == 0) RK[(size_t)row * NH + hd] = rks;
    }
}

DI void phase_attn(const Args& a, int l, int gw, int NGW, int lane) {
    unsigned char* ws = (unsigned char*)a.ws; const bf16* Z = (const bf16*)(ws + WS_Z); const bf16* VT = (const bf16*)(ws + WS_VT); bf16* O = (bf16*)(ws + WS_OATT);
    const float* sinks = a.inp(I_SINKS) + l * NH;
    constexpr int NMAIN = NB * NH * (SEQ / 32), NUNITS = NMAIN + NB * NH;
    const int c = lane & 31, h = lane >> 5;
    const int kperm = (c & ~12) | ((c & 8) >> 1) | ((c & 4) << 1);
    constexpr float SCL = 0.125f * 1.44269504088896f;
    for (int u = gw; u < NUNITS; u += NGW) {
        const bool metaq = u >= NMAIN; const int uu = metaq ? u - NMAIN : u;
        const int hq4 = uu & 3, rest = uu >> 2; const int qb = metaq ? -8 : (rest & 63), bk = metaq ? rest : (rest >> 6); const int kvh = bk & 3, b = bk >> 2; const int hq = kvh * 4 + hq4;
        const int qpos = metaq ? c : NMETA + 32 * qb + c;
        const bf16* zb = Z + (size_t)(b * L) * NZ; const bf16* vb = VT + ((size_t)(b * 4 + kvh) * HD + c) * LPAD + 8 * h;
#define AT_KBASE(s) (((s) == 0) ? 0 : NMETA + 32 * (qb - 5 + (s)))
#define AT_VALID(s) (((s) == 0) || (qb - 5 + (s) >= 0))
#define AT_KLOAD(dst, s) do { if (AT_VALID(s)) { const bf16* kp_ = zb + (size_t)(AT_KBASE(s) + kperm) * NZ + ZK + kvh * 64 + 8 * h; _Pragma("unroll") for (int ks = 0; ks < 4; ++ks) dst[ks] = *(const bf16x8*)(kp_ + 16 * ks); } } while (0)
#define AT_VLOAD(dst, s) do { if (AT_VALID(s)) { const bf16* vp_ = vb + AT_KBASE(s); dst[0] = *(const bf16x8*)(vp_); dst[1] = *(const bf16x8*)(vp_ + 16); dst[2] = *(const bf16x8*)(vp_ + (size_t)32 * LPAD); dst[3] = *(const bf16x8*)(vp_ + (size_t)32 * LPAD + 16); } } while (0)
        bf16x8 qf[4], fr[2][4];
#pragma unroll
        for (int ks = 0; ks < 4; ++ks) qf[ks] = *(const bf16x8*)(zb + (size_t)qpos * NZ + ZQ + hq * 64 + 16 * ks + 8 * h);
        AT_KLOAD(fr[0], 0);
        f32x16 sc[6];
        float mx = sinks[hq] * 1.44269504088896f;
#pragma unroll
        for (int s = 0; s < 6; ++s) {
            const bool valid = AT_VALID(s); const int kbase = AT_KBASE(s);
            if (s + 1 < 6) AT_KLOAD(fr[(s + 1) & 1], s + 1);
            __builtin_amdgcn_sched_barrier(0);
#pragma unroll
            for (int i = 0; i < 16; ++i) sc[s][i] = 0.f;
            if (valid) {
#pragma unroll
                for (int ks = 0; ks < 4; ++ks) sc[s] = __builtin_amdgcn_mfma_f32_32x32x16_bf16(fr[s & 1][ks], qf[ks], sc[s], 0, 0, 0);
            }
#pragma unroll
            for (int i = 0; i < 16; ++i) { const int kpos = kbase + 16 * (i >> 3) + 8 * h + 4 * ((i >> 2) & 1) + (i & 3);
                const int dist = qpos - kpos;
                const bool vis = valid && ((s == 0) ? (kpos < NMETA && kpos <= qpos) : (s >= 2 && s <= 4) ? true : (dist >= 0 && dist < 128));
                sc[s][i] = vis ? sc[s][i] * SCL : -1e30f; mx = fmaxf(mx, sc[s][i]); }
        }
        AT_VLOAD(fr[0], 0);
        mx = fmaxf(mx, __shfl_xor(mx, 32));
        float sum = 0.f;
#pragma unroll
        for (int s = 0; s < 6; ++s)
#pragma unroll
            for (int i = 0; i < 16; ++i) { const float p = __builtin_amdgcn_exp2f(sc[s][i] - mx); sc[s][i] = p; sum += p; }
        sum += __shfl_xor(sum, 32);
        sum += __builtin_amdgcn_exp2f(sinks[hq] * 1.44269504088896f - mx);
        f32x16 o0, o1;
#pragma unroll
        for (int i = 0; i < 16; ++i) { o0[i] = 0.f; o1[i] = 0.f; }
#pragma unroll
        for (int s = 0; s < 6; ++s) {
            const bool valid = AT_VALID(s);
            if (s + 1 < 6) AT_VLOAD(fr[(s + 1) & 1], s + 1);
            __builtin_amdgcn_sched_barrier(0);
            if (valid) {
#pragma unroll
                for (int s2 = 0; s2 < 2; ++s2) {
                    u32x4 pw; pw.x = pk2(sc[s][8 * s2 + 0], sc[s][8 * s2 + 1]); pw.y = pk2(sc[s][8 * s2 + 2], sc[s][8 * s2 + 3]); pw.z = pk2(sc[s][8 * s2 + 4], sc[s][8 * s2 + 5]); pw.w = pk2(sc[s][8 * s2 + 6], sc[s][8 * s2 + 7]);
                    const bf16x8 pf = __builtin_bit_cast(bf16x8, pw);
                    o0 = __builtin_amdgcn_mfma_f32_32x32x16_bf16(fr[s & 1][s2], pf, o0, 0, 0, 0);
                    o1 = __builtin_amdgcn_mfma_f32_32x32x16_bf16(fr[s & 1][2 + s2], pf, o1, 0, 0, 0); }
            }
        }
#undef AT_KBASE
#undef AT_VALID
#undef AT_KLOAD
#undef AT_VLOAD
        if (!metaq || c < NMETA) { const float inv = 1.f / sum; bf16* orow = O + (size_t)(b * L + qpos) * C + hq * 64 + 4 * h;
#pragma unroll
            for (int g4 = 0; g4 < 4; ++g4) { u32x2 w0, w1;
                w0.x = pk2(o0[4 * g4] * inv, o0[4 * g4 + 1] * inv); w0.y = pk2(o0[4 * g4 + 2] * inv, o0[4 * g4 + 3] * inv);
                w1.x = pk2(o1[4 * g4] * inv, o1[4 * g4 + 1] * inv); w1.y = pk2(o1[4 * g4 + 2] * inv, o1[4 * g4 + 3] * inv);
                *(u32x2*)(orow + 8 * g4) = w0; *(u32x2*)(orow + 32 + 8 * g4) = w1; } }
    }
}

constexpr int CK = 64, NCK = (L + CK - 1) / CK  , NCHUNK = NB * NH * NCK  ;
constexpr size_t CH_P = WS_XR, CH_Q = CH_P + (size_t)NCHUNK * 4096 * 2, CH_RH = CH_Q + (size_t)NCHUNK * 4096 * 4, CH_YL = CH_RH + (size_t)NCHUNK * 4096 * 2, CH_ZS = CH_YL + (size_t)NCHUNK * 4096 * 4;
static_assert(CH_ZS + (size_t)NCHUNK * 4096 * 2 <= WS_HID, "chunk buffers fit the free XR region");
constexpr int CP = 72, CMS = 64 * CP * 2;
struct CkF { bf16x8 a[2], b[2][2]; };
DI void ck_ld(CkF& f, const LAS bf16* A, const LAS bf16* Bt, int wave, int lane) {
    const int mt = wave >> 1, nt0 = 2 * (wave & 1), r = lane & 15, q = lane >> 4;
#pragma unroll
    for (int ks = 0; ks < 2; ++ks) { f.a[ks] = *(const LAS bf16x8*)(A + (16 * mt + r) * CP + 32 * ks + 8 * q);
#pragma unroll
        for (int j = 0; j < 2; ++j) f.b[j][ks] = *(const LAS bf16x8*)(Bt + (16 * (nt0 + j) + r) * CP + 32 * ks + 8 * q); }
}
DI void ck_mma(f32x4 (&acc)[2], const CkF& f) {
#pragma unroll
    for (int ks = 0; ks < 2; ++ks)
#pragma unroll
        for (int j = 0; j < 2; ++j) acc[j] = __builtin_amdgcn_mfma_f32_16x16x32_bf16(f.a[ks], f.b[j][ks], acc[j], 0, 0, 0);
}
template <class F> DI void ck_epi(const f32x4 (&acc)[2], int wave, int lane, const F& epi) {
    const int mt = wave >> 1, nt0 = 2 * (wave & 1), r = lane & 15, q = lane >> 4;
#pragma unroll
    for (int j = 0; j < 2; ++j) epi(16 * mt + 4 * q, 16 * (nt0 + j) + r, acc[j]);
}
template <class F>
DI void ck_mm(const LAS bf16* A, const LAS bf16* Bt, const LAS bf16* A2, const LAS bf16* Bt2, int wave, int lane, const F& epi) {
    CkF f; ck_ld(f, A, Bt, wave, lane); f32x4 acc[2] = {{0.f, 0.f, 0.f, 0.f}, {0.f, 0.f, 0.f, 0.f}}; ck_mma(acc, f);
    if (A2) { CkF g; ck_ld(g, A2, Bt2, wave, lane); ck_mma(acc, g); }
    ck_epi(acc, wave, lane, epi);
}
#define CK_Z2 {{0.f, 0.f, 0.f, 0.f}, {0.f, 0.f, 0.f, 0.f}}
DI void ck_wr_row(LAS bf16* X, int m, int n, f32x4 v) {
#pragma unroll
    for (int g = 0; g < 4; ++g) X[(m + g) * CP + n] = (bf16)(pk2(v[g], 0.f) & 0xffffu);
}
DI void ck_wr_tr(LAS bf16* XT, int m, int n, f32x4 v) { *(LAS u32x2*)(XT + n * CP + m) = (u32x2){pk2(v[0], v[1]), pk2(v[2], v[3])}; }

DI void phase_chunkA(const Args& a, LAS unsigned char* lds, int wave, int lane, int tid, int bid, int G) {
    unsigned char* ws = (unsigned char*)a.ws;
    const float* Ww = (const float*)(ws + WS_W); const bf16* KKn = (const bf16*)(ws + WS_KK); const bf16* Bb = (const bf16*)(ws + WS_B);
    const bf16* Kk = (const bf16*)(ws + WS_K); const bf16* Rr = (const bf16*)(ws + WS_R); const bf16* Vv = (const bf16*)(ws + WS_V);
#define SL(i) ((LAS bf16*)(lds + (i) * CMS))
#define CK_BAR() do { asm volatile("s_waitcnt lgkmcnt(0)" ::: "memory"); __builtin_amdgcn_s_barrier(); asm volatile("" ::: "memory"); } while (0)
    LAS float* Gf = (LAS float*)(lds + 8 * CMS);
    LAS float* gC = (LAS float*)(lds + 14 * CMS);
    f32x4 nw0, nw1; u32x4 nr8, nk8, nv8, nkk8, nb8;
#define CK_LOADIN(cc, hh, bb) do { const int t_ = tid >> 3, c8_ = (tid & 7) * 8; const bool ok_ = CK * (cc) + t_ < L; const size_t ro_ = (size_t)((bb) * L + CK * (cc) + t_) * C + (hh) * 64 + c8_; \
        const f32x4 one_ = {1.f, 1.f, 1.f, 1.f}; const u32x4 z_ = {0u, 0u, 0u, 0u}; \
        nw0 = ok_ ? *(const f32x4*)(Ww + ro_) : one_; nw1 = ok_ ? *(const f32x4*)(Ww + ro_ + 4) : one_; \
        nr8 = ok_ ? *(const u32x4*)(Rr + ro_) : z_; nk8 = ok_ ? *(const u32x4*)(Kk + ro_) : z_; nv8 = ok_ ? *(const u32x4*)(Vv + ro_) : z_; nkk8 = ok_ ? *(const u32x4*)(KKn + ro_) : z_; nb8 = ok_ ? *(const u32x4*)(Bb + ro_) : z_; } while (0)
    if (bid < NCHUNK) { const int c0_ = bid % NCK, bh0_ = bid / NCK; CK_LOADIN(c0_, bh0_ & 15, bh0_ >> 4); }
    for (int cid = bid; cid < NCHUNK; cid += G) {
        const int c = cid % NCK, bh = cid / NCK, hd = bh & 15, b = bh >> 4; const int tok0 = CK * c; (void)tok0; (void)hd; (void)b;
        CK_BAR();
        const int t = tid >> 3, c8 = (tid & 7) * 8;
        float wv[8], gv[8], gp[8];
#pragma unroll
        for (int e = 0; e < 4; ++e) { wv[e] = nw0[e]; wv[4 + e] = nw1[e]; }
        const u32x4 r8 = nr8, k8 = nk8, v8 = nv8, kk8 = nkk8, b8 = nb8;
        { const int cid2 = cid + G; if (cid2 < NCHUNK) { const int c2 = cid2 % NCK, bh2 = cid2 / NCK; CK_LOADIN(c2, bh2 & 15, bh2 >> 4); } }
        { const int tl = lane >> 3;
#pragma unroll
          for (int e = 0; e < 8; ++e) { float x = wv[e];
              float y = __shfl_up(x, 8); if (tl >= 1) x *= y;
              y = __shfl_up(x, 16); if (tl >= 2) x *= y;
              y = __shfl_up(x, 32); if (tl >= 4) x *= y;
              gv[e] = x; }
          if (tl == 7) {
#pragma unroll
              for (int e = 0; e < 8; ++e) Gf[wave * 64 + c8 + e] = gv[e]; } }
        CK_BAR();
        {
#pragma unroll 1
          for (int w2 = 0; w2 < wave; ++w2) {
#pragma unroll
              for (int e = 0; e < 8; ++e) gv[e] *= Gf[w2 * 64 + c8 + e]; }
#pragma unroll
          for (int e = 0; e < 8; ++e) gp[e] = gv[e] / wv[e];
          if (t == CK - 1) {
#pragma unroll
              for (int e = 0; e < 8; ++e) gC[c8 + e] = gv[e]; } }
        {
          float rt[8], at[8], kt[8], bt[8], vv[8];
#pragma unroll
          for (int e = 0; e < 8; ++e) { const unsigned rw = (e < 2) ? r8.x : (e < 4) ? r8.y : (e < 6) ? r8.z : r8.w, kw = (e < 2) ? k8.x : (e < 4) ? k8.y : (e < 6) ? k8.z : k8.w, vw = (e < 2) ? v8.x : (e < 4) ? v8.y : (e < 6) ? v8.z : v8.w,
                  qw = (e < 2) ? kk8.x : (e < 4) ? kk8.y : (e < 6) ? kk8.z : kk8.w, bw = (e < 2) ? b8.x : (e < 4) ? b8.y : (e < 6) ? b8.z : b8.w;
              const float rv = (e & 1) ? bfhi(rw) : bflo(rw), kv = (e & 1) ? bfhi(kw) : bflo(kw), vx = (e & 1) ? bfhi(vw) : bflo(vw), qv = (e & 1) ? bfhi(qw) : bflo(qw), bv = (e & 1) ? bfhi(bw) : bflo(bw);
              const float ig = 1.f / gv[e];
              rt[e] = rv * gv[e]; at[e] = -qv * gp[e]; kt[e] = kv * ig; bt[e] = bv * ig; vv[e] = vx; }
          *(LAS u32x4*)(SL(6) + t * CP + c8) = (u32x4){pk2(rt[0], rt[1]), pk2(rt[2], rt[3]), pk2(rt[4], rt[5]), pk2(rt[6], rt[7])};
          *(LAS u32x4*)(SL(0) + t * CP + c8) = (u32x4){pk2(at[0], at[1]), pk2(at[2], at[3]), pk2(at[4], at[5]), pk2(at[6], at[7])};
          *(LAS u32x4*)(SL(4) + t * CP + c8) = (u32x4){pk2(kt[0], kt[1]), pk2(kt[2], kt[3]), pk2(kt[4], kt[5]), pk2(kt[6], kt[7])};
          *(LAS u32x4*)(SL(2) + t * CP + c8) = (u32x4){pk2(bt[0], bt[1]), pk2(bt[2], bt[3]), pk2(bt[4], bt[5]), pk2(bt[6], bt[7])};
          *(LAS u32x4*)(SL(10) + t * CP + c8) = (u32x4){pk2(vv[0], vv[1]), pk2(vv[2], vv[3]), pk2(vv[4], vv[5]), pk2(vv[6], vv[7])};
          { unsigned iw[4];
#pragma unroll
            for (int e = 0; e < 4; ++e) iw[e] = ((c8 + 2 * e == t) ? 0x3f80u : 0u) | ((c8 + 2 * e + 1 == t) ? 0x3f800000u : 0u);
            *(LAS u32x4*)(SL(11) + t * CP + c8) = (u32x4){iw[0], iw[1], iw[2], iw[3]}; } }
        CK_BAR();
#define CK_RUN2(A1, B1, E1, A2, B2, E2) do { CkF f1_, f2_; ck_ld(f1_, A1, B1, wave, lane); ck_ld(f2_, A2, B2, wave, lane); __builtin_amdgcn_sched_barrier(0); \
            f32x4 c1_[2] = CK_Z2, c2_[2] = CK_Z2; ck_mma(c1_, f1_); ck_mma(c2_, f2_); ck_epi(c1_, wave, lane, E1); ck_epi(c2_, wave, lane, E2); } while (0)
#define CK_RUN3(A1, B1, E1, A2, B2, E2, A3, B3, E3) do { CkF f1_, f2_, f3_; ck_ld(f1_, A1, B1, wave, lane); ck_ld(f2_, A2, B2, wave, lane); ck_ld(f3_, A3, B3, wave, lane); __builtin_amdgcn_sched_barrier(0); \
            f32x4 c1_[2] = CK_Z2, c2_[2] = CK_Z2, c3_[2] = CK_Z2; ck_mma(c1_, f1_); ck_mma(c2_, f2_); ck_mma(c3_, f3_); ck_epi(c1_, wave, lane, E1); ck_epi(c2_, wave, lane, E2); ck_epi(c3_, wave, lane, E3); } while (0)
        { auto t1 = [&](int m, int n, f32x4 v) { ck_wr_tr(SL(1), m, n, v); }; auto t3 = [&](int m, int n, f32x4 v) { ck_wr_tr(SL(3), m, n, v); };
          auto t5 = [&](int m, int n, f32x4 v) { ck_wr_tr(SL(5), m, n, v); }; auto t7 = [&](int m, int n, f32x4 v) { ck_wr_tr(SL(7), m, n, v); };
          CK_RUN2(SL(0), SL(11), t1, SL(2), SL(11), t3); CK_RUN2(SL(4), SL(11), t5, SL(10), SL(11), t7); }
        CK_BAR();
        { auto ePT = [&](int m, int n, f32x4 v) {
#pragma unroll
              for (int g = 0; g < 4; ++g) v[g] = (n < m + g) ? v[g] : 0.f;
              ck_wr_tr(SL(13), m, n, v); };
          auto ePA = [&](int m, int n, f32x4 v) { f32x4 tt;
#pragma unroll
              for (int g = 0; g < 4; ++g) { v[g] = (m + g < n) ? v[g] : 0.f; tt[g] = (m + g == n) ? 1.f : v[g]; }
              ck_wr_tr(SL(12), m, n, v); ck_wr_tr(SL(8), m, n, tt); };
          auto eMak = [&](int m, int n, f32x4 v) {
#pragma unroll
              for (int g = 0; g < 4; ++g) v[g] = (m + g < n) ? v[g] : 0.f;
              ck_wr_tr(SL(9), m, n, v); };
          CK_RUN3(SL(0), SL(2), ePT, SL(2), SL(0), ePA, SL(4), SL(0), eMak); }
        { auto eNrb = [&](int m, int n, f32x4 v) {
#pragma unroll
              for (int g = 0; g < 4; ++g) v[g] = (m + g <= n) ? v[g] : 0.f;
              ck_wr_tr(SL(10), m, n, v); };
          auto eNrk = [&](int m, int n, f32x4 v) {
#pragma unroll
              for (int g = 0; g < 4; ++g) v[g] = (m + g <= n) ? v[g] : 0.f;
              ck_wr_tr(SL(11), m, n, v); };
          CK_RUN2(SL(2), SL(6), eNrb, SL(4), SL(6), eNrk); }
        CK_BAR();
#define CK_NEU(TA, TB, PA_, PT_, PAN, PTN) do { \
            auto eT_ = [&](int m, int n, f32x4 v) { const u32x2 o = *(const LAS u32x2*)(SL(TA) + n * CP + m); v[0] += bflo(o.x); v[1] += bfhi(o.x); v[2] += bflo(o.y); v[3] += bfhi(o.y); ck_wr_tr(SL(TB), m, n, v); }; \
            auto eS1_ = [&](int m, int n, f32x4 v) { ck_wr_tr(SL(PTN), m, n, v); }; auto eS2_ = [&](int m, int n, f32x4 v) { ck_wr_tr(SL(PAN), m, n, v); }; \
            CK_RUN3(SL(PT_), SL(TA), eT_, SL(PA_), SL(PT_), eS1_, SL(PT_), SL(PA_), eS2_); CK_BAR(); } while (0)
        { auto eS1 = [&](int m, int n, f32x4 v) { ck_wr_tr(SL(2), m, n, v); }; auto eS2 = [&](int m, int n, f32x4 v) { ck_wr_tr(SL(0), m, n, v); };
          CK_RUN2(SL(12), SL(13), eS1, SL(13), SL(12), eS2); }
        CK_BAR();
        CK_NEU(8, 4, 0, 2, 12, 13);
        CK_NEU(4, 8, 12, 13, 0, 2);
        CK_NEU(8, 4, 0, 2, 12, 13);
        CK_NEU(4, 8, 12, 13, 0, 2);
        ck_mm(SL(2), SL(8), nullptr, nullptr, wave, lane, [&](int m, int n, f32x4 v) { const u32x2 o = *(const LAS u32x2*)(SL(8) + n * CP + m);
            v[0] += bflo(o.x); v[1] += bfhi(o.x); v[2] += bflo(o.y); v[3] += bfhi(o.y); ck_wr_tr(SL(4), m, n, v); });
        CK_BAR();
#undef CK_NEU
        { auto e12 = [&](int m, int n, f32x4 v) { ck_wr_tr(SL(12), m, n, v); }; auto e0 = [&](int m, int n, f32x4 v) { ck_wr_tr(SL(0), m, n, v); };
          CK_RUN2(SL(9), SL(7), e12, SL(4), SL(1), e0); }
        CK_BAR();
        { bf16* Pg = (bf16*)(ws + CH_P) + (size_t)cid * 4096; bf16* Rg = (bf16*)(ws + CH_RH) + (size_t)cid * 4096;
          auto e13 = [&](int m, int n, f32x4 v) { ck_wr_tr(SL(13), m, n, v); };
          auto eP = [&](int m, int n, f32x4 v) { const float gc = gC[n];
#pragma unroll
              for (int g = 0; g < 4; ++g) v[g] = gc * (((m + g == n) ? 1.f : 0.f) + v[g]);
              *(u32x2*)(Pg + n * 64 + m) = (u32x2){pk2(v[0], v[1]), pk2(v[2], v[3])}; };
          auto eR = [&](int m, int n, f32x4 v) { const u32x2 o = *(const LAS u32x2*)(SL(6) + n * CP + m);
              v[0] += bflo(o.x); v[1] += bfhi(o.x); v[2] += bflo(o.y); v[3] += bfhi(o.y);
              *(u32x2*)(Rg + n * 64 + m) = (u32x2){pk2(v[0], v[1]), pk2(v[2], v[3])}; };
          CK_RUN3(SL(4), SL(12), e13, SL(0), SL(3), eP, SL(0), SL(10), eR); }
        CK_BAR();
        { float* Qg = (float*)(ws + CH_Q) + (size_t)cid * 4096; float* Yg = (float*)(ws + CH_YL) + (size_t)cid * 4096;
          CkF f1, f2, f3, f4; ck_ld(f1, SL(13), SL(3), wave, lane); ck_ld(f2, SL(7), SL(5), wave, lane); ck_ld(f3, SL(13), SL(10), wave, lane); ck_ld(f4, SL(7), SL(11), wave, lane); __builtin_amdgcn_sched_barrier(0);
          f32x4 cq[2] = CK_Z2, cy[2] = CK_Z2; ck_mma(cq, f1); ck_mma(cq, f2); ck_mma(cy, f3); ck_mma(cy, f4);
          ck_epi(cq, wave, lane, [&](int m, int n, f32x4 v) { *(f32x4*)(Qg + n * 64 + m) = v * gC[n]; });
          ck_epi(cy, wave, lane, [&](int m, int n, f32x4 v) { *(f32x4*)(Yg + n * 64 + m) = v; }); }
#undef CK_RUN2
#undef CK_RUN3
    }
#undef SL
#undef CK_BAR
#undef CK_LOADIN
}
DI void phase_chunkB(const Args& a, LAS unsigned char* lds, int wave, int lane, int bid, int G) {
    unsigned char* ws = (unsigned char*)a.ws; LAS bf16* Zb = (LAS bf16*)lds;
    const int r = lane & 15, q = lane >> 4;
    if (wave != 0) return;
    for (int u = bid; u < NB * NH * 4; u += G) { const int iq = u & 3, bh = u >> 2;
        bf16x8 pf[4][2]; f32x4 qv[4];
#define CB_LOAD(cc) do { const size_t cid_ = (size_t)bh * NCK + (cc); const bf16* Pg_ = (const bf16*)(ws + CH_P) + cid_ * 4096; const float* Qg_ = (const float*)(ws + CH_Q) + cid_ * 4096; \
            _Pragma("unroll") for (int mt = 0; mt < 4; ++mt) { _Pragma("unroll") for (int ks = 0; ks < 2; ++ks) pf[mt][ks] = *(const bf16x8*)(Pg_ + (16 * mt + r) * 64 + 32 * ks + 8 * q); \
            _Pragma("unroll") for (int g = 0; g < 4; ++g) qv[mt][g] = Qg_[(16 * mt + 4 * q + g) * 64 + 16 * iq + r]; } } while (0)
        asm volatile("s_waitcnt lgkmcnt(0)" ::: "memory");
#pragma unroll
        for (int mt = 0; mt < 4; ++mt) { *(LAS u32x2*)(Zb + r * CP + 16 * mt + 4 * q) = (u32x2){0u, 0u};
            *(u32x2*)((bf16*)(ws + CH_ZS) + ((size_t)bh * NCK) * 4096 + (16 * iq + r) * 64 + 16 * mt + 4 * q) = (u32x2){0u, 0u}; }
        CB_LOAD(0);
        for (int c = 0; c < NCK - 1; ++c) { const size_t cid = (size_t)bh * NCK + c;
            asm volatile("s_waitcnt lgkmcnt(0)" ::: "memory");
            bf16x8 zf[2];
#pragma unroll
            for (int ks = 0; ks < 2; ++ks) zf[ks] = *(const LAS bf16x8*)(Zb + r * CP + 32 * ks + 8 * q);
            f32x4 z[4];
#pragma unroll
            for (int mt = 0; mt < 4; ++mt) { z[mt] = qv[mt];
#pragma unroll
                for (int ks = 0; ks < 2; ++ks) z[mt] = __builtin_amdgcn_mfma_f32_16x16x32_bf16(pf[mt][ks], zf[ks], z[mt], 0, 0, 0); }
            if (c + 1 < NCK - 1) CB_LOAD(c + 1);
#pragma unroll
            for (int mt = 0; mt < 4; ++mt) { const u32x2 zw = {pk2(z[mt][0], z[mt][1]), pk2(z[mt][2], z[mt][3])}; *(LAS u32x2*)(Zb + r * CP + 16 * mt + 4 * q) = zw;
                *(u32x2*)((bf16*)(ws + CH_ZS) + (cid + 1) * 4096 + (16 * iq + r) * 64 + 16 * mt + 4 * q) = zw; }
        }
    }
#undef CB_LOAD
}
DI void phase_chunkC(const Args& a, int l, int gw, int NGW, int lane) {
    unsigned char* ws = (unsigned char*)a.ws; const int r = lane & 15, q = lane >> 4;
    const bf16* Vv = (const bf16*)(ws + WS_V); const bf16* Gg = (const bf16*)(ws + WS_G); const float* RK = (const float*)(ws + WS_RK); bf16* ORW = (bf16*)(ws + WS_ORW);
    const float* lnw = a.inp(I_LNW) + (size_t)l * C; const float* lnb = a.inp(I_LNB) + (size_t)l * C;
    for (int u = gw; u < NCHUNK * 4; u += NGW) { const int tt = u & 3, cid = u >> 2; const int c = cid % NCK, bh = cid / NCK, hd = bh & 15, b = bh >> 4;
        const bf16* Zg = (const bf16*)(ws + CH_ZS) + (size_t)cid * 4096; const bf16* Rg = (const bf16*)(ws + CH_RH) + (size_t)cid * 4096; const float* Yg = (const float*)(ws + CH_YL) + (size_t)cid * 4096;
        const int t = 16 * tt + r, tok = CK * c + t; const bool ok = tok < L; const size_t ro = (size_t)(b * L + (ok ? tok : 0)) * C + hd * 64;
        bf16x8 bfr[2];
#pragma unroll
        for (int ks = 0; ks < 2; ++ks) bfr[ks] = *(const bf16x8*)(Rg + t * 64 + 32 * ks + 8 * q);
        f32x4 y[4]; float s = 0.f;
#pragma unroll
        for (int it = 0; it < 4; ++it) { f32x4 acc = *(const f32x4*)(Yg + t * 64 + 16 * it + 4 * q);
#pragma unroll
            for (int ks = 0; ks < 2; ++ks) acc = __builtin_amdgcn_mfma_f32_16x16x32_bf16(*(const bf16x8*)(Zg + (16 * it + r) * 64 + 32 * ks + 8 * q), bfr[ks], acc, 0, 0, 0);
            y[it] = acc; s += (acc[0] + acc[1]) + (acc[2] + acc[3]); }
        s += __shfl_xor(s, 16); s += __shfl_xor(s, 32); const float mean = s * (1.f / 64.f); float qs = 0.f;
#pragma unroll
        for (int it = 0; it < 4; ++it) { y[it] = y[it] - mean; qs += (y[it][0] * y[it][0] + y[it][1] * y[it][1]) + (y[it][2] * y[it][2] + y[it][3] * y[it][3]); }
        qs += __shfl_xor(qs, 16); qs += __shfl_xor(qs, 32); const float rstd = rsqrtf(qs * (1.f / 64.f) + GN_EPS);
        const float rk = RK[(size_t)(b * L + (ok ? tok : 0)) * NH + hd];
#pragma unroll
        for (int it = 0; it < 4; ++it) { const int ch = 16 * it + 4 * q; const u32x2 vw = *(const u32x2*)(Vv + ro + ch), gw_ = *(const u32x2*)(Gg + ro + ch);
            const f32x4 v = {bflo(vw.x), bfhi(vw.x), bflo(vw.y), bfhi(vw.y)}, g = {bflo(gw_.x), bfhi(gw_.x), bflo(gw_.y), bfhi(gw_.y)};
            const f32x4 lw = *(const f32x4*)(lnw + hd * 64 + ch), lb = *(const f32x4*)(lnb + hd * 64 + ch);
            const f32x4 o = (y[it] * rstd * lw + lb + rk * v) * g;
            if (ok) *(u32x2*)(ORW + ro + ch) = (u32x2){pk2(o[0], o[1]), pk2(o[2], o[3])}; }
    }
}
DI void phase_router(const Args& a, int l, LAS unsigned char* lds, int wave, int lane, int bid, int G, bool dummy = false) {
    unsigned char* ws = (unsigned char*)a.ws; const float* H = (const float*)(ws + WS_H); bf16* U = (bf16*)(ws + WS_U); const bf16* WRO = (const bf16*)(ws + WS_WRO) + (size_t)l * 80 * D;
    const float* gain = a.inp(I_NORM_FFN) + (size_t)l * D; const float* bco = a.inp(I_BCOARSE) + l * 8; const float* bfi = a.inp(I_BFINE) + l * 64;
    int* toke = (int*)(ws + WS_TOKE); int* toks = (int*)(ws + WS_TOKS); float* tokw = (float*)(ws + WS_TOKW); unsigned* cnt = (unsigned*)(ws + WS_CTL) + CW_CNT + l * 64 * 16;
    int* elist = (int*)(ws + WS_ELIST);
    if (dummy) { toke = (int*)(ws + WS_XR); toks = toke + 2 * T; tokw = (float*)(toks + 2 * T); cnt += 8192; U = (bf16*)(ws + WS_XR) + (size_t)8 * T; elist = (int*)(ws + WS_XR) + (size_t)(8 + 2048) * T; }
    LAS float* red = (LAS float*)lds;
    LAS float* ssp = red + 8 * 16 * 80;
    LAS float* lg = ssp + 8 * 16;
    LAS float* rs = lg + 16 * 72;
    const int tid = wave * 64 + lane;
    const int n = lane & 15, q = lane >> 4;
    for (int tile = bid; tile < T / 16; tile += G) { const int row0 = tile * 16;
        __syncthreads();
        f32x4 hv[8][2];
        const float* hp = H + (size_t)(row0 + n) * D + wave * 256 + 8 * q; const float* gp = gain + wave * 256 + 8 * q;
#pragma unroll
        for (int ks = 0; ks < 8; ++ks) { hv[ks][0] = *(const f32x4*)(hp + ks * 32); hv[ks][1] = *(const f32x4*)(hp + ks * 32 + 4); }
        f32x4 acc[5];
#pragma unroll
        for (int nt = 0; nt < 5; ++nt) acc[nt] = (f32x4){0.f, 0.f, 0.f, 0.f};
        float ss = 0.f;
#pragma unroll
        for (int ks = 0; ks < 8; ++ks) { const int k0 = wave * 256 + ks * 32 + 8 * q;
            const f32x4 g0 = *(const f32x4*)(gp + ks * 32), g1 = *(const f32x4*)(gp + ks * 32 + 4); const f32x4 x0 = hv[ks][0], x1 = hv[ks][1];
            ss += (x0[0] * x0[0] + x0[1] * x0[1]) + (x0[2] * x0[2] + x0[3] * x0[3]) + (x1[0] * x1[0] + x1[1] * x1[1]) + (x1[2] * x1[2] + x1[3] * x1[3]);
            const f32x4 y0 = x0 * g0, y1 = x1 * g1; u32x4 aw; aw.x = pk2(y0[0], y0[1]); aw.y = pk2(y0[2], y0[3]); aw.z = pk2(y1[0], y1[1]); aw.w = pk2(y1[2], y1[3]);
            const bf16x8 af = __builtin_bit_cast(bf16x8, aw);
#pragma unroll
            for (int nt = 0; nt < 5; ++nt) acc[nt] = __builtin_amdgcn_mfma_f32_16x16x32_bf16(af, *(const bf16x8*)(WRO + (size_t)(nt * 16 + n) * D + k0), acc[nt], 0, 0, 0); }
        ss += __shfl_xor(ss, 16); ss += __shfl_xor(ss, 32);
        if (q == 0) ssp[wave * 16 + n] = ss;
#pragma unroll
        for (int nt = 0; nt < 5; ++nt)
#pragma unroll
            for (int j = 0; j < 4; ++j) red[(wave * 16 + 4 * q + j) * 80 + nt * 16 + n] = acc[nt][j];
        __syncthreads();
        if (tid < 16) { float s = 0.f;
#pragma unroll
            for (int w = 0; w < 8; ++w) s += ssp[w * 16 + tid];
            rs[tid] = rsqrtf(s * (1.f / D) + NORM_EPS); }
        __syncthreads();
        for (int i = tid; i < 16 * 72; i += NTHR) { const int tk = i / 72, nn = i % 72; float s = 0.f;
#pragma unroll
            for (int w = 0; w < 8; ++w) s += red[(w * 16 + tk) * 80 + nn];
            lg[tk * 72 + nn] = s * rs[tk] + ((nn < 8) ? bco[nn] : bfi[nn - 8]); }
        { const float rstd = rs[n]; bf16* up = U + (size_t)(row0 + n) * D + wave * 256 + 8 * q;
#pragma unroll
          for (int ks = 0; ks < 8; ++ks) { const f32x4 g0 = *(const f32x4*)(gp + ks * 32), g1 = *(const f32x4*)(gp + ks * 32 + 4); const f32x4 y0 = hv[ks][0] * rstd * g0, y1 = hv[ks][1] * rstd * g1;
              *(u32x4*)(up + ks * 32) = (u32x4){pk2(y0[0], y0[1]), pk2(y0[2], y0[3]), pk2(y1[0], y1[1]), pk2(y1[2], y1[3])}; } }
        __syncthreads();
        if (tid < 16) { const int m = row0 + tid; const LAS float* p = lg + tid * 72;
            int gi = 0; float gm = p[0];
#pragma unroll
            for (int j = 1; j < 8; ++j) if (p[j] > gm) { gm = p[j]; gi = j; }
            float se = 0.f;
#pragma unroll
            for (int j = 0; j < 8; ++j) se += __expf(p[j] - gm);
            const float pgrp = 1.f / se;
            const LAS float* f = p + 8 + gi * 8;
            int i0 = 0; float f0 = f[0];
#pragma unroll
            for (int j = 1; j < 8; ++j) if (f[j] > f0) { f0 = f[j]; i0 = j; }
            int i1 = -1; float f1 = -3.0e38f;
#pragma unroll
            for (int j = 0; j < 8; ++j) if (j != i0 && f[j] > f1) { f1 = f[j]; i1 = j; }
            const float e1 = __expf(f1 - f0), den = 1.f / (1.f + e1);
            const int e0x = gi * 8 + i0, e1x = gi * 8 + i1;
            toke[2 * m] = e0x; toke[2 * m + 1] = e1x; tokw[2 * m] = den * pgrp; tokw[2 * m + 1] = e1 * den * pgrp;
            const int s0 = (int)__hip_atomic_fetch_add(cnt + e0x * 16, 1u, RLX_AGENT), s1 = (int)__hip_atomic_fetch_add(cnt + e1x * 16, 1u, RLX_AGENT);
            toks[2 * m] = s0; toks[2 * m + 1] = s1; elist[(size_t)e0x * T + s0] = m; elist[(size_t)e1x * T + s1] = m; }
    }
}
constexpr int MS_XOFF = 2 * 128 * 128, MS_XBUF = 48 * 128, MS_XWAVE = 2 * MS_XBUF;
constexpr int MS_TILE = 128 * 128;
template <int MODE, int VAR = 0>
DI void moe_stream_phase(const Args& a, int l, LAS unsigned char* lds, int wave, int lane, int tid, int bid, int G, int lw = -1, size_t out_off = 0) {
    unsigned char* ws = (unsigned char*)a.ws; LAS int* lc = (LAS int*)(lds + LDSCTL_OFF);
    moe_tables((const unsigned*)(ws + WS_CTL) + CW_CNT + l * 64 * 16, lc, tid);
    if (lw >= 0) l = lw;
    const size_t o_hid = out_off ? out_off : WS_HID, o_yr = out_off ? out_off : WS_YR;
    constexpr int KD = (MODE == 0) ? D : DEXP, NT = KD / 64, NSLAB = (MODE == 0) ? 8 : 16, LDW = (MODE == 0) ? DEXP : D, LDX = KD;
    const int half = wave & 1, nb16 = lane & 15, kb = 4 * (wave >> 1) + (lane >> 4);
    const int tk = lane & 15, q = lane >> 4;
    const GAS char* wmat = (const GAS char*)((MODE == 0) ? (half ? a.inp(I_WEU) : a.inp(I_WEG)) : a.inp(I_WED));
    const unsigned wvo = (unsigned)((4 * kb * LDW + 4 * nb16) * 4);
    const int lw0 = (64 * half + 4 * nb16) * 128 + (((kb >> 1) ^ ((2 * nb16) & 7)) << 4) + (kb & 1) * 8, lw1 = lw0 ^ 16;
    const int rd_g = (tk >> 1) & 7;
    for (int vb = bid; vb < NEXP * NSLAB; vb += G) {
        const int xcd = vb & 7, idx = vb >> 3; const int e = xcd * 8 + idx / NSLAB, slab = idx % NSLAB;
        const int M = __builtin_amdgcn_readfirstlane(lc[LC_CNT / 4 + e]), row0 = __builtin_amdgcn_readfirstlane(lc[LC_PSTART / 4 + e]);
        const size_t wuo = (MODE == 0) ? ((size_t)(l * NEXP + e) * D * DEXP + slab * 64) * 4 : ((size_t)(l * NEXP + e) * DEXP * D + slab * 128 + 64 * half) * 4;
        const __amdgpu_buffer_rsrc_t wrs = __builtin_amdgcn_make_buffer_rsrc((void*)(wmat + wuo), 0, KD * LDW * 4, 0x00020000);
        const __amdgpu_buffer_rsrc_t xrs = __builtin_amdgcn_make_buffer_rsrc((MODE == 0) ? (void*)(ws + WS_U) : (void*)((const GAS char*)(ws + WS_HID) + (size_t)row0 * LDX * 2), 0, 0x7fffffff, 0x00020000);
        const int* el = (const int*)(ws + WS_ELIST) + (size_t)e * T;
        for (int rp = 0; rp < M; rp += 384) {
            unsigned xso[6];
#pragma unroll
            for (int i = 0; i < 6; ++i) { int tok = rp + wave * 48 + 8 * i + (lane >> 3); tok = min(tok, M - 1); if (VAR == 5) tok &= 15; if (MODE == 0) tok = el[tok]; xso[i] = (unsigned)(tok * LDX * 2 + (lane & 7) * 16); }
            LAS unsigned char* xw = lds + MS_XOFF + wave * MS_XWAVE; const int xwo = (lane >> 3) * 128 + (((lane & 7) ^ ((lane >> 4) & 3)) << 4);
            const LAS unsigned char* xr = lds + MS_XOFF + wave * MS_XWAVE + tk * 128 + ((q ^ rd_g) << 4);
            f32x4 acc[3][8];
#pragma unroll
            for (int mt = 0; mt < 3; ++mt)
#pragma unroll
                for (int j = 0; j < 8; ++j) acc[mt][j] = (f32x4){0.f, 0.f, 0.f, 0.f};
            f32x4 wr[2][4];
            bf16x8 xs[6];
#define MS_CL(t) (((t) < NT) ? (t) : NT - 1)
#define MS_WLOAD(set, t) do { _Pragma("unroll") for (int r_ = 0; r_ < 4; ++r_) wr[set][r_] = __builtin_bit_cast(f32x4, __builtin_amdgcn_raw_buffer_load_b128(wrs, (int)wvo + r_ * LDW * 4, MS_CL(t) * (64 * LDW * 4), 0)); } while (0)
#define MS_WCOMMIT(set, bufi) do { LAS unsigned char* wb_ = lds + (bufi) * MS_TILE; _Pragma("unroll") for (int i_ = 0; i_ < 4; ++i_) { \
            u32x2 p_; p_.x = pk2(wr[set][0][i_], wr[set][1][i_]); p_.y = pk2(wr[set][2][i_], wr[set][3][i_]); \
            *(LAS u32x2*)(wb_ + ((i_ < 2) ? lw0 : lw1) + i_ * 128) = p_; } } while (0)
#define MS_XSLOAD(t) do { _Pragma("unroll") for (int i_ = 0; i_ < 6; ++i_) xs[i_] = __builtin_bit_cast(bf16x8, __builtin_amdgcn_raw_buffer_load_b128(xrs, (int)xso[i_], MS_CL(t) * 128, 0)); } while (0)
#define MS_XSWRITE(bufi) do { _Pragma("unroll") for (int i_ = 0; i_ < 6; ++i_) *(LAS bf16x8*)(xw + (bufi) * MS_XBUF + i_ * 1024 + ((i_ & 1) ? (xwo ^ 64) : xwo)) = xs[i_]; } while (0)
#define MS_WF(dst, bufi, g) do { const LAS unsigned char* wb_ = lds + (bufi) * MS_TILE + tk * 128; _Pragma("unroll") for (int jj = 0; jj < 4; ++jj) \
            dst[jj] = *(const LAS bf16x8*)(wb_ + (16 * (4 * ((g) & 1) + jj)) * 128 + (((4 * ((g) >> 1) + q) ^ rd_g) << 4)); } while (0)
#define MS_XF(ks, bufi) do { _Pragma("unroll") for (int mt = 0; mt < 3; ++mt) xf[mt] = *(const LAS bf16x8*)(((ks) ? xr1 : xr) + (bufi) * MS_XBUF + mt * 2048); } while (0)
#define MS_MM(wf, g) do { _Pragma("unroll") for (int jj = 0; jj < 4; ++jj) _Pragma("unroll") for (int mt = 0; mt < 3; ++mt) \
            acc[mt][4 * ((g) & 1) + jj] = __builtin_amdgcn_mfma_f32_16x16x32_bf16(wf[jj], xf[mt], acc[mt][4 * ((g) & 1) + jj], 0, 0, 0); } while (0)
#define MS_COMPUTE(bufi) do { bf16x8 wf_[4], xf[3]; MS_XF(0, bufi); MS_WF(wf_, bufi, 0); __builtin_amdgcn_sched_barrier(0); MS_MM(wf_, 0); __builtin_amdgcn_sched_barrier(0); \
            MS_WF(wf_, bufi, 1); __builtin_amdgcn_sched_barrier(0); MS_MM(wf_, 1); __builtin_amdgcn_sched_barrier(0); MS_XF(1, bufi); MS_WF(wf_, bufi, 2); __builtin_amdgcn_sched_barrier(0); MS_MM(wf_, 2); \
            __builtin_amdgcn_sched_barrier(0); MS_WF(wf_, bufi, 3); __builtin_amdgcn_sched_barrier(0); MS_MM(wf_, 3); } while (0)
#define MS_STEP(I, J, t) do { MS_WCOMMIT(J, J); MS_WLOAD(J, (t) + 3); MS_COMPUTE(I); MS_XSWRITE(J); MS_XSLOAD((t) + 2); __syncthreads(); } while (0)
            const LAS unsigned char* xr1 = lds + MS_XOFF + wave * MS_XWAVE + tk * 128 + (((4 + q) ^ rd_g) << 4);
            __syncthreads();
            MS_XSLOAD(0); MS_WLOAD(0, 0); MS_WLOAD(1, 1);
            MS_WCOMMIT(0, 0); MS_WLOAD(0, 2);
            MS_XSWRITE(0); MS_XSLOAD(1);
            __syncthreads();
#pragma unroll 1
            for (int t = 0; t < NT; t += 2) { MS_STEP(0, 1, t); MS_STEP(1, 0, t + 1); }
#pragma unroll
            for (int mt = 0; mt < 3; ++mt) { const int tok = rp + wave * 48 + mt * 16 + tk;
                if (tok < M) {
                    if (MODE == 0) { bf16* o = (bf16*)(ws + o_hid) + (size_t)(row0 + tok) * DEXP + slab * 64 + 4 * q;
#pragma unroll
                        for (int j = 0; j < 4; ++j) { float h[4];
#pragma unroll
                            for (int i = 0; i < 4; ++i) { const float gt = acc[mt][j][i]; h[i] = gt * sigmoidf_(gt) * acc[mt][j + 4][i]; }
                            *(u32x2*)(o + 16 * j) = (u32x2){pk2(h[0], h[1]), pk2(h[2], h[3])}; }
                    } else { bf16* o = (bf16*)(ws + o_yr) + (size_t)(row0 + tok) * D + slab * 128 + 4 * q;
#pragma unroll
                        for (int j = 0; j < 8; ++j) *(u32x2*)(o + 16 * j) = (u32x2){pk2(acc[mt][j][0], acc[mt][j][1]), pk2(acc[mt][j][2], acc[mt][j][3])}; } } }
#undef MS_CL
#undef MS_XSLOAD
#undef MS_XSWRITE
#undef MS_XF
#undef MS_STEP
#undef MS_WLOAD
#undef MS_WCOMMIT
#undef MS_COMPUTE
#undef MS_WF
#undef MS_MM
        }
    }
}

constexpr int PH_PER_LAYER = 10, NPHASE = 1 + 2 * PH_PER_LAYER + 1;
__global__ void __launch_bounds__(NTHR, 2) mk_fwd(ArgsV argsv) {
    extern __shared__ __attribute__((aligned(16))) unsigned char lds_raw[];
    LAS unsigned char* lds = (LAS unsigned char*)lds_raw;
    Args args; args.p = (ArgsP)__builtin_amdgcn_kernarg_segment_ptr(); args.ws = (GAS unsigned char*)args.p->ws; args.out = (GAS float*)args.p->out;
    { const int tid0 = threadIdx.x; for (int u = tid0; u < (LDS_BYTES - LDSCTL_OFF) / 4; u += NTHR) ((LAS unsigned*)(lds + LDSCTL_OFF))[u] = 0u; }
    __syncthreads();
    XcdBarrier bar; bar.bar = (unsigned*)(args.ws + WS_CTL) + CW_BAR; bar.x = 0; bar.st = nullptr;
    const int lo = args.p->ph_lo, hi = args.p->ph_hi;
    if (hi - lo > 1) bar = xcd_barrier_post((unsigned*)(args.ws + WS_CTL) + CW_BAR, (volatile LAS unsigned*)(lds + LDSCTL_OFF + LC_BAR));
#ifndef PHMASK
#define PHMASK 0xffffffffu
#endif
#define PHBIT(k) ((k) == 0 ? 0 : ((k) == NPHASE - 1 ? 12 : 1 + ((k) - 1) % PH_PER_LAYER))
#define IN(k) (((PHMASK >> PHBIT(k)) & 1u) && lo <= (k) && (k) < hi)
#define SEAM(k) do { if (IN(k) && IN((k) + 1)) xcd_barrier(bar); } while (0)
#define PH_BEGIN() int tid = threadIdx.x; asm volatile("" : "+v"(tid)); Args a = args; asm volatile("" : "+s"(a.p), "+s"(a.ws), "+s"(a.out)); unsigned char* ws = (unsigned char*)a.ws; \
    const int lane = tid & 63, wave = __builtin_amdgcn_readfirstlane(tid >> 6); int G = gridDim.x, bid = blockIdx.x; asm volatile("" : "+s"(G), "+s"(bid)); const int gw = bid * NWAVES + wave, NGW = G * NWAVES; (void)lane; (void)gw; (void)NGW; (void)ws

#ifndef PROBE_DUP
#define PROBE_DUP 0u
#endif
#define DUP(bit) if constexpr (((PROBE_DUP >> (bit)) & 1u) != 0u)
    enum { PB_CONVERT = 0, PB_NORM0, PB_GEMM1, PB_VT, PB_RWKVPREP, PB_SCAN, PB_ATTN, PB_POST, PB_BRANCH, PB_GATHER, PB_MOEK, PB_MOEL, PB_FINAL, PB_WOUT, PB_ROUTER, PB_MOEK_COLD, PB_MOEL_COLD, PB_MK5, PB_CKA, PB_CKB, PB_CKC };

    if (IN(0)) { { PH_BEGIN(); phase_convert<2>(a, 0, lds, gw, NGW, wave, lane); } DUP(PB_CONVERT) { PH_BEGIN(); phase_convert<2>(a, 0, lds, gw, NGW, wave, lane); } } SEAM(0);

#pragma unroll 1
    for (int l = 0; l < 2; ++l) {
        const int pb = 1 + l * PH_PER_LAYER;
        if (IN(pb + 0)) { { PH_BEGIN(); phase_norm<0>(a, a.inp(I_NORM_MIX) + (size_t)l * D, l > 0, l - 1, lds, tid, gw, NGW, lane, (l == 0) ? a.inp(I_X) : nullptr, a.inp(I_META)); }
            DUP(PB_NORM0) { if (l == 0) { PH_BEGIN(); phase_norm<0>(a, a.inp(I_NORM_MIX) + (size_t)l * D, false, 0, lds, tid, gw, NGW, lane, a.inp(I_X), a.inp(I_META)); } } } SEAM(pb + 0);
#define RUN_GEMM1() { PH_BEGIN(); pg8::RectOrder S; S.init(ws + WS_U, (const bf16*)(ws + WS_W1T) + (size_t)l * NZ * D, D, D, TP / 256, NZ / 256, G, bid); \
            pg8::EpiBf16 E{(bf16*)(ws + WS_Z), NZ, (const float*)(ws + WS_BIAS) + (size_t)l * NZ}; \
            pg8::gemm_phase<pg8::EpiBf16, pg8::RectOrder>(lds, pg8::Dims{D, D, D / 64}, S, E); }
        if (IN(pb + 1)) { RUN_GEMM1(); DUP(PB_GEMM1) RUN_GEMM1();
            if (l == 0) { PH_BEGIN(); const int nfull = (TP / 256) * (NZ / 256) % G; if (nfull != 0 && bid >= nfull) phase_convert<0>(a, 1, lds, (bid - nfull) * NWAVES + wave, (G - nfull) * NWAVES, wave, lane);
                          else if (nfull == 0) phase_convert<0>(a, 1, lds, gw, NGW, wave, lane); } } SEAM(pb + 1);
        if (IN(pb + 2)) { { PH_BEGIN(); phase_rope(a, gw, NGW, lane); } { PH_BEGIN(); phase_vt(a, gw, NGW, lane); } DUP(PB_VT) { PH_BEGIN(); phase_vt(a, gw, NGW, lane); }
            { PH_BEGIN(); phase_rwkvprep(a, l, lds, tid, gw, NGW, lane); } DUP(PB_RWKVPREP) { PH_BEGIN(); phase_rwkvprep(a, l, lds, tid, gw, NGW, lane); } } SEAM(pb + 2);
        if (IN(pb + 3)) { { PH_BEGIN(); phase_chunkA(a, lds, wave, lane, tid, bid, G); } DUP(PB_CKA) { PH_BEGIN(); phase_chunkA(a, lds, wave, lane, tid, bid, G); }
            { PH_BEGIN(); phase_attn(a, l, gw, NGW, lane); } DUP(PB_ATTN) { PH_BEGIN(); phase_attn(a, l, gw, NGW, lane); }
            xcd_barrier(bar);
            { PH_BEGIN(); phase_chunkB(a, lds, wave, lane, bid, G); if (wave != 0) phase_convert<1>(a, l, lds, bid * (NWAVES - 1) + wave - 1, G * (NWAVES - 1), wave, lane); }
            DUP(PB_CKB) { PH_BEGIN(); phase_chunkB(a, lds, wave, lane, bid, G); } xcd_barrier(bar);
            { PH_BEGIN(); phase_chunkC(a, l, gw, NGW, lane); } DUP(PB_CKC) { PH_BEGIN(); phase_chunkC(a, l, gw, NGW, lane); } }
        SEAM(pb + 3);
#define RUN_BRANCH() { \
            { PH_BEGIN(); pg8::RectOrder S; S.init(ws + WS_OATT, (const bf16*)(ws + WS_WAT) + (size_t)l * D * C, C, C, MBIG / 256, D / 256, G, bid); \
              pg8::EpiGate E{(bf16*)(ws + WS_T1), (const bf16*)(ws + WS_Z), ZGA, nullptr}; \
              pg8::gemm_phase<pg8::EpiGate, pg8::RectOrder>(lds, pg8::Dims{C, C, C / 64}, S, E); \
              skinny64((const bf16*)(ws + WS_OATT), C, (const bf16*)(ws + WS_WAT) + (size_t)l * D * C, C, D, C, MBIG, lds, SkGate{(bf16*)(ws + WS_T1), (const bf16*)(ws + WS_Z), ZGA, nullptr}, wave, lane, bid, G); } \
            { PH_BEGIN(); pg8::RectOrder S; S.init(ws + WS_ORW, (const bf16*)(ws + WS_WRT) + (size_t)l * D * C, C, C, MBIG / 256, D / 256, G, bid); \
              pg8::EpiGate E{(bf16*)(ws + WS_MIX), (const bf16*)(ws + WS_Z), ZGR, (const bf16*)(ws + WS_T1)}; \
              pg8::gemm_phase<pg8::EpiGate, pg8::RectOrder>(lds, pg8::Dims{C, C, C / 64}, S, E); \
              skinny64((const bf16*)(ws + WS_ORW), C, (const bf16*)(ws + WS_WRT) + (size_t)l * D * C, C, D, C, MBIG, lds, SkGate{(bf16*)(ws + WS_MIX), (const bf16*)(ws + WS_Z), ZGR, (const bf16*)(ws + WS_T1)}, wave, lane, bid, G); } }
        if (IN(pb + 5)) { RUN_BRANCH(); DUP(PB_BRANCH) RUN_BRANCH(); } SEAM(pb + 5);
#define RUN_WOUT(HP) { PH_BEGIN(); pg8::RectOrder S; S.init(ws + WS_MIX, (const bf16*)(ws + WS_WOT) + (size_t)l * D * D, D, D, MBIG / 256, D / 256, G, bid); \
            pg8::EpiResAdd E{(float*)(ws + (HP)), (l == 0) ? a.inp(I_X) : nullptr, a.inp(I_META)}; \
            pg8::gemm_phase<pg8::EpiResAdd, pg8::RectOrder>(lds, pg8::Dims{D, D, D / 64}, S, E); \
            skinny64((const bf16*)(ws + WS_MIX), D, (const bf16*)(ws + WS_WOT) + (size_t)l * D * D, D, D, D, MBIG, lds, SkRes{(float*)(ws + (HP)), (l == 0) ? a.inp(I_X) : nullptr, a.inp(I_META)}, wave, lane, bid, G); }
        if (IN(pb + 6)) { RUN_WOUT(WS_H); DUP(PB_WOUT) RUN_WOUT(WS_YR); } SEAM(pb + 6);
        if (IN(pb + 7)) { { PH_BEGIN(); phase_router(a, l, lds, wave, lane, bid, G); } DUP(PB_ROUTER) { PH_BEGIN(); phase_router(a, l, lds, wave, lane, bid, G, true); } } SEAM(pb + 7);
        if (IN(pb + 8)) { { PH_BEGIN(); moe_stream_phase<0>(a, l, lds, wave, lane, tid, bid, G); } DUP(PB_MOEK) { PH_BEGIN(); moe_stream_phase<0>(a, l, lds, wave, lane, tid, bid, G); }
            DUP(PB_MOEK_COLD) { PH_BEGIN(); moe_stream_phase<0>(a, l, lds, wave, lane, tid, bid, G, 1 - l, WS_T1); }
            DUP(PB_MK5) { PH_BEGIN(); moe_stream_phase<0, 5>(a, l, lds, wave, lane, tid, bid, G, 1 - l, WS_T1); } } SEAM(pb + 8);
        if (IN(pb + 9)) { { PH_BEGIN(); moe_stream_phase<1>(a, l, lds, wave, lane, tid, bid, G); } DUP(PB_MOEL) { PH_BEGIN(); moe_stream_phase<1>(a, l, lds, wave, lane, tid, bid, G); }
            DUP(PB_MOEL_COLD) { PH_BEGIN(); moe_stream_phase<1>(a, l, lds, wave, lane, tid, bid, G, 1 - l, WS_XR); } } SEAM(pb + 9);
    }
    if (IN(NPHASE - 1)) { { PH_BEGIN(); phase_norm<1>(a, a.inp(I_NORM_FINAL), true, 1, lds, tid, gw, NGW, lane); } DUP(PB_FINAL) { PH_BEGIN(); phase_norm<1>(a, a.inp(I_NORM_FINAL), true, 1, lds, tid, gw, NGW, lane); } }
#undef IN
#undef SEAM
}

extern "C" void kernel_launch(void* const* d_in, const int* in_sizes, int n_in, void* d_out, int out_size, void* d_ws, size_t ws_size, hipStream_t stream) {
    static int grid = 0;
    if (grid == 0) {
        if (n_in != 33 || ws_size < WS_END) { fprintf(stderr, "kernel_launch: need 33 inputs and %zu bytes of workspace (got %d, %zu)\n", (size_t)WS_END, n_in, ws_size); grid = -1; return; }
        int dev = 0, cus = 0, per_cu = 0;
        if (hipGetDevice(&dev) != hipSuccess || hipDeviceGetAttribute(&cus, hipDeviceAttributeMultiprocessorCount, dev) != hipSuccess) { grid = -1; return; }
        if (hipFuncSetAttribute((const void*)mk_fwd, hipFuncAttributeMaxDynamicSharedMemorySize, LDS_BYTES) != hipSuccess) { fprintf(stderr, "kernel_launch: hipFuncSetAttribute failed\n"); grid = -1; return; }
        if (hipOccupancyMaxActiveBlocksPerMultiprocessor(&per_cu, (const void*)mk_fwd, NTHR, LDS_BYTES) != hipSuccess || per_cu < 1) fprintf(stderr, "kernel_launch: occupancy query says %d\n", per_cu);
        (void)hipGetLastError();
        grid = cus;
    }
    if (grid < 0) return;
    (void)hipMemsetAsync((char*)d_ws + WS_CTL, 0, 128 * 1024, stream);
    ArgsV a{};
    for (int i = 0; i < 33; ++i) a.in[i] = (const float*)d_in[i];
    a.out = (float*)d_out; a.ws = (unsigned char*)d_ws;
#if MK_N_LAUNCHES == 1
    a.ph_lo = 0; a.ph_hi = NPHASE;
    hipLaunchKernelGGL(mk_fwd, dim3(grid), dim3(NTHR), LDS_BYTES, stream, a);
#else
    for (int p = 0; p < NPHASE; ++p) { a.ph_lo = p; a.ph_hi = p + 1; hipLaunchKernelGGL(mk_fwd, dim3(grid), dim3(NTHR), LDS_BYTES, stream, a); }
#endif
}
```

```cpp
#include <hip/hip_runtime.h>
#include <cstdio>
#include <cstdint>

#ifndef MK_N_LAUNCHES
#define MK_N_LAUNCHES 1
#endif

#define GAS __attribute__((address_space(1)))
#define LAS __attribute__((address_space(3)))
typedef unsigned short bf16;
typedef short bf16x8 __attribute__((ext_vector_type(8)));
typedef float f32x4 __attribute__((ext_vector_type(4)));
typedef float f32x2 __attribute__((ext_vector_type(2)));
typedef float f32x16 __attribute__((ext_vector_type(16)));
typedef unsigned u32x4 __attribute__((ext_vector_type(4)));
typedef unsigned u32x2 __attribute__((ext_vector_type(2)));
typedef __bf16 bf16x2_t __attribute__((ext_vector_type(2)));
typedef GAS unsigned gu32;
#define RLX_AGENT __ATOMIC_RELAXED, __HIP_MEMORY_SCOPE_AGENT
#define DI __device__ __forceinline__

constexpr int D = 2048, NB = 4, SEQ = 2048, NMETA = 16, L = SEQ + NMETA, T = NB * L  , TP = 8448  ;
constexpr int NIN = 8896, NZ = 8960  ;
constexpr int ZQ = 0, ZK = 1024, ZV = 1280, ZGA = 1536, ZGR = 3584, ZR0 = 5632, ZVD = 8896;
constexpr int C = 1024, NH = 16, HD = 64;
constexpr int NEXP = 64, DEXP = 512, PR = 128 * 256;
constexpr int LPAD = 2080;
constexpr float NORM_EPS = 1e-5f, GN_EPS = 64e-5f;
constexpr int NWAVES = 8, NTHR = 512;
constexpr int MBIG = 8192;
static_assert(T - MBIG == 64, "skinny64 covers exactly 64 rows");

constexpr size_t al256(size_t x) { return (x + 255) & ~(size_t)255; }
constexpr size_t WS_CTL = 0, CTL_BYTES = 1u << 20;
constexpr size_t WS_H = WS_CTL + CTL_BYTES;
constexpr size_t WS_U = WS_H + (size_t)TP * D * 4;
constexpr size_t WS_Z = WS_U + (size_t)TP * D * 2;
constexpr size_t WS_R = WS_Z + (size_t)TP * NZ * 2;
constexpr size_t SZ_TC = (size_t)T * C * 4;
constexpr size_t WS_W = WS_R + SZ_TC, WS_K = WS_W + SZ_TC, WS_V = WS_K + SZ_TC, WS_KK = WS_V + SZ_TC, WS_B = WS_KK + SZ_TC;
constexpr size_t WS_Y = WS_B + SZ_TC, WS_VF = WS_Y + SZ_TC, WS_G = WS_VF + SZ_TC;
constexpr size_t WS_RK = WS_G + SZ_TC;
constexpr size_t WS_VT = al256(WS_RK + (size_t)T * NH * 4);
constexpr size_t WS_OATT = al256(WS_VT + (size_t)NB * 4 * HD * LPAD * 2);
constexpr size_t WS_ORW = WS_OATT + (size_t)TP * C * 2;
constexpr size_t WS_T1 = WS_ORW + (size_t)TP * C * 2;
constexpr size_t WS_MIX = WS_T1 + (size_t)TP * D * 2;
constexpr size_t WS_XR = WS_MIX + (size_t)TP * D * 2;
constexpr size_t WS_HID = WS_XR + (size_t)PR * D * 2;
constexpr size_t WS_YR = WS_HID + (size_t)PR * DEXP * 2;
constexpr size_t WS_TOKE = WS_YR + (size_t)PR * D * 2;
constexpr size_t WS_TOKS = al256(WS_TOKE + (size_t)T * 2 * 4);
constexpr size_t WS_TOKW = al256(WS_TOKS + (size_t)T * 2 * 4);
constexpr size_t WS_ELIST = al256(WS_TOKW + (size_t)T * 2 * 4);
constexpr size_t WS_ROPE = al256(WS_ELIST + (size_t)NEXP * T * 4);
constexpr size_t WS_BIAS = al256(WS_ROPE + (size_t)L * 16 * 4);
constexpr size_t WS_W1T = al256(WS_BIAS + (size_t)2 * NZ * 4);
constexpr size_t WS_WAT = WS_W1T + (size_t)2 * NZ * D * 2;
constexpr size_t WS_WRT = WS_WAT + (size_t)2 * D * C * 2;
constexpr size_t WS_WOT = WS_WRT + (size_t)2 * D * C * 2;
constexpr size_t WS_WRO = WS_WOT + (size_t)2 * D * D * 2;
constexpr size_t WS_LDEC = WS_WRO + (size_t)2 * 80 * D * 2;
constexpr size_t WS_LICL = WS_LDEC + (size_t)2 * C * 64 * 2;
constexpr size_t WS_LGAT = WS_LICL + (size_t)2 * C * 64 * 2;
constexpr size_t WS_LVUP = WS_LGAT + (size_t)2 * C * 64 * 2;
constexpr size_t WS_END = WS_LVUP + (size_t)C * 32 * 2;
constexpr int CW_TMO = 0, CW_BAR = 4096, CW_CNT = 16384;

constexpr int RING_BYTES = 131072, LDSCTL_OFF = RING_BYTES, LDS_BYTES = 147456;
constexpr int LC_BAR = 0, LC_NTILE = 16, LC_TILEE = 32  , LC_PSTART = 32 + 512  , LC_CNT = LC_PSTART + 256  ;

DI unsigned pk2(float a, float b) { f32x2 v = {a, b}; bf16x2_t r = __builtin_convertvector(v, bf16x2_t); return __builtin_bit_cast(unsigned, r); }
DI float bf2f(unsigned short b) { return __builtin_bit_cast(float, (unsigned)b << 16); }
DI float bflo(unsigned u) { return __builtin_bit_cast(float, u << 16); }
DI float bfhi(unsigned u) { return __builtin_bit_cast(float, u & 0xffff0000u); }
DI float wave_sum(float v) {
#pragma unroll
    for (int o = 1; o < 64; o <<= 1) v += __shfl_xor(v, o);
    return v;
}
DI float sigmoidf_(float x) { return 1.f / (1.f + __expf(-x)); }
#define LDS_WAIT() asm volatile("s_waitcnt lgkmcnt(0)" ::: "memory")
#define VM_WAIT() asm volatile("s_waitcnt vmcnt(0)" ::: "memory")

#define XB_TMO      128
#define XB_XCNT(j)  (256  + 64 * (j))
#define XB_XSUB(j)  (1280 + 64 * (j))
#define XB_XGEN(j)  (2304 + 64 * (j))
#define XB_TOP      3328
#define XB_TOPGEN   3392
#define XCD_BAR_WORDS 3456
#define XB_SPIN_CAP (1u << 22)

__device__ __forceinline__ unsigned xb_ld(unsigned* p)              { return __hip_atomic_load(p, __ATOMIC_RELAXED, __HIP_MEMORY_SCOPE_AGENT); }
__device__ __forceinline__ unsigned xb_add(unsigned* p, unsigned v) { return __hip_atomic_fetch_add(p, v, __ATOMIC_RELAXED, __HIP_MEMORY_SCOPE_AGENT); }
__device__ __forceinline__ unsigned xb_xcc_id() { return (unsigned)__builtin_amdgcn_s_getreg((3 << 11) | 20) & 0xFu; }
#define XB_SPIN(cond, bar) do { unsigned _sp = 0; while (cond) { __builtin_amdgcn_s_sleep(1); \
    if ((++_sp & 255u) == 0u) { if (xb_ld(&(bar)[XB_TMO])) break; if (_sp > XB_SPIN_CAP) { atomicAdd(&(bar)[XB_TMO], 1u); break; } } } } while (0)

struct XcdBarrier { unsigned* bar; unsigned x; volatile LAS unsigned* st; };

__device__ __forceinline__ XcdBarrier xcd_barrier_post(unsigned* bar, volatile LAS unsigned* st) {
    XcdBarrier b; b.bar = bar; b.x = xb_xcc_id(); b.st = st;
    if (threadIdx.x == 0) (void)xb_add(&bar[XB_XCNT(b.x)], 1u);
    return b;
}
__device__ __forceinline__ void xcd_barrier_complete(unsigned* bar, unsigned x, unsigned& nloc, unsigned& nx) {
    const unsigned G = gridDim.x * gridDim.y * gridDim.z;
    unsigned sum, cnt, mine, sp = 0u;
    for (;;) {
        sum = 0u; cnt = 0u; mine = 0u;
#pragma unroll
        for (unsigned j = 0; j < 16; ++j) { const unsigned c = xb_ld(&bar[XB_XCNT(j)]); sum += c; cnt += (c > 0u) ? 1u : 0u; mine = (j == x) ? c : mine; }
        if (sum == G) break;
        __builtin_amdgcn_s_sleep(1);
        if ((++sp & 255u) == 0u) { if (xb_ld(&bar[XB_TMO])) break; if (sp > XB_SPIN_CAP) { atomicAdd(&bar[XB_TMO], 1u); break; } }
    }
    nloc = mine > 0u ? mine : 1u; nx = cnt > 0u ? cnt : 1u;
}
__device__ __forceinline__ void xcd_barrier(const XcdBarrier& b) {
    asm volatile("s_waitcnt vmcnt(0)" ::: "memory");
    __syncthreads();
    if (threadIdx.x == 0) {
        unsigned* bar = b.bar;
        __builtin_amdgcn_s_waitcnt(0);
        unsigned nloc = b.st[0], nx = b.st[1];
        if (nloc == 0u) { xcd_barrier_complete(bar, b.x, nloc, nx); b.st[0] = nloc; b.st[1] = nx; }
        const unsigned old = xb_add(&bar[XB_XSUB(b.x)], 1u);
        const unsigned gen = old / nloc;
        if (old + 1u == (gen + 1u) * nloc) {
            __builtin_amdgcn_fence(__ATOMIC_RELEASE, "agent");
            asm volatile("s_waitcnt vmcnt(0)" ::: "memory");
            const unsigned og = xb_add(&bar[XB_TOP], 1u);
            const unsigned tg = og / nx;
            if (og + 1u == (tg + 1u) * nx) xb_add(&bar[XB_TOPGEN], 1u);
            else XB_SPIN(xb_ld(&bar[XB_TOPGEN]) == tg, bar);
            __builtin_amdgcn_fence(__ATOMIC_ACQUIRE, "agent");
            xb_add(&bar[XB_XGEN(b.x)], 1u);
            asm volatile("s_waitcnt vmcnt(0)" ::: "memory");
        } else {
            XB_SPIN(xb_ld(&bar[XB_XGEN(b.x)]) == gen, bar);
            __builtin_amdgcn_fence(__ATOMIC_ACQUIRE, "agent");
            asm volatile("s_waitcnt vmcnt(0)" ::: "memory");
        }
    }
    __syncthreads();
}

DI const float* resid_row(const float* H, const float* x, const float* meta, int m) {
    if (!x) return H + (size_t)m * D;
    const int b = m / L, t = m - b * L; return (t < NMETA) ? meta + (size_t)t * D : x + ((size_t)b * SEQ + (t - NMETA)) * D;
}
namespace pg8 {
constexpr int BM = 256, BK = 64, HALF = 128, HTB = HALF * BK * 2, STAGE_BYTES = 8 * HTB, NXCD = 8, WGM = 8;
__host__ __device__ __forceinline__ int lds_byte(int r, int c) { const int st = (r >> 4) * 2 + (c >> 5), rr = r & 15, cc = c & 31, ob = rr * 64 + cc * 2; return st * 1024 + (ob ^ (((ob >> 9) & 1) << 5)); }
__host__ __device__ __forceinline__ void stage_rc(int b, int& R, int& Cc) { const int st = b / 1024, sb = b % 1024, swz = sb ^ (((sb >> 9) & 1) << 5); R = (st >> 1) * 16 + swz / 64; Cc = (st & 1) * 32 + (swz % 64) / 2; }
__host__ __device__ __forceinline__ int perm32(int rho) { const int n = rho >> 4, i = rho & 15; return 8 * (i >> 2) + 4 * n + (i & 3); }

struct Unit { const char* A; const char* B; int pm, pn; };
struct Dims { int lda, ldb, nt; };

struct RectOrder {
    const char* A; const char* B; int lda, ldb; int nM, nN, nwg, G, c;
    __device__ void init(const void* A_, const void* B_, int lda_, int ldb_, int nM_, int nN_, int G_, int c_) { A = (const char*)A_; B = (const char*)B_; lda = lda_; ldb = ldb_; nM = nM_; nN = nN_; nwg = nM * nN; G = G_; c = c_; }
    __device__ bool next(int i, Unit& u) const {
        const long Lx = (long)i * G + c; if (Lx >= nwg) return false;
        int wgid = (int)Lx; { const int q = nwg / NXCD, r = nwg % NXCD, xcd = wgid % NXCD, off = wgid / NXCD; wgid = (xcd < r ? xcd * (q + 1) : r * (q + 1) + (xcd - r) * q) + off; }
        const int nig = WGM * nN, gid = wgid / nig, fm = gid * WGM, gsz = (nM - fm) < WGM ? (nM - fm) : WGM;
        u.pm = fm + ((wgid % nig) % gsz); u.pn = (wgid % nig) / gsz;
        u.A = A + (size_t)u.pm * BM * lda * 2; u.B = B + (size_t)u.pn * BM * ldb * 2; return true;
    }
};
template <class Epi, class Sched, bool ALIGN_EPI = true, bool SP2 = true>
__device__ __forceinline__ void gemm_phase(LAS unsigned char* lds, const Dims g, const Sched& S, const Epi& E) {
    int tid = threadIdx.x; asm volatile("" : "+v"(tid));
    const int wid = __builtin_amdgcn_readfirstlane(tid >> 6), lane = tid & 63, wr = wid >> 2, wc = wid & 3, fr = lane & 15, fq = lane >> 4;
    const int nt = g.nt;
    unsigned voffA[2], voffB[2];
#pragma unroll
    for (int i = 0; i < 2; ++i) { int R, Cc; stage_rc(tid * 16 + i * 8192, R, Cc); const int Rb = Epi::PERM ? ((R & ~31) + perm32(R & 31)) : R;
        voffA[i] = (unsigned)(R * g.lda + Cc) * 2u; voffB[i] = (unsigned)(Rb * g.ldb + Cc) * 2u; }
    const size_t kstep = (size_t)(BK * 2);
    const size_t hstepA = (size_t)HALF * g.lda * 2, hstepB = (size_t)HALF * g.ldb * 2;
    const unsigned ldsw = (unsigned)wid * 1024u;
    const int aoff = lds_byte(wr * 64 + fr, fq * 8), boff = lds_byte(wc * 32 + fr, fq * 8);
#define PG8_SA(b, h) (((b) * 2 + (h)) * HTB)
#define PG8_SB(b, h) ((4 + (b) * 2 + (h)) * HTB)
#define PG8_STAGE(bufoff, gbase, voff) do { _Pragma("unroll") for (int _i = 0; _i < 2; ++_i) \
        __builtin_amdgcn_global_load_lds((const unsigned*)((const char*)(gbase) + (voff)[_i]), (LAS unsigned*)(lds + (bufoff) + ldsw + _i * 8192), 16, 0, 0); } while (0)
#define PG8_LDA(dst, b, h) do { _Pragma("unroll") for (int m = 0; m < 4; ++m) _Pragma("unroll") for (int k = 0; k < 2; ++k) dst[m][k] = *(const LAS bf16x8*)(lds + PG8_SA(b, h) + aoff + m * 2048 + k * 1024); } while (0)
#define PG8_LDB(dst, b, h) do { _Pragma("unroll") for (int n = 0; n < 2; ++n) _Pragma("unroll") for (int k = 0; k < 2; ++k) dst[n][k] = *(const LAS bf16x8*)(lds + PG8_SB(b, h) + boff + n * 2048 + k * 1024); } while (0)
#define PG8_MMA(ai, bj, At, Bt) do { __builtin_amdgcn_s_setprio(1); _Pragma("unroll") for (int m = 0; m < 4; ++m) _Pragma("unroll") for (int n = 0; n < 2; ++n) _Pragma("unroll") for (int k = 0; k < 2; ++k) \
        acc[ai][bj][m][n] = __builtin_amdgcn_mfma_f32_16x16x32_bf16(Bt[n][k], At[m][k], acc[ai][bj][m][n], 0, 0, 0); __builtin_amdgcn_s_setprio(0); } while (0)
#define PG8_WAIT_V(n) asm volatile("s_waitcnt vmcnt(" #n ")" ::: "memory")
#define PG8_WAIT_L(n) asm volatile("s_waitcnt lgkmcnt(" #n ")" ::: "memory")
#define PG8_BAR __builtin_amdgcn_s_barrier()
#define PG8_SCHED __builtin_amdgcn_sched_barrier(0)
    Unit cur, nxt; int ui = 0;
    if (!S.next(0, cur)) return;
    f32x4 acc[2][2][4][2];
#pragma unroll
    for (int a = 0; a < 2; ++a)
#pragma unroll
        for (int b = 0; b < 2; ++b)
#pragma unroll
            for (int m = 0; m < 4; ++m)
#pragma unroll
                for (int n = 0; n < 2; ++n) acc[a][b][m][n] = (f32x4){0.f, 0.f, 0.f, 0.f};
    bf16x8 At[4][2], B0[2][2], B1[2][2];
    const char* cA = cur.A; const char* cB = cur.B;
    if constexpr (SP2) {
        PG8_STAGE(PG8_SB(0, 0), cB, voffB); PG8_STAGE(PG8_SB(0, 1), cB + hstepB, voffB); PG8_STAGE(PG8_SA(0, 0), cA, voffA); PG8_STAGE(PG8_SA(0, 1), cA + hstepA, voffA);
        if (wr == 1) PG8_BAR;
        PG8_WAIT_V(2); PG8_BAR;
        PG8_STAGE(PG8_SB(1, 0), cB + kstep, voffB); PG8_STAGE(PG8_SA(1, 0), cA + kstep, voffA); PG8_STAGE(PG8_SB(1, 1), cB + hstepB + kstep, voffB);
        PG8_WAIT_V(6); PG8_BAR;
    } else {
        PG8_STAGE(PG8_SB(0, 0), cB, voffB); PG8_STAGE(PG8_SA(0, 0), cA, voffA); PG8_STAGE(PG8_SB(0, 1), cB + hstepB, voffB); PG8_STAGE(PG8_SA(0, 1), cA + hstepA, voffA);
        if (wr == 1) PG8_BAR;
        PG8_WAIT_V(4); PG8_BAR;
        PG8_STAGE(PG8_SB(1, 0), cB + kstep, voffB); PG8_STAGE(PG8_SA(1, 0), cA + kstep, voffA); PG8_STAGE(PG8_SB(1, 1), cB + hstepB + kstep, voffB);
        PG8_WAIT_V(6); PG8_BAR;
    }
    for (;;) {
        const bool has_next = S.next(ui + 1, nxt);
        const char* nA = has_next ? nxt.A : cA; const char* nB = has_next ? nxt.B : cB;
        for (int t = 0; t < nt; t += 2) {
            const bool last = (t == nt - 2);
            const char* a1 = cA + (size_t)(t + 1) * kstep;
            const char* a2 = last ? nA : cA + (size_t)(t + 2) * kstep; const char* b2 = last ? nB : cB + (size_t)(t + 2) * kstep;
            const char* a3 = a2 + kstep; const char* b3 = b2 + kstep;
            if constexpr (SP2) {
            PG8_LDB(B0, 0, 0); PG8_LDB(B1, 0, 1); PG8_SCHED; PG8_LDA(At, 0, 0); PG8_STAGE(PG8_SA(1, 1), a1 + hstepA, voffA);
            PG8_WAIT_V(8); PG8_WAIT_L(0); PG8_BAR; PG8_MMA(0, 0, At, B0); PG8_MMA(0, 1, At, B1); PG8_BAR; PG8_SCHED;
            PG8_LDA(At, 0, 1); PG8_STAGE(PG8_SB(0, 0), b2, voffB); PG8_STAGE(PG8_SB(0, 1), b2 + hstepB, voffB); PG8_STAGE(PG8_SA(0, 0), a2, voffA);
            PG8_WAIT_V(8); PG8_WAIT_L(0); PG8_BAR; PG8_MMA(1, 0, At, B0); PG8_MMA(1, 1, At, B1); PG8_BAR; PG8_SCHED;
            PG8_LDB(B0, 1, 0); PG8_LDB(B1, 1, 1); PG8_SCHED; PG8_LDA(At, 1, 0); PG8_STAGE(PG8_SA(0, 1), a2 + hstepA, voffA);
            PG8_WAIT_V(8); PG8_WAIT_L(0); PG8_BAR; PG8_MMA(0, 0, At, B0); PG8_MMA(0, 1, At, B1); PG8_BAR; PG8_SCHED;
            PG8_LDA(At, 1, 1); PG8_STAGE(PG8_SB(1, 0), b3, voffB); PG8_STAGE(PG8_SB(1, 1), b3 + hstepB, voffB); PG8_STAGE(PG8_SA(1, 0), a3, voffA);
            PG8_WAIT_V(8); PG8_WAIT_L(0); PG8_BAR; PG8_MMA(1, 0, At, B0); PG8_MMA(1, 1, At, B1); PG8_BAR; PG8_SCHED;
            } else {
            PG8_LDB(B0, 0, 0); PG8_SCHED; PG8_LDA(At, 0, 0); PG8_STAGE(PG8_SA(1, 1), a1 + hstepA, voffA);
            PG8_WAIT_L(8); PG8_BAR; PG8_WAIT_L(0); PG8_MMA(0, 0, At, B0); PG8_BAR; PG8_SCHED;
            PG8_LDB(B1, 0, 1); PG8_STAGE(PG8_SB(0, 0), b2, voffB);
            PG8_BAR; PG8_WAIT_L(0); PG8_MMA(0, 1, At, B1); PG8_BAR;
            PG8_LDA(At, 0, 1); PG8_STAGE(PG8_SA(0, 0), a2, voffA);
            PG8_BAR; PG8_WAIT_L(0); PG8_MMA(1, 0, At, B0); PG8_BAR; PG8_SCHED;
            PG8_STAGE(PG8_SB(0, 1), b2 + hstepB, voffB);
            PG8_WAIT_V(6); PG8_BAR; PG8_MMA(1, 1, At, B1); PG8_BAR;
            PG8_LDB(B0, 1, 0); PG8_SCHED; PG8_LDA(At, 1, 0); PG8_STAGE(PG8_SA(0, 1), a2 + hstepA, voffA);
            PG8_WAIT_L(8); PG8_BAR; PG8_WAIT_L(0); PG8_MMA(0, 0, At, B0); PG8_BAR; PG8_SCHED;
            PG8_LDB(B1, 1, 1); PG8_STAGE(PG8_SB(1, 0), b3, voffB);
            PG8_BAR; PG8_WAIT_L(0); PG8_MMA(0, 1, At, B1); PG8_BAR;
            PG8_LDA(At, 1, 1); PG8_STAGE(PG8_SA(1, 0), a3, voffA);
            PG8_BAR; PG8_WAIT_L(0); PG8_MMA(1, 0, At, B0); PG8_BAR; PG8_SCHED;
            PG8_STAGE(PG8_SB(1, 1), b3 + hstepB, voffB);
            PG8_WAIT_V(6); PG8_BAR; PG8_MMA(1, 1, At, B1); PG8_BAR;
            }
        }
        if constexpr (ALIGN_EPI) { if (wr == 0) PG8_BAR; }
        E(acc, cur, wr, wc, fr, fq);
        if (!has_next) break;
#pragma unroll
        for (int a = 0; a < 2; ++a)
#pragma unroll
            for (int b = 0; b < 2; ++b)
#pragma unroll
                for (int m = 0; m < 4; ++m)
#pragma unroll
                    for (int n = 0; n < 2; ++n) acc[a][b][m][n] = (f32x4){0.f, 0.f, 0.f, 0.f};
        cur = nxt; cA = nA; cB = nB; ++ui;
        if constexpr (ALIGN_EPI) { if (wr == 1) PG8_BAR; }
    }
    PG8_WAIT_V(0);
    if constexpr (!ALIGN_EPI) { if (wr == 0) PG8_BAR; }
    PG8_BAR;
#undef PG8_SA
#undef PG8_SB
#undef PG8_STAGE
#undef PG8_LDA
#undef PG8_LDB
#undef PG8_MMA
#undef PG8_WAIT_V
#undef PG8_WAIT_L
#undef PG8_BAR
#undef PG8_SCHED
}

struct EpiBf16 {
    static constexpr bool PERM = true;
    bf16* O; int ldc; const float* bias;
    DI void operator()(const f32x4 (&acc)[2][2][4][2], const Unit& u, int wr, int wc, int fr, int fq) const {
        const int row0 = u.pm * BM + wr * 64 + fr, col0 = u.pn * BM + wc * 32 + 8 * fq;
        f32x4 bv[2][2];
#pragma unroll
        for (int bj = 0; bj < 2; ++bj)
#pragma unroll
            for (int n = 0; n < 2; ++n) bv[bj][n] = bias ? *(const f32x4*)(bias + col0 + bj * HALF + 4 * n) : (f32x4){0.f, 0.f, 0.f, 0.f};
#pragma unroll
        for (int ai = 0; ai < 2; ++ai)
#pragma unroll
            for (int m = 0; m < 4; ++m) { bf16* rowp = O + (size_t)(row0 + ai * HALF + m * 16) * ldc + col0;
#pragma unroll
                for (int bj = 0; bj < 2; ++bj) { const f32x4 v0 = acc[ai][bj][m][0] + bv[bj][0], v1 = acc[ai][bj][m][1] + bv[bj][1];
                    u32x4 w; w.x = pk2(v0[0], v0[1]); w.y = pk2(v0[2], v0[3]); w.z = pk2(v1[0], v1[1]); w.w = pk2(v1[2], v1[3]);
                    *(u32x4*)(rowp + bj * HALF) = w; } }
    }
};
struct EpiGate {
    static constexpr bool PERM = true;
    bf16* O; const bf16* Zg; int goff; const bf16* add;
    DI void operator()(const f32x4 (&acc)[2][2][4][2], const Unit& u, int wr, int wc, int fr, int fq) const {
        const int row0 = u.pm * BM + wr * 64 + fr, col0 = u.pn * BM + wc * 32 + 8 * fq;
#pragma unroll
        for (int ai = 0; ai < 2; ++ai)
#pragma unroll
            for (int m = 0; m < 4; ++m) { const size_t row = (size_t)(row0 + ai * HALF + m * 16);
#pragma unroll
                for (int bj = 0; bj < 2; ++bj) {
                    const int col = col0 + bj * HALF;
                    const u32x4 gz = *(const u32x4*)(Zg + row * NZ + goff + col);
                    float a[8] = {0.f, 0.f, 0.f, 0.f, 0.f, 0.f, 0.f, 0.f};
                    if (add) { const u32x4 t = *(const u32x4*)(add + row * D + col); a[0] = bflo(t.x); a[1] = bfhi(t.x); a[2] = bflo(t.y); a[3] = bfhi(t.y); a[4] = bflo(t.z); a[5] = bfhi(t.z); a[6] = bflo(t.w); a[7] = bfhi(t.w); }
                    const f32x4 v0 = acc[ai][bj][m][0], v1 = acc[ai][bj][m][1];
                    float o[8];
                    o[0] = a[0] + sigmoidf_(bflo(gz.x)) * v0[0]; o[1] = a[1] + sigmoidf_(bfhi(gz.x)) * v0[1];
                    o[2] = a[2] + sigmoidf_(bflo(gz.y)) * v0[2]; o[3] = a[3] + sigmoidf_(bfhi(gz.y)) * v0[3];
                    o[4] = a[4] + sigmoidf_(bflo(gz.z)) * v1[0]; o[5] = a[5] + sigmoidf_(bfhi(gz.z)) * v1[1];
                    o[6] = a[6] + sigmoidf_(bflo(gz.w)) * v1[2]; o[7] = a[7] + sigmoidf_(bfhi(gz.w)) * v1[3];
                    u32x4 w; w.x = pk2(o[0], o[1]); w.y = pk2(o[2], o[3]); w.z = pk2(o[4], o[5]); w.w = pk2(o[6], o[7]);
                    *(u32x4*)(O + row * D + col) = w; } }
    }
};
struct EpiResAdd {
    static constexpr bool PERM = false;
    float* H; const float* x; const float* meta;
    DI void operator()(const f32x4 (&acc)[2][2][4][2], const Unit& u, int wr, int wc, int fr, int fq) const {
        const int row0 = u.pm * BM + wr * 64 + fr, col0 = u.pn * BM + wc * 32 + 4 * fq;
#pragma unroll
        for (int ai = 0; ai < 2; ++ai)
#pragma unroll
            for (int m = 0; m < 4; ++m) { const int row = row0 + ai * HALF + m * 16; float* rowp = H + (size_t)row * D + col0; const float* srcp = resid_row(H, x, meta, row) + col0;
#pragma unroll
                for (int bj = 0; bj < 2; ++bj)
#pragma unroll
                    for (int n = 0; n < 2; ++n) { *(f32x4*)(rowp + bj * HALF + n * 16) = *(const f32x4*)(srcp + bj * HALF + n * 16) + acc[ai][bj][m][n]; } }
    }
};
}

struct SkZ    { bf16* Z; const float* bias; DI void operator()(int row, int col, f32x4 v) const { v = v + *(const f32x4*)(bias + col); *(u32x2*)(Z + (size_t)row * NZ + col) = (u32x2){pk2(v[0], v[1]), pk2(v[2], v[3])}; } };
struct SkGate { bf16* O; const bf16* Zg; int goff; const bf16* add;
    DI void operator()(int row, int col, f32x4 v) const { const u32x2 gz = *(const u32x2*)(Zg + (size_t)row * NZ + goff + col); float a0 = 0.f, a1 = 0.f, a2 = 0.f, a3 = 0.f;
        if (add) { const u32x2 t = *(const u32x2*)(add + (size_t)row * D + col); a0 = bflo(t.x); a1 = bfhi(t.x); a2 = bflo(t.y); a3 = bfhi(t.y); }
        *(u32x2*)(O + (size_t)row * D + col) = (u32x2){pk2(a0 + sigmoidf_(bflo(gz.x)) * v[0], a1 + sigmoidf_(bfhi(gz.x)) * v[1]), pk2(a2 + sigmoidf_(bflo(gz.y)) * v[2], a3 + sigmoidf_(bfhi(gz.y)) * v[3])}; } };
struct SkRes  { float* H; const float* x; const float* meta; DI void operator()(int row, int col, f32x4 v) const { *(f32x4*)(H + (size_t)row * D + col) = *(const f32x4*)(resid_row(H, x, meta, row) + col) + v; } };
template <class Epi>
DI void skinny64(const bf16* A, int lda, const bf16* Bt, int ldb, int N, int K, int r0, LAS unsigned char* lds, const Epi& epi, int wave, int lane, int bid, int G) {
    const int n16 = lane & 15, q = lane >> 4; const int ksw = (K / 32) / 8;
    LAS f32x4* red = (LAS f32x4*)lds;
    for (int nt = bid; nt < N / 16; nt += G) {
        f32x4 acc[4];
#pragma unroll
        for (int mt = 0; mt < 4; ++mt) acc[mt] = (f32x4){0.f, 0.f, 0.f, 0.f};
        const bf16* wp = Bt + (size_t)(16 * nt + n16) * ldb + 8 * q + wave * ksw * 32; const bf16* ap = A + (size_t)(r0 + n16) * lda + 8 * q + wave * ksw * 32;
#pragma unroll 8
        for (int ks = 0; ks < ksw; ++ks) { const bf16x8 wf = *(const bf16x8*)(wp + ks * 32);
#pragma unroll
            for (int mt = 0; mt < 4; ++mt) acc[mt] = __builtin_amdgcn_mfma_f32_16x16x32_bf16(wf, *(const bf16x8*)(ap + (size_t)(16 * mt) * lda + ks * 32), acc[mt], 0, 0, 0); }
        __syncthreads();
#pragma unroll
        for (int mt = 0; mt < 4; ++mt) red[(wave * 4 + mt) * 64 + lane] = acc[mt];
        __syncthreads();
        if (wave < 4) { f32x4 s = red[wave * 64 + lane];
#pragma unroll
            for (int w = 1; w < 8; ++w) s = s + red[(w * 4 + wave) * 64 + lane];
            epi(r0 + 16 * wave + n16, 16 * nt + 4 * q, s); }
    }
    __syncthreads();
}

struct ArgsV { const float* in[33]; float* out; unsigned char* ws; int ph_lo, ph_hi; };
#define CAS __attribute__((address_space(4)))
typedef const CAS ArgsV* ArgsP;
struct Args { ArgsP p; GAS unsigned char* ws; GAS float* out; DI const float* inp(int i) const { return (const float*)(const GAS float*)p->in[i]; } };
enum InIdx { I_X = 0, I_META, I_NORM_MIX, I_W_IN, I_B_QKV, I_SINKS, I_MU, I_W0, I_DEC_UP, I_A0, I_ICLR_UP, I_GATE_UP, I_KK, I_KA, I_RK, I_LNW, I_LNB,
             I_VDOWN, I_VMU, I_V0, I_VUP, I_WBA, I_WBR, I_WOUT, I_NORM_FFN, I_WCOARSE, I_BCOARSE, I_WFINE, I_BFINE, I_WEG, I_WEU, I_WED, I_NORM_FINAL };

DI void tr_item(const float* W, int ldw, int K, int N, bf16* WT, int ldt, int kb, int nb, LAS float* scr, int lane) {
    (void)scr;
    const int k0 = 64 * kb + 8 * (lane >> 3), n0 = 32 * nb + 4 * (lane & 7);
    f32x4 v[8];
#pragma unroll
    for (int r = 0; r < 8; ++r) v[r] = (n0 < N && k0 + r < K) ? *(const f32x4*)(W + (size_t)(k0 + r) * ldw + n0) : (f32x4){0.f, 0.f, 0.f, 0.f};
    if (k0 < K && n0 < N) {
#pragma unroll
        for (int i = 0; i < 4; ++i) {
            u32x4 o; o.x = pk2(v[0][i], v[1][i]); o.y = pk2(v[2][i], v[3][i]); o.z = pk2(v[4][i], v[5][i]); o.w = pk2(v[6][i], v[7][i]);
            *(u32x4*)(WT + (size_t)(n0 + i) * ldt + k0) = o; } }
}

struct TrDesc { const float* W; bf16* WT; int ldw, K, N, ldt, kb, nb; };
DI void tr_load(const TrDesc& d, f32x4 (&v)[8], int lane) {
    const int k0 = 64 * d.kb + 8 * (lane >> 3), n0 = 32 * d.nb + 4 * (lane & 7);
#pragma unroll
    for (int r = 0; r < 8; ++r) v[r] = (n0 < d.N && k0 + r < d.K) ? *(const f32x4*)(d.W + (size_t)(k0 + r) * d.ldw + n0) : (f32x4){0.f, 0.f, 0.f, 0.f};
}
DI void tr_store(const TrDesc& d, const f32x4 (&v)[8], int lane) {
    const int k0 = 64 * d.kb + 8 * (lane >> 3), n0 = 32 * d.nb + 4 * (lane & 7);
    if (k0 < d.K && n0 < d.N) {
#pragma unroll
        for (int i = 0; i < 4; ++i) {
            u32x4 o; o.x = pk2(v[0][i], v[1][i]); o.y = pk2(v[2][i], v[3][i]); o.z = pk2(v[4][i], v[5][i]); o.w = pk2(v[6][i], v[7][i]);
            *(u32x4*)(d.WT + (size_t)(n0 + i) * d.ldt + k0) = o; } }
}
template <int GRP>
DI TrDesc tr_decode(const Args& a, int l, int r) {
    unsigned char* ws = (unsigned char*)a.ws;
    constexpr int NB_IN = NIN / 32;
    constexpr int J1 = 32 * NB_IN, J3 = 16 * 64, J5 = 32 * 64, J9 = 32 * 2, J10 = 32, J11 = 32, J2 = 32;
    if (GRP == 1) {
        if (r < J3) return TrDesc{a.inp(I_WBA) + (size_t)l * C * D, (bf16*)(ws + WS_WAT) + (size_t)l * D * C, D, C, D, C, r / 64, r % 64}; r -= J3;
        if (r < J3) return TrDesc{a.inp(I_WBR) + (size_t)l * C * D, (bf16*)(ws + WS_WRT) + (size_t)l * D * C, D, C, D, C, r / 64, r % 64}; r -= J3;
        if (r < J5) return TrDesc{a.inp(I_WOUT) + (size_t)l * D * D, (bf16*)(ws + WS_WOT) + (size_t)l * D * D, D, D, D, D, r / 64, r % 64}; r -= J5;
        if (r < J9) return TrDesc{a.inp(I_WFINE) + (size_t)l * D * 64, (bf16*)(ws + WS_WRO) + (size_t)l * 80 * D + (size_t)8 * D, 64, D, 64, D, r / 2, r % 2}; r -= J9;
        return TrDesc{a.inp(I_WCOARSE) + (size_t)l * D * 8, (bf16*)(ws + WS_WRO) + (size_t)l * 80 * D, 8, D, 8, D, r, 0};
    }
    if (r < J1) return TrDesc{a.inp(I_W_IN) + (size_t)l * D * NIN, (bf16*)(ws + WS_W1T) + (size_t)l * NZ * D, NIN, D, NIN, D, r / NB_IN, r % NB_IN}; r -= J1;
    if (r < J11) return TrDesc{a.inp(I_DEC_UP) + (size_t)l * 64 * C, (bf16*)(ws + WS_LDEC) + (size_t)l * C * 64, C, 64, C, 64, 0, r}; r -= J11;
    if (r < J11) return TrDesc{a.inp(I_ICLR_UP) + (size_t)l * 64 * C, (bf16*)(ws + WS_LICL) + (size_t)l * C * 64, C, 64, C, 64, 0, r}; r -= J11;
    if (r < J11 || GRP != 2) return TrDesc{a.inp(I_GATE_UP) + (size_t)l * 64 * C, (bf16*)(ws + WS_LGAT) + (size_t)l * C * 64, C, 64, C, 64, 0, r}; r -= J11;
    if (r < J2) return TrDesc{a.inp(I_VDOWN), (bf16*)(ws + WS_W1T) + (size_t)NZ * D + (size_t)ZVD * D, 32, D, 32, D, r, 0}; r -= J2;
    return TrDesc{a.inp(I_VUP), (bf16*)(ws + WS_LVUP), C, 32, C, 32, 0, r};
}
template <int GRP>
DI void phase_convert(const Args& a, int l, LAS unsigned char* lds, int gw, int NGW, int wave, int lane) {
    unsigned char* ws = (unsigned char*)a.ws; (void)lds; (void)wave;
    constexpr int NB_IN = NIN / 32;
    constexpr int NITEMS = (GRP == 1) ? 2 * 16 * 64 + 32 * 64 + 32 * 2 + 32 : 32 * NB_IN + 3 * 32 + (GRP == 2 ? 32 + 32 : 0);
    for (int it = gw; it < NITEMS; it += 2 * NGW) {
        const bool two = it + NGW < NITEMS;
        const TrDesc d0 = tr_decode<GRP>(a, l, it), d1 = tr_decode<GRP>(a, l, two ? it + NGW : it);
        f32x4 v0[8], v1[8];
        tr_load(d0, v0, lane); tr_load(d1, v1, lane);
        tr_store(d0, v0, lane); if (two) tr_store(d1, v1, lane);
    }
    if (GRP != 2) return;
    const size_t gt = (size_t)gw * 64 + lane, NGT = (size_t)NGW * 64;
    { unsigned* U = (unsigned*)(ws + WS_U);
      for (size_t i = gt; i < (size_t)(TP - T) * (D / 2); i += NGT) U[(size_t)T * (D / 2) + i] = 0u; }
    { float* bias = (float*)(ws + WS_BIAS);
      for (size_t i = gt; i < (size_t)2 * NZ; i += NGT) { const int l = (int)(i / NZ), c = (int)(i % NZ); bias[i] = (c < 1536) ? a.inp(I_B_QKV)[l * 1536 + c] : 0.f; } }
    { float* rope = (float*)(ws + WS_ROPE);
      for (size_t i = gt; i < (size_t)L * 8; i += NGT) { const int t = (int)(i / 8), k = (int)(i % 8);
          const float invf = (float)exp2(-(double)k * 0.125 * 18.931568569324174  );
          const float ang = (float)t * invf;
          const double rev = (double)ang * 0.15915494309189535; const float fr = (float)(rev - floor(rev));
          rope[i * 2 + 0] = __builtin_amdgcn_cosf(fr); rope[i * 2 + 1] = __builtin_amdgcn_sinf(fr); } }
    { unsigned* wro = (unsigned*)(ws + WS_WRO);
      for (size_t i = gt; i < (size_t)2 * 8 * (D / 2); i += NGT) { const int l = (int)(i / (8 * (D / 2))), rr = (int)(i % (8 * (D / 2))); wro[(size_t)l * 80 * (D / 2) + (size_t)72 * (D / 2) + rr] = 0u; } }
}

DI void moe_tables(const unsigned* cnt, LAS int* lc, int tid) {
    __syncthreads();
    if (tid < 64) {
        const int c = (int)__hip_atomic_load(cnt + tid * 16, RLX_AGENT); const int pad = (c + 15) & ~15; int inc = pad;
#pragma unroll
        for (int o = 1; o < 64; o <<= 1) { const int v = __shfl_up(inc, o); if (tid >= o) inc += v; }
        lc[LC_PSTART / 4 + tid] = inc - pad; lc[LC_CNT / 4 + tid] = c; }
    __syncthreads();
}
template <int MODE>
DI void phase_norm(const Args& a, const float* gain, bool comb, int lprev, LAS unsigned char* lds, int tid, int gw, int NGW, int lane, const float* x0 = nullptr, const float* meta0 = nullptr) {
    unsigned char* ws = (unsigned char*)a.ws; float* H = (float*)(ws + WS_H); bf16* U = (bf16*)(ws + WS_U);
    const bf16* YR = (const bf16*)(ws + WS_YR); const int* toke = (const int*)(ws + WS_TOKE); const int* toks = (const int*)(ws + WS_TOKS); const float* tokw = (const float*)(ws + WS_TOKW);
    LAS int* lc = (LAS int*)(lds + LDSCTL_OFF);
    if (comb) moe_tables((const unsigned*)(ws + WS_CTL) + CW_CNT + lprev * 64 * 16, lc, tid);
    f32x4 g[8];
#pragma unroll
    for (int j = 0; j < 8; ++j) g[j] = *(const f32x4*)(gain + lane * 4 + 256 * j);
    for (int m = gw; m < T; m += 2 * NGW) {
        const int mm[2] = {m, (m + NGW < T) ? m + NGW : m}; const bool two = m + NGW < T;
        f32x4 v[2][8];
#pragma unroll
        for (int rr = 0; rr < 2; ++rr)
#pragma unroll
            for (int j = 0; j < 8; ++j) v[rr][j] = *(const f32x4*)(resid_row(H, x0, meta0, mm[rr]) + lane * 4 + 256 * j);
        if (comb) {
            int p[2][2]; float w[2][2];
#pragma unroll
            for (int rr = 0; rr < 2; ++rr)
#pragma unroll
                for (int k = 0; k < 2; ++k) { p[rr][k] = lc[LC_PSTART / 4 + toke[2 * mm[rr] + k]] + toks[2 * mm[rr] + k]; w[rr][k] = tokw[2 * mm[rr] + k]; }
            u32x2 y[2][2][8];
#pragma unroll
            for (int rr = 0; rr < 2; ++rr)
#pragma unroll
                for (int k = 0; k < 2; ++k)
#pragma unroll
                    for (int j = 0; j < 8; ++j) y[rr][k][j] = *(const u32x2*)(YR + (size_t)p[rr][k] * D + lane * 4 + 256 * j);
#pragma unroll
            for (int rr = 0; rr < 2; ++rr)
#pragma unroll
                for (int j = 0; j < 8; ++j) { const u32x2 a0 = y[rr][0][j], a1 = y[rr][1][j]; const float w0 = w[rr][0], w1 = w[rr][1];
                    v[rr][j][0] += w0 * bflo(a0.x) + w1 * bflo(a1.x); v[rr][j][1] += w0 * bfhi(a0.x) + w1 * bfhi(a1.x);
                    v[rr][j][2] += w0 * bflo(a0.y) + w1 * bflo(a1.y); v[rr][j][3] += w0 * bfhi(a0.y) + w1 * bfhi(a1.y);
                    if (MODE == 0 && (rr == 0 || two)) *(f32x4*)(H + (size_t)mm[rr] * D + lane * 4 + 256 * j) = v[rr][j]; }
        }
#pragma unroll
        for (int rr = 0; rr < 2; ++rr) {
            if (rr == 1 && !two) break;
            float ss = 0.f;
#pragma unroll
            for (int j = 0; j < 8; ++j) ss += (v[rr][j][0] * v[rr][j][0] + v[rr][j][1] * v[rr][j][1]) + (v[rr][j][2] * v[rr][j][2] + v[rr][j][3] * v[rr][j][3]);
            float rstd = rsqrtf(wave_sum(ss) * (1.f / D) + NORM_EPS);
#if defined(CHUNK_TEST)
            if (MODE == 1 && ((const unsigned*)(ws + WS_CTL))[40000] != 0u) rstd = __builtin_nanf("");
#endif
            if (MODE == 0) {
                bf16* ur = U + (size_t)mm[rr] * D + lane * 4;
#pragma unroll
                for (int j = 0; j < 8; ++j) { const f32x4 o = v[rr][j] * rstd * g[j]; u32x2 wv; wv.x = pk2(o[0], o[1]); wv.y = pk2(o[2], o[3]); *(u32x2*)(ur + 256 * j) = wv; }
            } else {
                const int b = mm[rr] / L, t = mm[rr] % L;
                if (t >= NMETA) { float* orow = (float*)a.out + ((size_t)b * SEQ + (t - NMETA)) * D + lane * 4;
#pragma unroll
                    for (int j = 0; j < 8; ++j) *(f32x4*)(orow + 256 * j) = v[rr][j] * rstd * g[j]; }
            }
        }
    }
}

DI void phase_rope(const Args& a, int gw, int NGW, int lane) {
    unsigned char* ws = (unsigned char*)a.ws; bf16* Z = (bf16*)(ws + WS_Z); const float* rope = (const float*)(ws + WS_ROPE);
    const int r = lane / 20, hs = lane % 20; const int cb = (hs < 16) ? ZQ + hs * 64 : ZK + (hs - 16) * 64;
    for (int m0 = 3 * gw; m0 < T; m0 += 3 * NGW) { const int m = m0 + r;
        if (lane < 60 && m < T) { const int t = m % L; bf16* zp = Z + (size_t)m * NZ + cb;
            const u32x4 a1 = *(const u32x4*)zp, a2 = *(const u32x4*)(zp + 8);
            const f32x4* rt = (const f32x4*)(rope + (size_t)t * 16);
            unsigned o1[4], o2[4];
#pragma unroll
            for (int w = 0; w < 4; ++w) { const f32x4 cs = rt[w];
                const unsigned w1 = (w == 0) ? a1.x : (w == 1) ? a1.y : (w == 2) ? a1.z : a1.w, w2 = (w == 0) ? a2.x : (w == 1) ? a2.y : (w == 2) ? a2.z : a2.w;
                const float x1a = bflo(w1), x1b = bfhi(w1), x2a = bflo(w2), x2b = bfhi(w2);
                o1[w] = pk2(x1a * cs[0] - x2a * cs[1], x1b * cs[2] - x2b * cs[3]); o2[w] = pk2(x2a * cs[0] + x1a * cs[1], x2b * cs[2] + x1b * cs[3]); }
            *(u32x4*)zp = (u32x4){o1[0], o1[1], o1[2], o1[3]}; *(u32x4*)(zp + 8) = (u32x4){o2[0], o2[1], o2[2], o2[3]}; } }
}
DI void phase_vt(const Args& a, int gw, int NGW, int lane) {
    unsigned char* ws = (unsigned char*)a.ws; const bf16* Z = (const bf16*)(ws + WS_Z); bf16* VT = (bf16*)(ws + WS_VT);
    const int tgl = lane >> 3, cgl = lane & 7; constexpr int NTG = (LPAD + 63) / 64;
    for (int u = gw; u < NB * NTG * 4; u += NGW) { const int kvh = u & 3, tg8 = (u >> 2) % NTG, b = (u >> 2) / NTG; const int t0 = 64 * tg8 + 8 * tgl;
        u32x4 x[8];
#pragma unroll
        for (int j = 0; j < 8; ++j) { const int t = t0 + j; x[j] = (t < L) ? *(const u32x4*)(Z + (size_t)(b * L + t) * NZ + ZV + kvh * 64 + 8 * cgl) : (u32x4){0u, 0u, 0u, 0u}; }
        if (t0 < LPAD) {
#pragma unroll
            for (int ch = 0; ch < 8; ++ch) { unsigned o[4];
#pragma unroll
                for (int w = 0; w < 4; ++w) { const unsigned lo = (ch >> 1) == 0 ? x[2 * w].x : (ch >> 1) == 1 ? x[2 * w].y : (ch >> 1) == 2 ? x[2 * w].z : x[2 * w].w;
                    const unsigned hi = (ch >> 1) == 0 ? x[2 * w + 1].x : (ch >> 1) == 1 ? x[2 * w + 1].y : (ch >> 1) == 2 ? x[2 * w + 1].z : x[2 * w + 1].w;
                    o[w] = (ch & 1) ? ((lo >> 16) | (hi & 0xffff0000u)) : ((lo & 0xffffu) | (hi << 16)); }
                *(u32x4*)(VT + ((size_t)(b * 4 + kvh) * HD + 8 * cgl + ch) * LPAD + t0) = (u32x4){o[0], o[1], o[2], o[3]}; } }
    }
}
template <int MODE> DI bf16x8 lora_in8(const u32x4 c, const u32x4 p, const f32x4 m0, const f32x4 m1) {
    float o[8];
#pragma unroll
    for (int j = 0; j < 8; ++j) { const unsigned cw = (j < 2) ? c.x : (j < 4) ? c.y : (j < 6) ? c.z : c.w, pw = (j < 2) ? p.x : (j < 4) ? p.y : (j < 6) ? p.z : p.w;
        const float cv = (j & 1) ? bfhi(cw) : bflo(cw), pv = (j & 1) ? bfhi(pw) : bflo(pw); const float mm = (j < 4) ? m0[j & 3] : m1[j & 3];
        const float zs = cv + (pv - cv) * mm;
        if (MODE == 0) { const float e = __expf(2.f * zs); o[j] = 1.f - 2.f / (e + 1.f); } else if (MODE == 1) o[j] = zs; else o[j] = sigmoidf_(zs); }
    u32x4 w; w.x = pk2(o[0], o[1]); w.y = pk2(o[2], o[3]); w.z = pk2(o[4], o[5]); w.w = pk2(o[6], o[7]);
    return __builtin_bit_cast(bf16x8, w);
}
DI void phase_rwkvprep(const Args& a, int l, LAS unsigned char* lds, int tid, int gw, int NGW, int lane) {
    unsigned char* ws = (unsigned char*)a.ws; const bf16* Z = (const bf16*)(ws + WS_Z);
    const float* mu = a.inp(I_MU) + (size_t)l * 3264; const float* vmu = a.inp(I_VMU);
    const bf16* WdT = (const bf16*)(ws + WS_LDEC) + (size_t)l * C * 64; const bf16* WiT = (const bf16*)(ws + WS_LICL) + (size_t)l * C * 64; const bf16* WgT = (const bf16*)(ws + WS_LGAT) + (size_t)l * C * 64;
    const bf16* WvT = (const bf16*)(ws + WS_LVUP);
    bf16* Rr = (bf16*)(ws + WS_R); float* Ww = (float*)(ws + WS_W); bf16* Kk = (bf16*)(ws + WS_K); bf16* Vv = (bf16*)(ws + WS_V); bf16* KKn = (bf16*)(ws + WS_KK); bf16* Bb = (bf16*)(ws + WS_B);
    bf16* VF = (bf16*)(ws + WS_VF); bf16* Gg = (bf16*)(ws + WS_G); float* RK = (float*)(ws + WS_RK);
    LAS float* par = (LAS float*)lds;
    __syncthreads();
    for (int i = tid; i < 9 * C; i += NTHR) { const int wch = i / C, ch = i % C; float v;
        if (wch < 3) v = mu[wch * C + ch]; else if (wch == 3) v = a.inp(I_W0)[(size_t)l * C + ch]; else if (wch == 4) v = a.inp(I_A0)[(size_t)l * C + ch]; else if (wch == 5) v = a.inp(I_KK)[(size_t)l * C + ch];
        else if (wch == 6) v = a.inp(I_KA)[(size_t)l * C + ch]; else if (wch == 7) v = a.inp(I_RK)[(size_t)l * C + ch]; else v = (l > 0) ? a.inp(I_V0)[ch] : 0.f;
        par[i] = v; }
    __syncthreads();
    const int tk = lane & 15, q = lane >> 4;
    for (int u = gw; u < (T / 16) * NH; u += NGW) {
        const int hd = u & 15, tile = u >> 4; const int b = tile / (L / 16), t0 = (tile % (L / 16)) * 16; const int row = b * L + t0 + tk, t = t0 + tk;
        const bf16* zrow = Z + (size_t)row * NZ; const bf16* prow = zrow - NZ; const bool hp = t > 0;
        const bf16* zc = zrow + ZR0; const bf16* zp = prow + ZR0;
        struct CtIn { bf16x8 wd[2], wi[2], wg[2], wv; u32x2 zr, zk, zv, pr, pk, pv, vf; };
#define RP_LOAD(dst, ct) do { const int chA_ = hd * 64 + (ct) * 16 + (lane & 15), c0_ = hd * 64 + (ct) * 16 + 4 * q; \
            _Pragma("unroll") for (int ks = 0; ks < 2; ++ks) { dst.wd[ks] = *(const bf16x8*)(WdT + (size_t)chA_ * 64 + ks * 32 + 8 * q); dst.wi[ks] = *(const bf16x8*)(WiT + (size_t)chA_ * 64 + ks * 32 + 8 * q); dst.wg[ks] = *(const bf16x8*)(WgT + (size_t)chA_ * 64 + ks * 32 + 8 * q); } \
            dst.wv = (l > 0) ? *(const bf16x8*)(WvT + (size_t)chA_ * 32 + 8 * q) : (bf16x8){0, 0, 0, 0, 0, 0, 0, 0}; \
            dst.zr = *(const u32x2*)(zc + c0_); dst.zk = *(const u32x2*)(zc + 1024 + c0_); dst.zv = *(const u32x2*)(zc + 2048 + c0_); \
            dst.pr = (u32x2){0u, 0u}; dst.pk = dst.pr; dst.pv = dst.pr; if (hp) { dst.pr = *(const u32x2*)(zp + c0_); dst.pk = *(const u32x2*)(zp + 1024 + c0_); dst.pv = *(const u32x2*)(zp + 2048 + c0_); } \
            dst.vf = (l > 0) ? *(const u32x2*)(VF + (size_t)row * C + c0_) : (u32x2){0u, 0u}; } while (0)
        CtIn in[2];
        RP_LOAD(in[0], 0);
        bf16x8 bw[2], ba[2], bg[2], bs = {0, 0, 0, 0, 0, 0, 0, 0};
#pragma unroll
        for (int ks = 0; ks < 2; ++ks) { const int ko = ks * 32 + 8 * q; const u32x4 z4 = {0u, 0u, 0u, 0u};
            const u32x4 cw = *(const u32x4*)(zrow + ZR0 + 3072 + ko), ca = *(const u32x4*)(zrow + ZR0 + 3136 + ko), cg = *(const u32x4*)(zrow + ZR0 + 3200 + ko);
            const u32x4 pw = hp ? *(const u32x4*)(prow + ZR0 + 3072 + ko) : z4, pa = hp ? *(const u32x4*)(prow + ZR0 + 3136 + ko) : z4, pg = hp ? *(const u32x4*)(prow + ZR0 + 3200 + ko) : z4;
            bw[ks] = lora_in8<0>(cw, pw, *(const f32x4*)(mu + 3072 + ko), *(const f32x4*)(mu + 3072 + ko + 4));
            ba[ks] = lora_in8<1>(ca, pa, *(const f32x4*)(mu + 3136 + ko), *(const f32x4*)(mu + 3136 + ko + 4));
            bg[ks] = lora_in8<2>(cg, pg, *(const f32x4*)(mu + 3200 + ko), *(const f32x4*)(mu + 3200 + ko + 4)); }
        if (l > 0) { const u32x4 z4 = {0u, 0u, 0u, 0u}; const u32x4 cs = *(const u32x4*)(zrow + ZVD + 8 * q); const u32x4 ps = hp ? *(const u32x4*)(prow + ZVD + 8 * q) : z4;
            bs = lora_in8<1>(cs, ps, *(const f32x4*)(vmu + 8 * q), *(const f32x4*)(vmu + 8 * q + 4)); }
        float kkv[4][4], av[4][4]; float ss = 0.f, rks = 0.f;
#pragma unroll
        for (int ct = 0; ct < 4; ++ct) { const int ch0 = hd * 64 + ct * 16;
            if (ct + 1 < 4) RP_LOAD(in[(ct + 1) & 1], ct + 1);
            __builtin_amdgcn_sched_barrier(0);
            const CtIn& I = in[ct & 1];
            f32x4 aw = {0.f, 0.f, 0.f, 0.f}, aa = aw, ag = aw, avr = aw;
#pragma unroll
            for (int ks = 0; ks < 2; ++ks) {
                aw = __builtin_amdgcn_mfma_f32_16x16x32_bf16(I.wd[ks], bw[ks], aw, 0, 0, 0);
                aa = __builtin_amdgcn_mfma_f32_16x16x32_bf16(I.wi[ks], ba[ks], aa, 0, 0, 0);
                ag = __builtin_amdgcn_mfma_f32_16x16x32_bf16(I.wg[ks], bg[ks], ag, 0, 0, 0); }
            if (l > 0) avr = __builtin_amdgcn_mfma_f32_16x16x32_bf16(I.wv, bs, avr, 0, 0, 0);
            const int c0 = ch0 + 4 * q;
            const u32x2 zr_ = I.zr, zk_ = I.zk, zv_ = I.zv, pr_ = I.pr, pk_ = I.pk, pv_ = I.pv, vfw = I.vf;
            const f32x4 mr = *(const LAS f32x4*)(par + c0), mk = *(const LAS f32x4*)(par + C + c0), mv = *(const LAS f32x4*)(par + 2 * C + c0);
            const f32x4 w0v = *(const LAS f32x4*)(par + 3 * C + c0), a0v = *(const LAS f32x4*)(par + 4 * C + c0), kkw = *(const LAS f32x4*)(par + 5 * C + c0), kaw = *(const LAS f32x4*)(par + 6 * C + c0), rkw = *(const LAS f32x4*)(par + 7 * C + c0);
            const f32x4 v0v = *(const LAS f32x4*)(par + 8 * C + c0);
            f32x4 ro, wo, ko, vo, go;
#pragma unroll
            for (int j = 0; j < 4; ++j) {
                const float rc = (j & 1) ? bfhi(j < 2 ? zr_.x : zr_.y) : bflo(j < 2 ? zr_.x : zr_.y), rp = (j & 1) ? bfhi(j < 2 ? pr_.x : pr_.y) : bflo(j < 2 ? pr_.x : pr_.y);
                const float kc = (j & 1) ? bfhi(j < 2 ? zk_.x : zk_.y) : bflo(j < 2 ? zk_.x : zk_.y), kp = (j & 1) ? bfhi(j < 2 ? pk_.x : pk_.y) : bflo(j < 2 ? pk_.x : pk_.y);
                const float vc = (j & 1) ? bfhi(j < 2 ? zv_.x : zv_.y) : bflo(j < 2 ? zv_.x : zv_.y), vp = (j & 1) ? bfhi(j < 2 ? pv_.x : pv_.y) : bflo(j < 2 ? pv_.x : pv_.y);
                const float vfj = (j & 1) ? bfhi(j < 2 ? vfw.x : vfw.y) : bflo(j < 2 ? vfw.x : vfw.y);
                const float r = rc + (rp - rc) * mr[j]; float k = kc + (kp - kc) * mk[j]; float v = vc + (vp - vc) * mv[j];
                const float xw = -(w0v[j] + aw[j]);
                const float sp = fmaxf(xw, 0.f) + __logf(1.f + __expf(-fabsf(xw)));
                const float wlog = -sp - 0.5f; const float dec = __expf(-__expf(wlog));
                const float aval = sigmoidf_(a0v[j] + aa[j]);
                if (l > 0) v = v + (vfj - v) * sigmoidf_(v0v[j] + avr[j]);
                const float kk = k * kkw[j]; ss += kk * kk;
                k = k * (1.f + (aval - 1.f) * kaw[j]);
                rks += r * k * rkw[j];
                kkv[ct][j] = kk; av[ct][j] = aval;
                ro[j] = r; wo[j] = dec; ko[j] = k; vo[j] = v; go[j] = ag[j]; }
            const size_t o = (size_t)row * C + c0;
            *(u32x2*)(Rr + o) = (u32x2){pk2(ro[0], ro[1]), pk2(ro[2], ro[3])}; *(f32x4*)(Ww + o) = wo; *(u32x2*)(Kk + o) = (u32x2){pk2(ko[0], ko[1]), pk2(ko[2], ko[3])};
            const u32x2 vpk = {pk2(vo[0], vo[1]), pk2(vo[2], vo[3])}; *(u32x2*)(Vv + o) = vpk; *(u32x2*)(Gg + o) = (u32x2){pk2(go[0], go[1]), pk2(go[2], go[3])};
            if (l == 0) *(u32x2*)(VF + o) = vpk; }
#undef RP_LOAD
        ss += __shfl_xor(ss, 16); ss += __shfl_xor(ss, 32); rks += __shfl_xor(rks, 16); rks += __shfl_xor(rks, 32);
        const float inv = 1.f / fmaxf(sqrtf(ss), 1e-12f);
#pragma unroll
        for (int ct = 0; ct < 4; ++ct) { const size_t o = (size_t)row * C + hd * 64 + ct * 16 + 4 * q;
            float kn[4], bo[4];
#pragma unroll
            for (int j = 0; j < 4; ++j) { kn[j] = kkv[ct][j] * inv; bo[j] = kn[j] * av[ct][j]; }
            *(u32x2*)(KKn + o) = (u32x2){pk2(kn[0], kn[1]), pk2(kn[2], kn[3])}; *(u32x2*)(Bb + o) = (u32x2){pk2(bo[0], bo[1]), pk2(bo[2], bo[3])}; }
        if (q == 0) RK[(size_t)row * NH + hd] = rks;
    }
}

DI void phase_attn(const Args& a, int l, int gw, int NGW, int lane) {
    unsigned char* ws = (unsigned char*)a.ws; const bf16* Z = (const bf16*)(ws + WS_Z); const bf16* VT = (const bf16*)(ws + WS_VT); bf16* O = (bf16*)(ws + WS_OATT);
    const float* sinks = a.inp(I_SINKS) + l * NH;
    constexpr int NMAIN = NB * NH * (SEQ / 32), NUNITS = NMAIN + NB * NH;
    const int c = lane & 31, h = lane >> 5;
    const int kperm = (c & ~12) | ((c & 8) >> 1) | ((c & 4) << 1);
    constexpr float SCL = 0.125f * 1.44269504088896f;
    for (int u = gw; u < NUNITS; u += NGW) {
        const bool metaq = u >= NMAIN; const int uu = metaq ? u - NMAIN : u;
        const int hq4 = uu & 3, rest = uu >> 2; const int qb = metaq ? -8 : (rest & 63), bk = metaq ? rest : (rest >> 6); const int kvh = bk & 3, b = bk >> 2; const int hq = kvh * 4 + hq4;
        const int qpos = metaq ? c : NMETA + 32 * qb + c;
        const bf16* zb = Z + (size_t)(b * L) * NZ; const bf16* vb = VT + ((size_t)(b * 4 + kvh) * HD + c) * LPAD + 8 * h;
#define AT_KBASE(s) (((s) == 0) ? 0 : NMETA + 32 * (qb - 5 + (s)))
#define AT_VALID(s) (((s) == 0) || (qb - 5 + (s) >= 0))
#define AT_KLOAD(dst, s) do { if (AT_VALID(s)) { const bf16* kp_ = zb + (size_t)(AT_KBASE(s) + kperm) * NZ + ZK + kvh * 64 + 8 * h; _Pragma("unroll") for (int ks = 0; ks < 4; ++ks) dst[ks] = *(const bf16x8*)(kp_ + 16 * ks); } } while (0)
#define AT_VLOAD(dst, s) do { if (AT_VALID(s)) { const bf16* vp_ = vb + AT_KBASE(s); dst[0] = *(const bf16x8*)(vp_); dst[1] = *(const bf16x8*)(vp_ + 16); dst[2] = *(const bf16x8*)(vp_ + (size_t)32 * LPAD); dst[3] = *(const bf16x8*)(vp_ + (size_t)32 * LPAD + 16); } } while (0)
        bf16x8 qf[4], fr[2][4];
#pragma unroll
        for (int ks = 0; ks < 4; ++ks) qf[ks] = *(const bf16x8*)(zb + (size_t)qpos * NZ + ZQ + hq * 64 + 16 * ks + 8 * h);
        AT_KLOAD(fr[0], 0);
        f32x16 sc[6];
        float mx = sinks[hq] * 1.44269504088896f;
#pragma unroll
        for (int s = 0; s < 6; ++s) {
            const bool valid = AT_VALID(s); const int kbase = AT_KBASE(s);
            if (s + 1 < 6) AT_KLOAD(fr[(s + 1) & 1], s + 1);
            __builtin_amdgcn_sched_barrier(0);
#pragma unroll
            for (int i = 0; i < 16; ++i) sc[s][i] = 0.f;
            if (valid) {
#pragma unroll
                for (int ks = 0; ks < 4; ++ks) sc[s] = __builtin_amdgcn_mfma_f32_32x32x16_bf16(fr[s & 1][ks], qf[ks], sc[s], 0, 0, 0);
            }
#pragma unroll
            for (int i = 0; i < 16; ++i) { const int kpos = kbase + 16 * (i >> 3) + 8 * h + 4 * ((i >> 2) & 1) + (i & 3);
                const int dist = qpos - kpos;
                const bool vis = valid && ((s == 0) ? (kpos < NMETA && kpos <= qpos) : (s >= 2 && s <= 4) ? true : (dist >= 0 && dist < 128));
                sc[s][i] = vis ? sc[s][i] * SCL : -1e30f; mx = fmaxf(mx, sc[s][i]); }
        }
        AT_VLOAD(fr[0], 0);
        mx = fmaxf(mx, __shfl_xor(mx, 32));
        float sum = 0.f;
#pragma unroll
        for (int s = 0; s < 6; ++s)
#pragma unroll
            for (int i = 0; i < 16; ++i) { const float p = __builtin_amdgcn_exp2f(sc[s][i] - mx); sc[s][i] = p; sum += p; }
        sum += __shfl_xor(sum, 32);
        sum += __builtin_amdgcn_exp2f(sinks[hq] * 1.44269504088896f - mx);
        f32x16 o0, o1;
#pragma unroll
        for (int i = 0; i < 16; ++i) { o0[i] = 0.f; o1[i] = 0.f; }
#pragma unroll
        for (int s = 0; s < 6; ++s) {
            const bool valid = AT_VALID(s);
            if (s + 1 < 6) AT_VLOAD(fr[(s + 1) & 1], s + 1);
            __builtin_amdgcn_sched_barrier(0);
            if (valid) {
#pragma unroll
                for (int s2 = 0; s2 < 2; ++s2) {
                    u32x4 pw; pw.x = pk2(sc[s][8 * s2 + 0], sc[s][8 * s2 + 1]); pw.y = pk2(sc[s][8 * s2 + 2], sc[s][8 * s2 + 3]); pw.z = pk2(sc[s][8 * s2 + 4], sc[s][8 * s2 + 5]); pw.w = pk2(sc[s][8 * s2 + 6], sc[s][8 * s2 + 7]);
                    const bf16x8 pf = __builtin_bit_cast(bf16x8, pw);
                    o0 = __builtin_amdgcn_mfma_f32_32x32x16_bf16(fr[s & 1][s2], pf, o0, 0, 0, 0);
                    o1 = __builtin_amdgcn_mfma_f32_32x32x16_bf16(fr[s & 1][2 + s2], pf, o1, 0, 0, 0); }
            }
        }
#undef AT_KBASE
#undef AT_VALID
#undef AT_KLOAD
#undef AT_VLOAD
        if (!metaq || c < NMETA) { const float inv = 1.f / sum; bf16* orow = O + (size_t)(b * L + qpos) * C + hq * 64 + 4 * h;
#pragma unroll
            for (int g4 = 0; g4 < 4; ++g4) { u32x2 w0, w1;
                w0.x = pk2(o0[4 * g4] * inv, o0[4 * g4 + 1] * inv); w0.y = pk2(o0[4 * g4 + 2] * inv, o0[4 * g4 + 3] * inv);
                w1.x = pk2(o1[4 * g4] * inv, o1[4 * g4 + 1] * inv); w1.y = pk2(o1[4 * g4 + 2] * inv, o1[4 * g4 + 3] * inv);
                *(u32x2*)(orow + 8 * g4) = w0; *(u32x2*)(orow + 32 + 8 * g4) = w1; } }
    }
}

constexpr int CK = 64, NCK = (L + CK - 1) / CK  , NCHUNK = NB * NH * NCK  ;
constexpr size_t CH_P = WS_XR, CH_Q = CH_P + (size_t)NCHUNK * 4096 * 2, CH_RH = CH_Q + (size_t)NCHUNK * 4096 * 4, CH_YL = CH_RH + (size_t)NCHUNK * 4096 * 2, CH_ZS = CH_YL + (size_t)NCHUNK * 4096 * 4;
static_assert(CH_ZS + (size_t)NCHUNK * 4096 * 2 <= WS_HID, "chunk buffers fit the free XR region");
constexpr int CP = 72, CMS = 64 * CP * 2;
struct CkF { bf16x8 a[2], b[2][2]; };
DI void ck_ld(CkF& f, const LAS bf16* A, const LAS bf16* Bt, int wave, int lane) {
    const int mt = wave >> 1, nt0 = 2 * (wave & 1), r = lane & 15, q = lane >> 4;
#pragma unroll
    for (int ks = 0; ks < 2; ++ks) { f.a[ks] = *(const LAS bf16x8*)(A + (16 * mt + r) * CP + 32 * ks + 8 * q);
#pragma unroll
        for (int j = 0; j < 2; ++j) f.b[j][ks] = *(const LAS bf16x8*)(Bt + (16 * (nt0 + j) + r) * CP + 32 * ks + 8 * q); }
}
DI void ck_mma(f32x4 (&acc)[2], const CkF& f) {
#pragma unroll
    for (int ks = 0; ks < 2; ++ks)
#pragma unroll
        for (int j = 0; j < 2; ++j) acc[j] = __builtin_amdgcn_mfma_f32_16x16x32_bf16(f.a[ks], f.b[j][ks], acc[j], 0, 0, 0);
}
template <class F> DI void ck_epi(const f32x4 (&acc)[2], int wave, int lane, const F& epi) {
    const int mt = wave >> 1, nt0 = 2 * (wave & 1), r = lane & 15, q = lane >> 4;
#pragma unroll
    for (int j = 0; j < 2; ++j) epi(16 * mt + 4 * q, 16 * (nt0 + j) + r, acc[j]);
}
template <class F>
DI void ck_mm(const LAS bf16* A, const LAS bf16* Bt, const LAS bf16* A2, const LAS bf16* Bt2, int wave, int lane, const F& epi) {
    CkF f; ck_ld(f, A, Bt, wave, lane); f32x4 acc[2] = {{0.f, 0.f, 0.f, 0.f}, {0.f, 0.f, 0.f, 0.f}}; ck_mma(acc, f);
    if (A2) { CkF g; ck_ld(g, A2, Bt2, wave, lane); ck_mma(acc, g); }
    ck_epi(acc, wave, lane, epi);
}
#define CK_Z2 {{0.f, 0.f, 0.f, 0.f}, {0.f, 0.f, 0.f, 0.f}}
DI void ck_wr_row(LAS bf16* X, int m, int n, f32x4 v) {
#pragma unroll
    for (int g = 0; g < 4; ++g) X[(m + g) * CP + n] = (bf16)(pk2(v[g], 0.f) & 0xffffu);
}
DI void ck_wr_tr(LAS bf16* XT, int m, int n, f32x4 v) { *(LAS u32x2*)(XT + n * CP + m) = (u32x2){pk2(v[0], v[1]), pk2(v[2], v[3])}; }

DI void phase_chunkA(const Args& a, LAS unsigned char* lds, int wave, int lane, int tid, int bid, int G) {
    unsigned char* ws = (unsigned char*)a.ws;
    const float* Ww = (const float*)(ws + WS_W); const bf16* KKn = (const bf16*)(ws + WS_KK); const bf16* Bb = (const bf16*)(ws + WS_B);
    const bf16* Kk = (const bf16*)(ws + WS_K); const bf16* Rr = (const bf16*)(ws + WS_R); const bf16* Vv = (const bf16*)(ws + WS_V);
#define SL(i) ((LAS bf16*)(lds + (i) * CMS))
#define CK_BAR() do { asm volatile("s_waitcnt lgkmcnt(0)" ::: "memory"); __builtin_amdgcn_s_barrier(); asm volatile("" ::: "memory"); } while (0)
    LAS float* Gf = (LAS float*)(lds + 8 * CMS);
    LAS float* gC = (LAS float*)(lds + 14 * CMS);
    f32x4 nw0, nw1; u32x4 nr8, nk8, nv8, nkk8, nb8;
#define CK_LOADIN(cc, hh, bb) do { const int t_ = tid >> 3, c8_ = (tid & 7) * 8; const bool ok_ = CK * (cc) + t_ < L; const size_t ro_ = (size_t)((bb) * L + CK * (cc) + t_) * C + (hh) * 64 + c8_; \
        const f32x4 one_ = {1.f, 1.f, 1.f, 1.f}; const u32x4 z_ = {0u, 0u, 0u, 0u}; \
        nw0 = ok_ ? *(const f32x4*)(Ww + ro_) : one_; nw1 = ok_ ? *(const f32x4*)(Ww + ro_ + 4) : one_; \
        nr8 = ok_ ? *(const u32x4*)(Rr + ro_) : z_; nk8 = ok_ ? *(const u32x4*)(Kk + ro_) : z_; nv8 = ok_ ? *(const u32x4*)(Vv + ro_) : z_; nkk8 = ok_ ? *(const u32x4*)(KKn + ro_) : z_; nb8 = ok_ ? *(const u32x4*)(Bb + ro_) : z_; } while (0)
    if (bid < NCHUNK) { const int c0_ = bid % NCK, bh0_ = bid / NCK; CK_LOADIN(c0_, bh0_ & 15, bh0_ >> 4); }
    for (int cid = bid; cid < NCHUNK; cid += G) {
        const int c = cid % NCK, bh = cid / NCK, hd = bh & 15, b = bh >> 4; const int tok0 = CK * c; (void)tok0; (void)hd; (void)b;
        CK_BAR();
        const int t = tid >> 3, c8 = (tid & 7) * 8;
        float wv[8], gv[8], gp[8];
#pragma unroll
        for (int e = 0; e < 4; ++e) { wv[e] = nw0[e]; wv[4 + e] = nw1[e]; }
        const u32x4 r8 = nr8, k8 = nk8, v8 = nv8, kk8 = nkk8, b8 = nb8;
        { const int cid2 = cid + G; if (cid2 < NCHUNK) { const int c2 = cid2 % NCK, bh2 = cid2 / NCK; CK_LOADIN(c2, bh2 & 15, bh2 >> 4); } }
        { const int tl = lane >> 3;
#pragma unroll
          for (int e = 0; e < 8; ++e) { float x = wv[e];
              float y = __shfl_up(x, 8); if (tl >= 1) x *= y;
              y = __shfl_up(x, 16); if (tl >= 2) x *= y;
              y = __shfl_up(x, 32); if (tl >= 4) x *= y;
              gv[e] = x; }
          if (tl == 7) {
#pragma unroll
              for (int e = 0; e < 8; ++e) Gf[wave * 64 + c8 + e] = gv[e]; } }
        CK_BAR();
        {
#pragma unroll 1
          for (int w2 = 0; w2 < wave; ++w2) {
#pragma unroll
              for (int e = 0; e < 8; ++e) gv[e] *= Gf[w2 * 64 + c8 + e]; }
#pragma unroll
          for (int e = 0; e < 8; ++e) gp[e] = gv[e] / wv[e];
          if (t == CK - 1) {
#pragma unroll
              for (int e = 0; e < 8; ++e) gC[c8 + e] = gv[e]; } }
        {
          float rt[8], at[8], kt[8], bt[8], vv[8];
#pragma unroll
          for (int e = 0; e < 8; ++e) { const unsigned rw = (e < 2) ? r8.x : (e < 4) ? r8.y : (e < 6) ? r8.z : r8.w, kw = (e < 2) ? k8.x : (e < 4) ? k8.y : (e < 6) ? k8.z : k8.w, vw = (e < 2) ? v8.x : (e < 4) ? v8.y : (e < 6) ? v8.z : v8.w,
                  qw = (e < 2) ? kk8.x : (e < 4) ? kk8.y : (e < 6) ? kk8.z : kk8.w, bw = (e < 2) ? b8.x : (e < 4) ? b8.y : (e < 6) ? b8.z : b8.w;
              const float rv = (e & 1) ? bfhi(rw) : bflo(rw), kv = (e & 1) ? bfhi(kw) : bflo(kw), vx = (e & 1) ? bfhi(vw) : bflo(vw), qv = (e & 1) ? bfhi(qw) : bflo(qw), bv = (e & 1) ? bfhi(bw) : bflo(bw);
              const float ig = 1.f / gv[e];
              rt[e] = rv * gv[e]; at[e] = -qv * gp[e]; kt[e] = kv * ig; bt[e] = bv * ig; vv[e] = vx; }
          *(LAS u32x4*)(SL(6) + t * CP + c8) = (u32x4){pk2(rt[0], rt[1]), pk2(rt[2], rt[3]), pk2(rt[4], rt[5]), pk2(rt[6], rt[7])};
          *(LAS u32x4*)(SL(0) + t * CP + c8) = (u32x4){pk2(at[0], at[1]), pk2(at[2], at[3]), pk2(at[4], at[5]), pk2(at[6], at[7])};
          *(LAS u32x4*)(SL(4) + t * CP + c8) = (u32x4){pk2(kt[0], kt[1]), pk2(kt[2], kt[3]), pk2(kt[4], kt[5]), pk2(kt[6], kt[7])};
          *(LAS u32x4*)(SL(2) + t * CP + c8) = (u32x4){pk2(bt[0], bt[1]), pk2(bt[2], bt[3]), pk2(bt[4], bt[5]), pk2(bt[6], bt[7])};
          *(LAS u32x4*)(SL(10) + t * CP + c8) = (u32x4){pk2(vv[0], vv[1]), pk2(vv[2], vv[3]), pk2(vv[4], vv[5]), pk2(vv[6], vv[7])};
          { unsigned iw[4];
#pragma unroll
            for (int e = 0; e < 4; ++e) iw[e] = ((c8 + 2 * e == t) ? 0x3f80u : 0u) | ((c8 + 2 * e + 1 == t) ? 0x3f800000u : 0u);
            *(LAS u32x4*)(SL(11) + t * CP + c8) = (u32x4){iw[0], iw[1], iw[2], iw[3]}; } }
        CK_BAR();
#define CK_RUN2(A1, B1, E1, A2, B2, E2) do { CkF f1_, f2_; ck_ld(f1_, A1, B1, wave, lane); ck_ld(f2_, A2, B2, wave, lane); __builtin_amdgcn_sched_barrier(0); \
            f32x4 c1_[2] = CK_Z2, c2_[2] = CK_Z2; ck_mma(c1_, f1_); ck_mma(c2_, f2_); ck_epi(c1_, wave, lane, E1); ck_epi(c2_, wave, lane, E2); } while (0)
#define CK_RUN3(A1, B1, E1, A2, B2, E2, A3, B3, E3) do { CkF f1_, f2_, f3_; ck_ld(f1_, A1, B1, wave, lane); ck_ld(f2_, A2, B2, wave, lane); ck_ld(f3_, A3, B3, wave, lane); __builtin_amdgcn_sched_barrier(0); \
            f32x4 c1_[2] = CK_Z2, c2_[2] = CK_Z2, c3_[2] = CK_Z2; ck_mma(c1_, f1_); ck_mma(c2_, f2_); ck_mma(c3_, f3_); ck_epi(c1_, wave, lane, E1); ck_epi(c2_, wave, lane, E2); ck_epi(c3_, wave, lane, E3); } while (0)
        { auto t1 = [&](int m, int n, f32x4 v) { ck_wr_tr(SL(1), m, n, v); }; auto t3 = [&](int m, int n, f32x4 v) { ck_wr_tr(SL(3), m, n, v); };
          auto t5 = [&](int m, int n, f32x4 v) { ck_wr_tr(SL(5), m, n, v); }; auto t7 = [&](int m, int n, f32x4 v) { ck_wr_tr(SL(7), m, n, v); };
          CK_RUN2(SL(0), SL(11), t1, SL(2), SL(11), t3); CK_RUN2(SL(4), SL(11), t5, SL(10), SL(11), t7); }
        CK_BAR();
        { auto ePT = [&](int m, int n, f32x4 v) {
#pragma unroll
              for (int g = 0; g < 4; ++g) v[g] = (n < m + g) ? v[g] : 0.f;
              ck_wr_tr(SL(13), m, n, v); };
          auto ePA = [&](int m, int n, f32x4 v) { f32x4 tt;
#pragma unroll
              for (int g = 0; g < 4; ++g) { v[g] = (m + g < n) ? v[g] : 0.f; tt[g] = (m + g == n) ? 1.f : v[g]; }
              ck_wr_tr(SL(12), m, n, v); ck_wr_tr(SL(8), m, n, tt); };
          auto eMak = [&](int m, int n, f32x4 v) {
#pragma unroll
              for (int g = 0; g < 4; ++g) v[g] = (m + g < n) ? v[g] : 0.f;
              ck_wr_tr(SL(9), m, n, v); };
          CK_RUN3(SL(0), SL(2), ePT, SL(2), SL(0), ePA, SL(4), SL(0), eMak); }
        { auto eNrb = [&](int m, int n, f32x4 v) {
#pragma unroll
              for (int g = 0; g < 4; ++g) v[g] = (m + g <= n) ? v[g] : 0.f;
              ck_wr_tr(SL(10), m, n, v); };
          auto eNrk = [&](int m, int n, f32x4 v) {
#pragma unroll
              for (int g = 0; g < 4; ++g) v[g] = (m + g <= n) ? v[g] : 0.f;
              ck_wr_tr(SL(11), m, n, v); };
          CK_RUN2(SL(2), SL(6), eNrb, SL(4), SL(6), eNrk); }
        CK_BAR();
#define CK_NEU(TA, TB, PA_, PT_, PAN, PTN) do { \
            auto eT_ = [&](int m, int n, f32x4 v) { const u32x2 o = *(const LAS u32x2*)(SL(TA) + n * CP + m); v[0] += bflo(o.x); v[1] += bfhi(o.x); v[2] += bflo(o.y); v[3] += bfhi(o.y); ck_wr_tr(SL(TB), m, n, v); }; \
            auto eS1_ = [&](int m, int n, f32x4 v) { ck_wr_tr(SL(PTN), m, n, v); }; auto eS2_ = [&](int m, int n, f32x4 v) { ck_wr_tr(SL(PAN), m, n, v); }; \
            CK_RUN3(SL(PT_), SL(TA), eT_, SL(PA_), SL(PT_), eS1_, SL(PT_), SL(PA_), eS2_); CK_BAR(); } while (0)
        { auto eS1 = [&](int m, int n, f32x4 v) { ck_wr_tr(SL(2), m, n, v); }; auto eS2 = [&](int m, int n, f32x4 v) { ck_wr_tr(SL(0), m, n, v); };
          CK_RUN2(SL(12), SL(13), eS1, SL(13), SL(12), eS2); }
        CK_BAR();
        CK_NEU(8, 4, 0, 2, 12, 13);
        CK_NEU(4, 8, 12, 13, 0, 2);
        CK_NEU(8, 4, 0, 2, 12, 13);
        CK_NEU(4, 8, 12, 13, 0, 2);
        ck_mm(SL(2), SL(8), nullptr, nullptr, wave, lane, [&](int m, int n, f32x4 v) { const u32x2 o = *(const LAS u32x2*)(SL(8) + n * CP + m);
            v[0] += bflo(o.x); v[1] += bfhi(o.x); v[2] += bflo(o.y); v[3] += bfhi(o.y); ck_wr_tr(SL(4), m, n, v); });
        CK_BAR();
#undef CK_NEU
        { auto e12 = [&](int m, int n, f32x4 v) { ck_wr_tr(SL(12), m, n, v); }; auto e0 = [&](int m, int n, f32x4 v) { ck_wr_tr(SL(0), m, n, v); };
          CK_RUN2(SL(9), SL(7), e12, SL(4), SL(1), e0); }
        CK_BAR();
        { bf16* Pg = (bf16*)(ws + CH_P) + (size_t)cid * 4096; bf16* Rg = (bf16*)(ws + CH_RH) + (size_t)cid * 4096;
          auto e13 = [&](int m, int n, f32x4 v) { ck_wr_tr(SL(13), m, n, v); };
          auto eP = [&](int m, int n, f32x4 v) { const float gc = gC[n];
#pragma unroll
              for (int g = 0; g < 4; ++g) v[g] = gc * (((m + g == n) ? 1.f : 0.f) + v[g]);
              *(u32x2*)(Pg + n * 64 + m) = (u32x2){pk2(v[0], v[1]), pk2(v[2], v[3])}; };
          auto eR = [&](int m, int n, f32x4 v) { const u32x2 o = *(const LAS u32x2*)(SL(6) + n * CP + m);
              v[0] += bflo(o.x); v[1] += bfhi(o.x); v[2] += bflo(o.y); v[3] += bfhi(o.y);
              *(u32x2*)(Rg + n * 64 + m) = (u32x2){pk2(v[0], v[1]), pk2(v[2], v[3])}; };
          CK_RUN3(SL(4), SL(12), e13, SL(0), SL(3), eP, SL(0), SL(10), eR); }
        CK_BAR();
        { float* Qg = (float*)(ws + CH_Q) + (size_t)cid * 4096; float* Yg = (float*)(ws + CH_YL) + (size_t)cid * 4096;
          CkF f1, f2, f3, f4; ck_ld(f1, SL(13), SL(3), wave, lane); ck_ld(f2, SL(7), SL(5), wave, lane); ck_ld(f3, SL(13), SL(10), wave, lane); ck_ld(f4, SL(7), SL(11), wave, lane); __builtin_amdgcn_sched_barrier(0);
          f32x4 cq[2] = CK_Z2, cy[2] = CK_Z2; ck_mma(cq, f1); ck_mma(cq, f2); ck_mma(cy, f3); ck_mma(cy, f4);
          ck_epi(cq, wave, lane, [&](int m, int n, f32x4 v) { *(f32x4*)(Qg + n * 64 + m) = v * gC[n]; });
          ck_epi(cy, wave, lane, [&](int m, int n, f32x4 v) { *(f32x4*)(Yg + n * 64 + m) = v; }); }
#undef CK_RUN2
#undef CK_RUN3
    }
#undef SL
#undef CK_BAR
#undef CK_LOADIN
}
DI void phase_chunkB(const Args& a, LAS unsigned char* lds, int wave, int lane, int bid, int G) {
    unsigned char* ws = (unsigned char*)a.ws; LAS bf16* Zb = (LAS bf16*)lds;
    const int r = lane & 15, q = lane >> 4;
    if (wave != 0) return;
    for (int u = bid; u < NB * NH * 4; u += G) { const int iq = u & 3, bh = u >> 2;
        bf16x8 pf[4][2]; f32x4 qv[4];
#define CB_LOAD(cc) do { const size_t cid_ = (size_t)bh * NCK + (cc); const bf16* Pg_ = (const bf16*)(ws + CH_P) + cid_ * 4096; const float* Qg_ = (const float*)(ws + CH_Q) + cid_ * 4096; \
            _Pragma("unroll") for (int mt = 0; mt < 4; ++mt) { _Pragma("unroll") for (int ks = 0; ks < 2; ++ks) pf[mt][ks] = *(const bf16x8*)(Pg_ + (16 * mt + r) * 64 + 32 * ks + 8 * q); \
            _Pragma("unroll") for (int g = 0; g < 4; ++g) qv[mt][g] = Qg_[(16 * mt + 4 * q + g) * 64 + 16 * iq + r]; } } while (0)
        asm volatile("s_waitcnt lgkmcnt(0)" ::: "memory");
#pragma unroll
        for (int mt = 0; mt < 4; ++mt) { *(LAS u32x2*)(Zb + r * CP + 16 * mt + 4 * q) = (u32x2){0u, 0u};
            *(u32x2*)((bf16*)(ws + CH_ZS) + ((size_t)bh * NCK) * 4096 + (16 * iq + r) * 64 + 16 * mt + 4 * q) = (u32x2){0u, 0u}; }
        CB_LOAD(0);
        for (int c = 0; c < NCK - 1; ++c) { const size_t cid = (size_t)bh * NCK + c;
            asm volatile("s_waitcnt lgkmcnt(0)" ::: "memory");
            bf16x8 zf[2];
#pragma unroll
            for (int ks = 0; ks < 2; ++ks) zf[ks] = *(const LAS bf16x8*)(Zb + r * CP + 32 * ks + 8 * q);
            f32x4 z[4];
#pragma unroll
            for (int mt = 0; mt < 4; ++mt) { z[mt] = qv[mt];
#pragma unroll
                for (int ks = 0; ks < 2; ++ks) z[mt] = __builtin_amdgcn_mfma_f32_16x16x32_bf16(pf[mt][ks], zf[ks], z[mt], 0, 0, 0); }
            if (c + 1 < NCK - 1) CB_LOAD(c + 1);
#pragma unroll
            for (int mt = 0; mt < 4; ++mt) { const u32x2 zw = {pk2(z[mt][0], z[mt][1]), pk2(z[mt][2], z[mt][3])}; *(LAS u32x2*)(Zb + r * CP + 16 * mt + 4 * q) = zw;
                *(u32x2*)((bf16*)(ws + CH_ZS) + (cid + 1) * 4096 + (16 * iq + r) * 64 + 16 * mt + 4 * q) = zw; }
        }
    }
#undef CB_LOAD
}
DI void phase_chunkC(const Args& a, int l, int gw, int NGW, int lane) {
    unsigned char* ws = (unsigned char*)a.ws; const int r = lane & 15, q = lane >> 4;
    const bf16* Vv = (const bf16*)(ws + WS_V); const bf16* Gg = (const bf16*)(ws + WS_G); const float* RK = (const float*)(ws + WS_RK); bf16* ORW = (bf16*)(ws + WS_ORW);
    const float* lnw = a.inp(I_LNW) + (size_t)l * C; const float* lnb = a.inp(I_LNB) + (size_t)l * C;
    for (int u = gw; u < NCHUNK * 4; u += NGW) { const int tt = u & 3, cid = u >> 2; const int c = cid % NCK, bh = cid / NCK, hd = bh & 15, b = bh >> 4;
        const bf16* Zg = (const bf16*)(ws + CH_ZS) + (size_t)cid * 4096; const bf16* Rg = (const bf16*)(ws + CH_RH) + (size_t)cid * 4096; const float* Yg = (const float*)(ws + CH_YL) + (size_t)cid * 4096;
        const int t = 16 * tt + r, tok = CK * c + t; const bool ok = tok < L; const size_t ro = (size_t)(b * L + (ok ? tok : 0)) * C + hd * 64;
        bf16x8 bfr[2];
#pragma unroll
        for (int ks = 0; ks < 2; ++ks) bfr[ks] = *(const bf16x8*)(Rg + t * 64 + 32 * ks + 8 * q);
        f32x4 y[4]; float s = 0.f;
#pragma unroll
        for (int it = 0; it < 4; ++it) { f32x4 acc = *(const f32x4*)(Yg + t * 64 + 16 * it + 4 * q);
#pragma unroll
            for (int ks = 0; ks < 2; ++ks) acc = __builtin_amdgcn_mfma_f32_16x16x32_bf16(*(const bf16x8*)(Zg + (16 * it + r) * 64 + 32 * ks + 8 * q), bfr[ks], acc, 0, 0, 0);
            y[it] = acc; s += (acc[0] + acc[1]) + (acc[2] + acc[3]); }
        s += __shfl_xor(s, 16); s += __shfl_xor(s, 32); const float mean = s * (1.f / 64.f); float qs = 0.f;
#pragma unroll
        for (int it = 0; it < 4; ++it) { y[it] = y[it] - mean; qs += (y[it][0] * y[it][0] + y[it][1] * y[it][1]) + (y[it][2] * y[it][2] + y[it][3] * y[it][3]); }
        qs += __shfl_xor(qs, 16); qs += __shfl_xor(qs, 32); const float rstd = rsqrtf(qs * (1.f / 64.f) + GN_EPS);
        const float rk = RK[(size_t)(b * L + (ok ? tok : 0)) * NH + hd];
#pragma unroll
        for (int it = 0; it < 4; ++it) { const int ch = 16 * it + 4 * q; const u32x2 vw = *(const u32x2*)(Vv + ro + ch), gw_ = *(const u32x2*)(Gg + ro + ch);
            const f32x4 v = {bflo(vw.x), bfhi(vw.x), bflo(vw.y), bfhi(vw.y)}, g = {bflo(gw_.x), bfhi(gw_.x), bflo(gw_.y), bfhi(gw_.y)};
            const f32x4 lw = *(const f32x4*)(lnw + hd * 64 + ch), lb = *(const f32x4*)(lnb + hd * 64 + ch);
            const f32x4 o = (y[it] * rstd * lw + lb + rk * v) * g;
            if (ok) *(u32x2*)(ORW + ro + ch) = (u32x2){pk2(o[0], o[1]), pk2(o[2], o[3])}; }
    }
}
DI void phase_router(const Args& a, int l, LAS unsigned char* lds, int wave, int lane, int bid, int G, bool dummy = false) {
    unsigned char* ws = (unsigned char*)a.ws; const float* H = (const float*)(ws + WS_H); bf16* U = (bf16*)(ws + WS_U); const bf16* WRO = (const bf16*)(ws + WS_WRO) + (size_t)l * 80 * D;
    const float* gain = a.inp(I_NORM_FFN) + (size_t)l * D; const float* bco = a.inp(I_BCOARSE) + l * 8; const float* bfi = a.inp(I_BFINE) + l * 64;
    int* toke = (int*)(ws + WS_TOKE); int* toks = (int*)(ws + WS_TOKS); float* tokw = (float*)(ws + WS_TOKW); unsigned* cnt = (unsigned*)(ws + WS_CTL) + CW_CNT + l * 64 * 16;
    int* elist = (int*)(ws + WS_ELIST);
    if (dummy) { toke = (int*)(ws + WS_XR); toks = toke + 2 * T; tokw = (float*)(toks + 2 * T); cnt += 8192; U = (bf16*)(ws + WS_XR) + (size_t)8 * T; elist = (int*)(ws + WS_XR) + (size_t)(8 + 2048) * T; }
    LAS float* red = (LAS float*)lds;
    LAS float* ssp = red + 8 * 16 * 80;
    LAS float* lg = ssp + 8 * 16;
    LAS float* rs = lg + 16 * 72;
    const int tid = wave * 64 + lane;
    const int n = lane & 15, q = lane >> 4;
    f32x4 hv[8][2];
    const float* gp = gain + wave * 256 + 8 * q;
#define RT_LOADH(tile_) do { const float* hp_ = H + (size_t)((tile_) * 16 + n) * D + wave * 256 + 8 * q; _Pragma("unroll") for (int ks = 0; ks < 8; ++ks) { hv[ks][0] = *(const f32x4*)(hp_ + ks * 32); hv[ks][1] = *(const f32x4*)(hp_ + ks * 32 + 4); } } while (0)
    if (bid < T / 16) RT_LOADH(bid);
    for (int tile = bid; tile < T / 16; tile += G) { const int row0 = tile * 16;
        __syncthreads();
        f32x4 acc[5];
#pragma unroll
        for (int nt = 0; nt < 5; ++nt) acc[nt] = (f32x4){0.f, 0.f, 0.f, 0.f};
        float ss = 0.f;
#pragma unroll
        for (int ks = 0; ks < 8; ++ks) { const int k0 = wave * 256 + ks * 32 + 8 * q;
            const f32x4 g0 = *(const f32x4*)(gp + ks * 32), g1 = *(const f32x4*)(gp + ks * 32 + 4); const f32x4 x0 = hv[ks][0], x1 = hv[ks][1];
            ss += (x0[0] * x0[0] + x0[1] * x0[1]) + (x0[2] * x0[2] + x0[3] * x0[3]) + (x1[0] * x1[0] + x1[1] * x1[1]) + (x1[2] * x1[2] + x1[3] * x1[3]);
            const f32x4 y0 = x0 * g0, y1 = x1 * g1; u32x4 aw; aw.x = pk2(y0[0], y0[1]); aw.y = pk2(y0[2], y0[3]); aw.z = pk2(y1[0], y1[1]); aw.w = pk2(y1[2], y1[3]);
            const bf16x8 af = __builtin_bit_cast(bf16x8, aw);
#pragma unroll
            for (int nt = 0; nt < 5; ++nt) acc[nt] = __builtin_amdgcn_mfma_f32_16x16x32_bf16(af, *(const bf16x8*)(WRO + (size_t)(nt * 16 + n) * D + k0), acc[nt], 0, 0, 0); }
        ss += __shfl_xor(ss, 16); ss += __shfl_xor(ss, 32);
        if (q == 0) ssp[wave * 16 + n] = ss;
#pragma unroll
        for (int nt = 0; nt < 5; ++nt)
#pragma unroll
            for (int j = 0; j < 4; ++j) red[(wave * 16 + 4 * q + j) * 80 + nt * 16 + n] = acc[nt][j];
        __syncthreads();
        if (tid < 16) { float s = 0.f;
#pragma unroll
            for (int w = 0; w < 8; ++w) s += ssp[w * 16 + tid];
            rs[tid] = rsqrtf(s * (1.f / D) + NORM_EPS); }
        __syncthreads();
        for (int i = tid; i < 16 * 72; i += NTHR) { const int tk = i / 72, nn = i % 72; float s = 0.f;
#pragma unroll
            for (int w = 0; w < 8; ++w) s += red[(w * 16 + tk) * 80 + nn];
            lg[tk * 72 + nn] = s * rs[tk] + ((nn < 8) ? bco[nn] : bfi[nn - 8]); }
        { const float rstd = rs[n]; bf16* up = U + (size_t)(row0 + n) * D + wave * 256 + 8 * q;
#pragma unroll
          for (int ks = 0; ks < 8; ++ks) { const f32x4 g0 = *(const f32x4*)(gp + ks * 32), g1 = *(const f32x4*)(gp + ks * 32 + 4); const f32x4 y0 = hv[ks][0] * rstd * g0, y1 = hv[ks][1] * rstd * g1;
              *(u32x4*)(up + ks * 32) = (u32x4){pk2(y0[0], y0[1]), pk2(y0[2], y0[3]), pk2(y1[0], y1[1]), pk2(y1[2], y1[3])}; } }
        if (tile + G < T / 16) RT_LOADH(tile + G);
        __syncthreads();
        if (tid < 16) { const int m = row0 + tid; const LAS float* p = lg + tid * 72;
            int gi = 0; float gm = p[0];
#pragma unroll
            for (int j = 1; j < 8; ++j) if (p[j] > gm) { gm = p[j]; gi = j; }
            float se = 0.f;
#pragma unroll
            for (int j = 0; j < 8; ++j) se += __expf(p[j] - gm);
            const float pgrp = 1.f / se;
            const LAS float* f = p + 8 + gi * 8;
            int i0 = 0; float f0 = f[0];
#pragma unroll
            for (int j = 1; j < 8; ++j) if (f[j] > f0) { f0 = f[j]; i0 = j; }
            int i1 = -1; float f1 = -3.0e38f;
#pragma unroll
            for (int j = 0; j < 8; ++j) if (j != i0 && f[j] > f1) { f1 = f[j]; i1 = j; }
            const float e1 = __expf(f1 - f0), den = 1.f / (1.f + e1);
            const int e0x = gi * 8 + i0, e1x = gi * 8 + i1;
            toke[2 * m] = e0x; toke[2 * m + 1] = e1x; tokw[2 * m] = den * pgrp; tokw[2 * m + 1] = e1 * den * pgrp;
            const int s0 = (int)__hip_atomic_fetch_add(cnt + e0x * 16, 1u, RLX_AGENT), s1 = (int)__hip_atomic_fetch_add(cnt + e1x * 16, 1u, RLX_AGENT);
            toks[2 * m] = s0; toks[2 * m + 1] = s1; elist[(size_t)e0x * T + s0] = m; elist[(size_t)e1x * T + s1] = m; }
    }
}
#undef RT_LOADH
constexpr int MS_XOFF = 2 * 128 * 128, MS_XBUF = 48 * 128, MS_XWAVE = 2 * MS_XBUF;
constexpr int MS_TILE = 128 * 128;
template <int MODE, int VAR = 0>
DI void moe_stream_phase(const Args& a, int l, LAS unsigned char* lds, int wave, int lane, int tid, int bid, int G, int lw = -1, size_t out_off = 0) {
    unsigned char* ws = (unsigned char*)a.ws; LAS int* lc = (LAS int*)(lds + LDSCTL_OFF);
    moe_tables((const unsigned*)(ws + WS_CTL) + CW_CNT + l * 64 * 16, lc, tid);
    if (lw >= 0) l = lw;
    const size_t o_hid = out_off ? out_off : WS_HID, o_yr = out_off ? out_off : WS_YR;
    constexpr int KD = (MODE == 0) ? D : DEXP, NT = KD / 64, NSLAB = (MODE == 0) ? 8 : 16, LDW = (MODE == 0) ? DEXP : D, LDX = KD;
    const int half = wave & 1, nb16 = lane & 15, kb = 4 * (wave >> 1) + (lane >> 4);
    const int tk = lane & 15, q = lane >> 4;
    const GAS char* wmat = (const GAS char*)((MODE == 0) ? (half ? a.inp(I_WEU) : a.inp(I_WEG)) : a.inp(I_WED));
    const unsigned wvo = (unsigned)((4 * kb * LDW + 4 * nb16) * 4);
    const int lw0 = (64 * half + 4 * nb16) * 128 + (((kb >> 1) ^ ((2 * nb16) & 7)) << 4) + (kb & 1) * 8, lw1 = lw0 ^ 16;
    const int rd_g = (tk >> 1) & 7;
    for (int vb = bid; vb < NEXP * NSLAB; vb += G) {
        const int xcd = vb & 7, idx = vb >> 3; const int e = xcd * 8 + idx / NSLAB, slab = idx % NSLAB;
        const int M = __builtin_amdgcn_readfirstlane(lc[LC_CNT / 4 + e]), row0 = __builtin_amdgcn_readfirstlane(lc[LC_PSTART / 4 + e]);
        const size_t wuo = (MODE == 0) ? ((size_t)(l * NEXP + e) * D * DEXP + slab * 64) * 4 : ((size_t)(l * NEXP + e) * DEXP * D + slab * 128 + 64 * half) * 4;
        const __amdgpu_buffer_rsrc_t wrs = __builtin_amdgcn_make_buffer_rsrc((void*)(wmat + wuo), 0, KD * LDW * 4, 0x00020000);
        const __amdgpu_buffer_rsrc_t xrs = __builtin_amdgcn_make_buffer_rsrc((MODE == 0) ? (void*)(ws + WS_U) : (void*)((const GAS char*)(ws + WS_HID) + (size_t)row0 * LDX * 2), 0, 0x7fffffff, 0x00020000);
        const int* el = (const int*)(ws + WS_ELIST) + (size_t)e * T;
        for (int rp = 0; rp < M; rp += 384) {
            unsigned xso[6];
#pragma unroll
            for (int i = 0; i < 6; ++i) { int tok = rp + wave * 48 + 8 * i + (lane >> 3); tok = min(tok, M - 1); if (VAR == 5) tok &= 15; if (MODE == 0) tok = el[tok]; xso[i] = (unsigned)(tok * LDX * 2 + (lane & 7) * 16); }
            LAS unsigned char* xw = lds + MS_XOFF + wave * MS_XWAVE; const int xwo = (lane >> 3) * 128 + (((lane & 7) ^ ((lane >> 4) & 3)) << 4);
            const LAS unsigned char* xr = lds + MS_XOFF + wave * MS_XWAVE + tk * 128 + ((q ^ rd_g) << 4);
            f32x4 acc[3][8];
#pragma unroll
            for (int mt = 0; mt < 3; ++mt)
#pragma unroll
                for (int j = 0; j < 8; ++j) acc[mt][j] = (f32x4){0.f, 0.f, 0.f, 0.f};
            f32x4 wr[2][4];
            bf16x8 xs[6];
#define MS_CL(t) (((t) < NT) ? (t) : NT - 1)
#define MS_WLOAD(set, t) do { _Pragma("unroll") for (int r_ = 0; r_ < 4; ++r_) wr[set][r_] = __builtin_bit_cast(f32x4, __builtin_amdgcn_raw_buffer_load_b128(wrs, (int)wvo + r_ * LDW * 4, MS_CL(t) * (64 * LDW * 4), 0)); } while (0)
#define MS_WCOMMIT(set, bufi) do { LAS unsigned char* wb_ = lds + (bufi) * MS_TILE; _Pragma("unroll") for (int i_ = 0; i_ < 4; ++i_) { \
            u32x2 p_; p_.x = pk2(wr[set][0][i_], wr[set][1][i_]); p_.y = pk2(wr[set][2][i_], wr[set][3][i_]); \
            *(LAS u32x2*)(wb_ + ((i_ < 2) ? lw0 : lw1) + i_ * 128) = p_; } } while (0)
#define MS_XSLOAD(t) do { _Pragma("unroll") for (int i_ = 0; i_ < 6; ++i_) xs[i_] = __builtin_bit_cast(bf16x8, __builtin_amdgcn_raw_buffer_load_b128(xrs, (int)xso[i_], MS_CL(t) * 128, 0)); } while (0)
#define MS_XSWRITE(bufi) do { _Pragma("unroll") for (int i_ = 0; i_ < 6; ++i_) *(LAS bf16x8*)(xw + (bufi) * MS_XBUF + i_ * 1024 + ((i_ & 1) ? (xwo ^ 64) : xwo)) = xs[i_]; } while (0)
#define MS_WF(dst, bufi, g) do { const LAS unsigned char* wb_ = lds + (bufi) * MS_TILE + tk * 128; _Pragma("unroll") for (int jj = 0; jj < 4; ++jj) \
            dst[jj] = *(const LAS bf16x8*)(wb_ + (16 * (4 * ((g) & 1) + jj)) * 128 + (((4 * ((g) >> 1) + q) ^ rd_g) << 4)); } while (0)
#define MS_XF(ks, bufi) do { _Pragma("unroll") for (int mt = 0; mt < 3; ++mt) xf[mt] = *(const LAS bf16x8*)(((ks) ? xr1 : xr) + (bufi) * MS_XBUF + mt * 2048); } while (0)
#define MS_MM(wf, g) do { _Pragma("unroll") for (int jj = 0; jj < 4; ++jj) _Pragma("unroll") for (int mt = 0; mt < 3; ++mt) \
            acc[mt][4 * ((g) & 1) + jj] = __builtin_amdgcn_mfma_f32_16x16x32_bf16(wf[jj], xf[mt], acc[mt][4 * ((g) & 1) + jj], 0, 0, 0); } while (0)
#define MS_COMPUTE(bufi) do { bf16x8 wf_[4], xf[3]; MS_XF(0, bufi); MS_WF(wf_, bufi, 0); __builtin_amdgcn_sched_barrier(0); MS_MM(wf_, 0); __builtin_amdgcn_sched_barrier(0); \
            MS_WF(wf_, bufi, 1); __builtin_amdgcn_sched_barrier(0); MS_MM(wf_, 1); __builtin_amdgcn_sched_barrier(0); MS_XF(1, bufi); MS_WF(wf_, bufi, 2); __builtin_amdgcn_sched_barrier(0); MS_MM(wf_, 2); \
            __builtin_amdgcn_sched_barrier(0); MS_WF(wf_, bufi, 3); __builtin_amdgcn_sched_barrier(0); MS_MM(wf_, 3); } while (0)
#define MS_STEP(I, J, t) do { MS_WCOMMIT(J, J); MS_WLOAD(J, (t) + 3); MS_COMPUTE(I); MS_XSWRITE(J); MS_XSLOAD((t) + 2); __syncthreads(); } while (0)
            const LAS unsigned char* xr1 = lds + MS_XOFF + wave * MS_XWAVE + tk * 128 + (((4 + q) ^ rd_g) << 4);
            __syncthreads();
            MS_XSLOAD(0); MS_WLOAD(0, 0); MS_WLOAD(1, 1);
            MS_WCOMMIT(0, 0); MS_WLOAD(0, 2);
            MS_XSWRITE(0); MS_XSLOAD(1);
            __syncthreads();
#pragma unroll 1
            for (int t = 0; t < NT; t += 2) { MS_STEP(0, 1, t); MS_STEP(1, 0, t + 1); }
#pragma unroll
            for (int mt = 0; mt < 3; ++mt) { const int tok = rp + wave * 48 + mt * 16 + tk;
                if (tok < M) {
                    if (MODE == 0) { bf16* o = (bf16*)(ws + o_hid) + (size_t)(row0 + tok) * DEXP + slab * 64 + 4 * q;
#pragma unroll
                        for (int j = 0; j < 4; ++j) { float h[4];
#pragma unroll
                            for (int i = 0; i < 4; ++i) { const float gt = acc[mt][j][i]; h[i] = gt * sigmoidf_(gt) * acc[mt][j + 4][i]; }
                            *(u32x2*)(o + 16 * j) = (u32x2){pk2(h[0], h[1]), pk2(h[2], h[3])}; }
                    } else { bf16* o = (bf16*)(ws + o_yr) + (size_t)(row0 + tok) * D + slab * 128 + 4 * q;
#pragma unroll
                        for (int j = 0; j < 8; ++j) *(u32x2*)(o + 16 * j) = (u32x2){pk2(acc[mt][j][0], acc[mt][j][1]), pk2(acc[mt][j][2], acc[mt][j][3])}; } } }
#undef MS_CL
#undef MS_XSLOAD
#undef MS_XSWRITE
#undef MS_XF
#undef MS_STEP
#undef MS_WLOAD
#undef MS_WCOMMIT
#undef MS_COMPUTE
#undef MS_WF
#undef MS_MM
        }
    }
}

constexpr int PH_PER_LAYER = 10, NPHASE = 1 + 2 * PH_PER_LAYER + 1;
__global__ void __launch_bounds__(NTHR, 2) mk_fwd(ArgsV argsv) {
    extern __shared__ __attribute__((aligned(16))) unsigned char lds_raw[];
    LAS unsigned char* lds = (LAS unsigned char*)lds_raw;
    Args args; args.p = (ArgsP)__builtin_amdgcn_kernarg_segment_ptr(); args.ws = (GAS unsigned char*)args.p->ws; args.out = (GAS float*)args.p->out;
    { const int tid0 = threadIdx.x; for (int u = tid0; u < (LDS_BYTES - LDSCTL_OFF) / 4; u += NTHR) ((LAS unsigned*)(lds + LDSCTL_OFF))[u] = 0u; }
    __syncthreads();
    XcdBarrier bar; bar.bar = (unsigned*)(args.ws + WS_CTL) + CW_BAR; bar.x = 0; bar.st = nullptr;
    const int lo = args.p->ph_lo, hi = args.p->ph_hi;
    if (hi - lo > 1) bar = xcd_barrier_post((unsigned*)(args.ws + WS_CTL) + CW_BAR, (volatile LAS unsigned*)(lds + LDSCTL_OFF + LC_BAR));
#ifndef PHMASK
#define PHMASK 0xffffffffu
#endif
#define PHBIT(k) ((k) == 0 ? 0 : ((k) == NPHASE - 1 ? 12 : 1 + ((k) - 1) % PH_PER_LAYER))
#define IN(k) (((PHMASK >> PHBIT(k)) & 1u) && lo <= (k) && (k) < hi)
#define SEAM(k) do { if (IN(k) && IN((k) + 1)) xcd_barrier(bar); } while (0)
#define PH_BEGIN() int tid = threadIdx.x; asm volatile("" : "+v"(tid)); Args a = args; asm volatile("" : "+s"(a.p), "+s"(a.ws), "+s"(a.out)); unsigned char* ws = (unsigned char*)a.ws; \
    const int lane = tid & 63, wave = __builtin_amdgcn_readfirstlane(tid >> 6); int G = gridDim.x, bid = blockIdx.x; asm volatile("" : "+s"(G), "+s"(bid)); const int gw = bid * NWAVES + wave, NGW = G * NWAVES; (void)lane; (void)gw; (void)NGW; (void)ws

#ifndef PROBE_DUP
#define PROBE_DUP 0u
#endif
#define DUP(bit) if constexpr (((PROBE_DUP >> (bit)) & 1u) != 0u)
    enum { PB_CONVERT = 0, PB_NORM0, PB_GEMM1, PB_VT, PB_RWKVPREP, PB_SCAN, PB_ATTN, PB_POST, PB_BRANCH, PB_GATHER, PB_MOEK, PB_MOEL, PB_FINAL, PB_WOUT, PB_ROUTER, PB_MOEK_COLD, PB_MOEL_COLD, PB_MK5, PB_CKA, PB_CKB, PB_CKC };

    if (IN(0)) { { PH_BEGIN(); phase_convert<2>(a, 0, lds, gw, NGW, wave, lane); } DUP(PB_CONVERT) { PH_BEGIN(); phase_convert<2>(a, 0, lds, gw, NGW, wave, lane); } } SEAM(0);

#pragma unroll 1
    for (int l = 0; l < 2; ++l) {
        const int pb = 1 + l * PH_PER_LAYER;
        if (IN(pb + 0)) { { PH_BEGIN(); phase_norm<0>(a, a.inp(I_NORM_MIX) + (size_t)l * D, l > 0, l - 1, lds, tid, gw, NGW, lane, (l == 0) ? a.inp(I_X) : nullptr, a.inp(I_META)); }
            DUP(PB_NORM0) { if (l == 0) { PH_BEGIN(); phase_norm<0>(a, a.inp(I_NORM_MIX) + (size_t)l * D, false, 0, lds, tid, gw, NGW, lane, a.inp(I_X), a.inp(I_META)); } } } SEAM(pb + 0);
#define RUN_GEMM1() { PH_BEGIN(); pg8::RectOrder S; S.init(ws + WS_U, (const bf16*)(ws + WS_W1T) + (size_t)l * NZ * D, D, D, TP / 256, NZ / 256, G, bid); \
            pg8::EpiBf16 E{(bf16*)(ws + WS_Z), NZ, (const float*)(ws + WS_BIAS) + (size_t)l * NZ}; \
            pg8::gemm_phase<pg8::EpiBf16, pg8::RectOrder>(lds, pg8::Dims{D, D, D / 64}, S, E); }
        if (IN(pb + 1)) { RUN_GEMM1(); DUP(PB_GEMM1) RUN_GEMM1();
            if (l == 0) { PH_BEGIN(); const int nfull = (TP / 256) * (NZ / 256) % G; if (nfull != 0 && bid >= nfull) phase_convert<0>(a, 1, lds, (bid - nfull) * NWAVES + wave, (G - nfull) * NWAVES, wave, lane);
                          else if (nfull == 0) phase_convert<0>(a, 1, lds, gw, NGW, wave, lane); } } SEAM(pb + 1);
        if (IN(pb + 2)) { { PH_BEGIN(); phase_rope(a, gw, NGW, lane); } { PH_BEGIN(); phase_vt(a, gw, NGW, lane); } DUP(PB_VT) { PH_BEGIN(); phase_vt(a, gw, NGW, lane); }
            { PH_BEGIN(); phase_rwkvprep(a, l, lds, tid, gw, NGW, lane); } DUP(PB_RWKVPREP) { PH_BEGIN(); phase_rwkvprep(a, l, lds, tid, gw, NGW, lane); } } SEAM(pb + 2);
        if (IN(pb + 3)) { { PH_BEGIN(); phase_chunkA(a, lds, wave, lane, tid, bid, G); } DUP(PB_CKA) { PH_BEGIN(); phase_chunkA(a, lds, wave, lane, tid, bid, G); }
            { PH_BEGIN(); phase_attn(a, l, gw, NGW, lane); } DUP(PB_ATTN) { PH_BEGIN(); phase_attn(a, l, gw, NGW, lane); }
            xcd_barrier(bar);
            { PH_BEGIN(); phase_chunkB(a, lds, wave, lane, bid, G); if (wave != 0) phase_convert<1>(a, l, lds, bid * (NWAVES - 1) + wave - 1, G * (NWAVES - 1), wave, lane); }
            DUP(PB_CKB) { PH_BEGIN(); phase_chunkB(a, lds, wave, lane, bid, G); } xcd_barrier(bar);
            { PH_BEGIN(); phase_chunkC(a, l, gw, NGW, lane); } DUP(PB_CKC) { PH_BEGIN(); phase_chunkC(a, l, gw, NGW, lane); } }
        SEAM(pb + 3);
#define RUN_BRANCH() { \
            { PH_BEGIN(); pg8::RectOrder S; S.init(ws + WS_OATT, (const bf16*)(ws + WS_WAT) + (size_t)l * D * C, C, C, MBIG / 256, D / 256, G, bid); \
              pg8::EpiGate E{(bf16*)(ws + WS_T1), (const bf16*)(ws + WS_Z), ZGA, nullptr}; \
              pg8::gemm_phase<pg8::EpiGate, pg8::RectOrder>(lds, pg8::Dims{C, C, C / 64}, S, E); \
              skinny64((const bf16*)(ws + WS_OATT), C, (const bf16*)(ws + WS_WAT) + (size_t)l * D * C, C, D, C, MBIG, lds, SkGate{(bf16*)(ws + WS_T1), (const bf16*)(ws + WS_Z), ZGA, nullptr}, wave, lane, bid, G); } \
            { PH_BEGIN(); pg8::RectOrder S; S.init(ws + WS_ORW, (const bf16*)(ws + WS_WRT) + (size_t)l * D * C, C, C, MBIG / 256, D / 256, G, bid); \
              pg8::EpiGate E{(bf16*)(ws + WS_MIX), (const bf16*)(ws + WS_Z), ZGR, (const bf16*)(ws + WS_T1)}; \
              pg8::gemm_phase<pg8::EpiGate, pg8::RectOrder>(lds, pg8::Dims{C, C, C / 64}, S, E); \
              skinny64((const bf16*)(ws + WS_ORW), C, (const bf16*)(ws + WS_WRT) + (size_t)l * D * C, C, D, C, MBIG, lds, SkGate{(bf16*)(ws + WS_MIX), (const bf16*)(ws + WS_Z), ZGR, (const bf16*)(ws + WS_T1)}, wave, lane, bid, G); } }
        if (IN(pb + 5)) { RUN_BRANCH(); DUP(PB_BRANCH) RUN_BRANCH(); } SEAM(pb + 5);
#define RUN_WOUT(HP) { PH_BEGIN(); pg8::RectOrder S; S.init(ws + WS_MIX, (const bf16*)(ws + WS_WOT) + (size_t)l * D * D, D, D, MBIG / 256, D / 256, G, bid); \
            pg8::EpiResAdd E{(float*)(ws + (HP)), (l == 0) ? a.inp(I_X) : nullptr, a.inp(I_META)}; \
            pg8::gemm_phase<pg8::EpiResAdd, pg8::RectOrder>(lds, pg8::Dims{D, D, D / 64}, S, E); \
            skinny64((const bf16*)(ws + WS_MIX), D, (const bf16*)(ws + WS_WOT) + (size_t)l * D * D, D, D, D, MBIG, lds, SkRes{(float*)(ws + (HP)), (l == 0) ? a.inp(I_X) : nullptr, a.inp(I_META)}, wave, lane, bid, G); }
        if (IN(pb + 6)) { RUN_WOUT(WS_H); DUP(PB_WOUT) RUN_WOUT(WS_YR); } SEAM(pb + 6);
        if (IN(pb + 7)) { { PH_BEGIN(); phase_router(a, l, lds, wave, lane, bid, G); } DUP(PB_ROUTER) { PH_BEGIN(); phase_router(a, l, lds, wave, lane, bid, G, true); } } SEAM(pb + 7);
        if (IN(pb + 8)) { { PH_BEGIN(); moe_stream_phase<0>(a, l, lds, wave, lane, tid, bid, G); } DUP(PB_MOEK) { PH_BEGIN(); moe_stream_phase<0>(a, l, lds, wave, lane, tid, bid, G); }
            DUP(PB_MOEK_COLD) { PH_BEGIN(); moe_stream_phase<0>(a, l, lds, wave, lane, tid, bid, G, 1 - l, WS_T1); }
            DUP(PB_MK5) { PH_BEGIN(); moe_stream_phase<0, 5>(a, l, lds, wave, lane, tid, bid, G, 1 - l, WS_T1); } } SEAM(pb + 8);
        if (IN(pb + 9)) { { PH_BEGIN(); moe_stream_phase<1>(a, l, lds, wave, lane, tid, bid, G); } DUP(PB_MOEL) { PH_BEGIN(); moe_stream_phase<1>(a, l, lds, wave, lane, tid, bid, G); }
            DUP(PB_MOEL_COLD) { PH_BEGIN(); moe_stream_phase<1>(a, l, lds, wave, lane, tid, bid, G, 1 - l, WS_XR); } } SEAM(pb + 9);
    }
    if (IN(NPHASE - 1)) { { PH_BEGIN(); phase_norm<1>(a, a.inp(I_NORM_FINAL), true, 1, lds, tid, gw, NGW, lane); } DUP(PB_FINAL) { PH_BEGIN(); phase_norm<1>(a, a.inp(I_NORM_FINAL), true, 1, lds, tid, gw, NGW, lane); } }
#undef IN
#undef SEAM
}

extern "C" void kernel_launch(void* const* d_in, const int* in_sizes, int n_in, void* d_out, int out_size, void* d_ws, size_t ws_size, hipStream_t stream) {
    static int grid = 0;
    if (grid == 0) {
        if (n_in != 33 || ws_size < WS_END) { fprintf(stderr, "kernel_launch: need 33 inputs and %zu bytes of workspace (got %d, %zu)\n", (size_t)WS_END, n_in, ws_size); grid = -1; return; }
        int dev = 0, cus = 0, per_cu = 0;
        if (hipGetDevice(&dev) != hipSuccess || hipDeviceGetAttribute(&cus, hipDeviceAttributeMultiprocessorCount, dev) != hipSuccess) { grid = -1; return; }
        if (hipFuncSetAttribute((const void*)mk_fwd, hipFuncAttributeMaxDynamicSharedMemorySize, LDS_BYTES) != hipSuccess) { fprintf(stderr, "kernel_launch: hipFuncSetAttribute failed\n"); grid = -1; return; }
        if (hipOccupancyMaxActiveBlocksPerMultiprocessor(&per_cu, (const void*)mk_fwd, NTHR, LDS_BYTES) != hipSuccess || per_cu < 1) fprintf(stderr, "kernel_launch: occupancy query says %d\n", per_cu);
        (void)hipGetLastError();
        grid = cus;
    }
    if (grid < 0) return;
    (void)hipMemsetAsync((char*)d_ws + WS_CTL, 0, 128 * 1024, stream);
    ArgsV a{};
    for (int i = 0; i < 33; ++i) a.in[i] = (const float*)d_in[i];
    a.out = (float*)d_out; a.ws = (unsigned char*)d_ws;
#if MK_N_LAUNCHES == 1
    a.ph_lo = 0; a.ph_hi = NPHASE;
    hipLaunchKernelGGL(mk_fwd, dim3(grid), dim3(NTHR), LDS_BYTES, stream, a);
#else
    for (int p = 0; p < NPHASE; ++p) { a.ph_lo = p; a.ph_hi = p + 1; hipLaunchKernelGGL(mk_fwd, dim3(grid), dim3(NTHR), LDS_BYTES, stream, a); }
#endif
}
```

```cpp
#include <hip/hip_runtime.h>
#include <cstdio>
#include <cstdint>

#ifndef MK_N_LAUNCHES
#define MK_N_LAUNCHES 1
#endif

#define GAS __attribute__((address_space(1)))
#define LAS __attribute__((address_space(3)))
typedef unsigned short bf16;
typedef short bf16x8 __attribute__((ext_vector_type(8)));
typedef float f32x4 __attribute__((ext_vector_type(4)));
typedef float f32x2 __attribute__((ext_vector_type(2)));
typedef float f32x16 __attribute__((ext_vector_type(16)));
typedef unsigned u32x4 __attribute__((ext_vector_type(4)));
typedef unsigned u32x2 __attribute__((ext_vector_type(2)));
typedef __bf16 bf16x2_t __attribute__((ext_vector_type(2)));
typedef GAS unsigned gu32;
#define RLX_AGENT __ATOMIC_RELAXED, __HIP_MEMORY_SCOPE_AGENT
#define DI __device__ __forceinline__

constexpr int D = 2048, NB = 4, SEQ = 2048, NMETA = 16, L = SEQ + NMETA, T = NB * L  , TP = 8448  ;
constexpr int NIN = 8896, NZ = 8960  ;
constexpr int ZQ = 0, ZK = 1024, ZV = 1280, ZGA = 1536, ZGR = 3584, ZR0 = 5632, ZVD = 8896;
constexpr int C = 1024, NH = 16, HD = 64;
constexpr int NEXP = 64, DEXP = 512, PR = 128 * 256;
constexpr int LPAD = 2080;
constexpr float NORM_EPS = 1e-5f, GN_EPS = 64e-5f;
constexpr int NWAVES = 8, NTHR = 512;
constexpr int MBIG = 8192;
static_assert(T - MBIG == 64, "skinny64 covers exactly 64 rows");

constexpr size_t al256(size_t x) { return (x + 255) & ~(size_t)255; }
constexpr size_t WS_CTL = 0, CTL_BYTES = 1u << 20;
constexpr size_t WS_H = WS_CTL + CTL_BYTES;
constexpr size_t WS_U = WS_H + (size_t)TP * D * 4;
constexpr size_t WS_Z = WS_U + (size_t)TP * D * 2;
constexpr size_t WS_R = WS_Z + (size_t)TP * NZ * 2;
constexpr size_t SZ_TC = (size_t)T * C * 4;
constexpr size_t WS_W = WS_R + SZ_TC, WS_K = WS_W + SZ_TC, WS_V = WS_K + SZ_TC, WS_KK = WS_V + SZ_TC, WS_B = WS_KK + SZ_TC;
constexpr size_t WS_Y = WS_B + SZ_TC, WS_VF = WS_Y + SZ_TC, WS_G = WS_VF + SZ_TC;
constexpr size_t WS_RK = WS_G + SZ_TC;
constexpr size_t WS_VT = al256(WS_RK + (size_t)T * NH * 4);
constexpr size_t WS_OATT = al256(WS_VT + (size_t)NB * 4 * HD * LPAD * 2);
constexpr size_t WS_ORW = WS_OATT + (size_t)TP * C * 2;
constexpr size_t WS_T1 = WS_ORW + (size_t)TP * C * 2;
constexpr size_t WS_MIX = WS_T1 + (size_t)TP * D * 2;
constexpr size_t WS_XR = WS_MIX + (size_t)TP * D * 2;
constexpr size_t WS_HID = WS_XR + (size_t)PR * D * 2;
constexpr size_t WS_YR = WS_HID + (size_t)PR * DEXP * 2;
constexpr size_t WS_TOKE = WS_YR + (size_t)PR * D * 2;
constexpr size_t WS_TOKS = al256(WS_TOKE + (size_t)T * 2 * 4);
constexpr size_t WS_TOKW = al256(WS_TOKS + (size_t)T * 2 * 4);
constexpr size_t WS_ELIST = al256(WS_TOKW + (size_t)T * 2 * 4);
constexpr size_t WS_ROPE = al256(WS_ELIST + (size_t)NEXP * T * 4);
constexpr size_t WS_BIAS = al256(WS_ROPE + (size_t)L * 16 * 4);
constexpr size_t WS_W1T = al256(WS_BIAS + (size_t)2 * NZ * 4);
constexpr size_t WS_WAT = WS_W1T + (size_t)2 * NZ * D * 2;
constexpr size_t WS_WRT = WS_WAT + (size_t)2 * D * C * 2;
constexpr size_t WS_WOT = WS_WRT + (size_t)2 * D * C * 2;
constexpr size_t WS_WRO = WS_WOT + (size_t)2 * D * D * 2;
constexpr size_t WS_LDEC = WS_WRO + (size_t)2 * 80 * D * 2;
constexpr size_t WS_LICL = WS_LDEC + (size_t)2 * C * 64 * 2;
constexpr size_t WS_LGAT = WS_LICL + (size_t)2 * C * 64 * 2;
constexpr size_t WS_LVUP = WS_LGAT + (size_t)2 * C * 64 * 2;
constexpr size_t WS_END = WS_LVUP + (size_t)C * 32 * 2;
constexpr int CW_PQ = 29696;
constexpr int CW_CQ = 30720;
constexpr int CW_NQ = 32768;
constexpr int CW_AQ = 28672;
constexpr int CW_TMO = 0, CW_BAR = 4096, CW_CNT = 16384;

constexpr int RING_BYTES = 131072, LDSCTL_OFF = RING_BYTES, LDS_BYTES = 147456;
constexpr int LC_BAR = 0, LC_NTILE = 16, LC_TILEE = 32  , LC_PSTART = 32 + 512  , LC_CNT = LC_PSTART + 256  ;

DI unsigned pk2(float a, float b) { f32x2 v = {a, b}; bf16x2_t r = __builtin_convertvector(v, bf16x2_t); return __builtin_bit_cast(unsigned, r); }
DI float bf2f(unsigned short b) { return __builtin_bit_cast(float, (unsigned)b << 16); }
DI float bflo(unsigned u) { return __builtin_bit_cast(float, u << 16); }
DI float bfhi(unsigned u) { return __builtin_bit_cast(float, u & 0xffff0000u); }
DI float wave_sum(float v) {
#pragma unroll
    for (int o = 1; o < 64; o <<= 1) v += __shfl_xor(v, o);
    return v;
}
DI float sigmoidf_(float x) { return 1.f / (1.f + __expf(-x)); }
#define LDS_WAIT() asm volatile("s_waitcnt lgkmcnt(0)" ::: "memory")
#define VM_WAIT() asm volatile("s_waitcnt vmcnt(0)" ::: "memory")

#define XB_TMO      128
#define XB_XCNT(j)  (256  + 64 * (j))
#define XB_XSUB(j)  (1280 + 64 * (j))
#define XB_XGEN(j)  (2304 + 64 * (j))
#define XB_TOP      3328
#define XB_TOPGEN   3392
#define XCD_BAR_WORDS 3456
#define XB_SPIN_CAP (1u << 22)

__device__ __forceinline__ unsigned xb_ld(unsigned* p)              { return __hip_atomic_load(p, __ATOMIC_RELAXED, __HIP_MEMORY_SCOPE_AGENT); }
__device__ __forceinline__ unsigned xb_add(unsigned* p, unsigned v) { return __hip_atomic_fetch_add(p, v, __ATOMIC_RELAXED, __HIP_MEMORY_SCOPE_AGENT); }
__device__ __forceinline__ unsigned xb_xcc_id() { return (unsigned)__builtin_amdgcn_s_getreg((3 << 11) | 20) & 0xFu; }
#define XB_SPIN(cond, bar) do { unsigned _sp = 0; while (cond) { __builtin_amdgcn_s_sleep(1); \
    if ((++_sp & 255u) == 0u) { if (xb_ld(&(bar)[XB_TMO])) break; if (_sp > XB_SPIN_CAP) { atomicAdd(&(bar)[XB_TMO], 1u); break; } } } } while (0)

struct XcdBarrier { unsigned* bar; unsigned x; volatile LAS unsigned* st; };

__device__ __forceinline__ XcdBarrier xcd_barrier_post(unsigned* bar, volatile LAS unsigned* st) {
    XcdBarrier b; b.bar = bar; b.x = xb_xcc_id(); b.st = st;
    if (threadIdx.x == 0) (void)xb_add(&bar[XB_XCNT(b.x)], 1u);
    return b;
}
__device__ __forceinline__ void xcd_barrier_complete(unsigned* bar, unsigned x, unsigned& nloc, unsigned& nx) {
    const unsigned G = gridDim.x * gridDim.y * gridDim.z;
    unsigned sum, cnt, mine, sp = 0u;
    for (;;) {
        sum = 0u; cnt = 0u; mine = 0u;
#pragma unroll
        for (unsigned j = 0; j < 16; ++j) { const unsigned c = xb_ld(&bar[XB_XCNT(j)]); sum += c; cnt += (c > 0u) ? 1u : 0u; mine = (j == x) ? c : mine; }
        if (sum == G) break;
        __builtin_amdgcn_s_sleep(1);
        if ((++sp & 255u) == 0u) { if (xb_ld(&bar[XB_TMO])) break; if (sp > XB_SPIN_CAP) { atomicAdd(&bar[XB_TMO], 1u); break; } }
    }
    nloc = mine > 0u ? mine : 1u; nx = cnt > 0u ? cnt : 1u;
}
__device__ __forceinline__ void xcd_barrier(const XcdBarrier& b) {
    asm volatile("s_waitcnt vmcnt(0)" ::: "memory");
    __syncthreads();
    if (threadIdx.x == 0) {
        unsigned* bar = b.bar;
        __builtin_amdgcn_s_waitcnt(0);
        unsigned nloc = b.st[0], nx = b.st[1];
        if (nloc == 0u) { xcd_barrier_complete(bar, b.x, nloc, nx); b.st[0] = nloc; b.st[1] = nx; }
        const unsigned old = xb_add(&bar[XB_XSUB(b.x)], 1u);
        const unsigned gen = old / nloc;
        if (old + 1u == (gen + 1u) * nloc) {
            __builtin_amdgcn_fence(__ATOMIC_RELEASE, "agent");
            asm volatile("s_waitcnt vmcnt(0)" ::: "memory");
            const unsigned og = xb_add(&bar[XB_TOP], 1u);
            const unsigned tg = og / nx;
            if (og + 1u == (tg + 1u) * nx) xb_add(&bar[XB_TOPGEN], 1u);
            else XB_SPIN(xb_ld(&bar[XB_TOPGEN]) == tg, bar);
            __builtin_amdgcn_fence(__ATOMIC_ACQUIRE, "agent");
            xb_add(&bar[XB_XGEN(b.x)], 1u);
            asm volatile("s_waitcnt vmcnt(0)" ::: "memory");
        } else {
            XB_SPIN(xb_ld(&bar[XB_XGEN(b.x)]) == gen, bar);
            __builtin_amdgcn_fence(__ATOMIC_ACQUIRE, "agent");
            asm volatile("s_waitcnt vmcnt(0)" ::: "memory");
        }
    }
    __syncthreads();
}

DI const float* resid_row(const float* H, const float* x, const float* meta, int m) {
    if (!x) return H + (size_t)m * D;
    const int b = m / L, t = m - b * L; return (t < NMETA) ? meta + (size_t)t * D : x + ((size_t)b * SEQ + (t - NMETA)) * D;
}
namespace pg8 {
constexpr int BM = 256, BK = 64, HALF = 128, HTB = HALF * BK * 2, STAGE_BYTES = 8 * HTB, NXCD = 8, WGM = 8;
__host__ __device__ __forceinline__ int lds_byte(int r, int c) { const int st = (r >> 4) * 2 + (c >> 5), rr = r & 15, cc = c & 31, ob = rr * 64 + cc * 2; return st * 1024 + (ob ^ (((ob >> 9) & 1) << 5)); }
__host__ __device__ __forceinline__ void stage_rc(int b, int& R, int& Cc) { const int st = b / 1024, sb = b % 1024, swz = sb ^ (((sb >> 9) & 1) << 5); R = (st >> 1) * 16 + swz / 64; Cc = (st & 1) * 32 + (swz % 64) / 2; }
__host__ __device__ __forceinline__ int perm32(int rho) { const int n = rho >> 4, i = rho & 15; return 8 * (i >> 2) + 4 * n + (i & 3); }

struct Unit { const char* A; const char* B; int pm, pn; };
struct Dims { int lda, ldb, nt; };

struct RectOrder {
    const char* A; const char* B; int lda, ldb; int nM, nN, nwg, G, c;
    __device__ void init(const void* A_, const void* B_, int lda_, int ldb_, int nM_, int nN_, int G_, int c_) { A = (const char*)A_; B = (const char*)B_; lda = lda_; ldb = ldb_; nM = nM_; nN = nN_; nwg = nM * nN; G = G_; c = c_; }
    __device__ bool next(int i, Unit& u) const {
        const long Lx = (long)i * G + c; if (Lx >= nwg) return false;
        int wgid = (int)Lx; { const int q = nwg / NXCD, r = nwg % NXCD, xcd = wgid % NXCD, off = wgid / NXCD; wgid = (xcd < r ? xcd * (q + 1) : r * (q + 1) + (xcd - r) * q) + off; }
        const int nig = WGM * nN, gid = wgid / nig, fm = gid * WGM, gsz = (nM - fm) < WGM ? (nM - fm) : WGM;
        u.pm = fm + ((wgid % nig) % gsz); u.pn = (wgid % nig) / gsz;
        u.A = A + (size_t)u.pm * BM * lda * 2; u.B = B + (size_t)u.pn * BM * ldb * 2; return true;
    }
};
template <class Epi, class Sched, bool ALIGN_EPI = true, bool SP2 = true>
__device__ __forceinline__ void gemm_phase(LAS unsigned char* lds, const Dims g, const Sched& S, const Epi& E) {
    int tid = threadIdx.x; asm volatile("" : "+v"(tid));
    const int wid = __builtin_amdgcn_readfirstlane(tid >> 6), lane = tid & 63, wr = wid >> 2, wc = wid & 3, fr = lane & 15, fq = lane >> 4;
    const int nt = g.nt;
    unsigned voffA[2], voffB[2];
#pragma unroll
    for (int i = 0; i < 2; ++i) { int R, Cc; stage_rc(tid * 16 + i * 8192, R, Cc); const int Rb = Epi::PERM ? ((R & ~31) + perm32(R & 31)) : R;
        voffA[i] = (unsigned)(R * g.lda + Cc) * 2u; voffB[i] = (unsigned)(Rb * g.ldb + Cc) * 2u; }
    const size_t kstep = (size_t)(BK * 2);
    const size_t hstepA = (size_t)HALF * g.lda * 2, hstepB = (size_t)HALF * g.ldb * 2;
    const unsigned ldsw = (unsigned)wid * 1024u;
    const int aoff = lds_byte(wr * 64 + fr, fq * 8), boff = lds_byte(wc * 32 + fr, fq * 8);
#define PG8_SA(b, h) (((b) * 2 + (h)) * HTB)
#define PG8_SB(b, h) ((4 + (b) * 2 + (h)) * HTB)
#define PG8_STAGE(bufoff, gbase, voff) do { _Pragma("unroll") for (int _i = 0; _i < 2; ++_i) \
        __builtin_amdgcn_global_load_lds((const unsigned*)((const char*)(gbase) + (voff)[_i]), (LAS unsigned*)(lds + (bufoff) + ldsw + _i * 8192), 16, 0, 0); } while (0)
#define PG8_LDA(dst, b, h) do { _Pragma("unroll") for (int m = 0; m < 4; ++m) _Pragma("unroll") for (int k = 0; k < 2; ++k) dst[m][k] = *(const LAS bf16x8*)(lds + PG8_SA(b, h) + aoff + m * 2048 + k * 1024); } while (0)
#define PG8_LDB(dst, b, h) do { _Pragma("unroll") for (int n = 0; n < 2; ++n) _Pragma("unroll") for (int k = 0; k < 2; ++k) dst[n][k] = *(const LAS bf16x8*)(lds + PG8_SB(b, h) + boff + n * 2048 + k * 1024); } while (0)
#define PG8_MMA(ai, bj, At, Bt) do { __builtin_amdgcn_s_setprio(1); _Pragma("unroll") for (int m = 0; m < 4; ++m) _Pragma("unroll") for (int n = 0; n < 2; ++n) _Pragma("unroll") for (int k = 0; k < 2; ++k) \
        acc[ai][bj][m][n] = __builtin_amdgcn_mfma_f32_16x16x32_bf16(Bt[n][k], At[m][k], acc[ai][bj][m][n], 0, 0, 0); __builtin_amdgcn_s_setprio(0); } while (0)
#define PG8_WAIT_V(n) asm volatile("s_waitcnt vmcnt(" #n ")" ::: "memory")
#define PG8_WAIT_L(n) asm volatile("s_waitcnt lgkmcnt(" #n ")" ::: "memory")
#define PG8_BAR __builtin_amdgcn_s_barrier()
#define PG8_SCHED __builtin_amdgcn_sched_barrier(0)
    Unit cur, nxt; int ui = 0;
    if (!S.next(0, cur)) return;
    f32x4 acc[2][2][4][2];
#pragma unroll
    for (int a = 0; a < 2; ++a)
#pragma unroll
        for (int b = 0; b < 2; ++b)
#pragma unroll
            for (int m = 0; m < 4; ++m)
#pragma unroll
                for (int n = 0; n < 2; ++n) acc[a][b][m][n] = (f32x4){0.f, 0.f, 0.f, 0.f};
    bf16x8 At[4][2], B0[2][2], B1[2][2];
    const char* cA = cur.A; const char* cB = cur.B;
    if constexpr (SP2) {
        PG8_STAGE(PG8_SB(0, 0), cB, voffB); PG8_STAGE(PG8_SB(0, 1), cB + hstepB, voffB); PG8_STAGE(PG8_SA(0, 0), cA, voffA); PG8_STAGE(PG8_SA(0, 1), cA + hstepA, voffA);
        if (wr == 1) PG8_BAR;
        PG8_WAIT_V(2); PG8_BAR;
        PG8_STAGE(PG8_SB(1, 0), cB + kstep, voffB); PG8_STAGE(PG8_SA(1, 0), cA + kstep, voffA); PG8_STAGE(PG8_SB(1, 1), cB + hstepB + kstep, voffB);
        PG8_WAIT_V(6); PG8_BAR;
    } else {
        PG8_STAGE(PG8_SB(0, 0), cB, voffB); PG8_STAGE(PG8_SA(0, 0), cA, voffA); PG8_STAGE(PG8_SB(0, 1), cB + hstepB, voffB); PG8_STAGE(PG8_SA(0, 1), cA + hstepA, voffA);
        if (wr == 1) PG8_BAR;
        PG8_WAIT_V(4); PG8_BAR;
        PG8_STAGE(PG8_SB(1, 0), cB + kstep, voffB); PG8_STAGE(PG8_SA(1, 0), cA + kstep, voffA); PG8_STAGE(PG8_SB(1, 1), cB + hstepB + kstep, voffB);
        PG8_WAIT_V(6); PG8_BAR;
    }
    for (;;) {
        const bool has_next = S.next(ui + 1, nxt);
        const char* nA = has_next ? nxt.A : cA; const char* nB = has_next ? nxt.B : cB;
        for (int t = 0; t < nt; t += 2) {
            const bool last = (t == nt - 2);
            const char* a1 = cA + (size_t)(t + 1) * kstep;
            const char* a2 = last ? nA : cA + (size_t)(t + 2) * kstep; const char* b2 = last ? nB : cB + (size_t)(t + 2) * kstep;
            const char* a3 = a2 + kstep; const char* b3 = b2 + kstep;
            if constexpr (SP2) {
            PG8_LDB(B0, 0, 0); PG8_LDB(B1, 0, 1); PG8_SCHED; PG8_LDA(At, 0, 0); PG8_STAGE(PG8_SA(1, 1), a1 + hstepA, voffA);
            PG8_WAIT_V(8); PG8_WAIT_L(0); PG8_BAR; PG8_MMA(0, 0, At, B0); PG8_MMA(0, 1, At, B1); PG8_BAR; PG8_SCHED;
            PG8_LDA(At, 0, 1); PG8_STAGE(PG8_SB(0, 0), b2, voffB); PG8_STAGE(PG8_SB(0, 1), b2 + hstepB, voffB); PG8_STAGE(PG8_SA(0, 0), a2, voffA);
            PG8_WAIT_V(8); PG8_WAIT_L(0); PG8_BAR; PG8_MMA(1, 0, At, B0); PG8_MMA(1, 1, At, B1); PG8_BAR; PG8_SCHED;
            PG8_LDB(B0, 1, 0); PG8_LDB(B1, 1, 1); PG8_SCHED; PG8_LDA(At, 1, 0); PG8_STAGE(PG8_SA(0, 1), a2 + hstepA, voffA);
            PG8_WAIT_V(8); PG8_WAIT_L(0); PG8_BAR; PG8_MMA(0, 0, At, B0); PG8_MMA(0, 1, At, B1); PG8_BAR; PG8_SCHED;
            PG8_LDA(At, 1, 1); PG8_STAGE(PG8_SB(1, 0), b3, voffB); PG8_STAGE(PG8_SB(1, 1), b3 + hstepB, voffB); PG8_STAGE(PG8_SA(1, 0), a3, voffA);
            PG8_WAIT_V(8); PG8_WAIT_L(0); PG8_BAR; PG8_MMA(1, 0, At, B0); PG8_MMA(1, 1, At, B1); PG8_BAR; PG8_SCHED;
            } else {
            PG8_LDB(B0, 0, 0); PG8_SCHED; PG8_LDA(At, 0, 0); PG8_STAGE(PG8_SA(1, 1), a1 + hstepA, voffA);
            PG8_WAIT_L(8); PG8_BAR; PG8_WAIT_L(0); PG8_MMA(0, 0, At, B0); PG8_BAR; PG8_SCHED;
            PG8_LDB(B1, 0, 1); PG8_STAGE(PG8_SB(0, 0), b2, voffB);
            PG8_BAR; PG8_WAIT_L(0); PG8_MMA(0, 1, At, B1); PG8_BAR;
            PG8_LDA(At, 0, 1); PG8_STAGE(PG8_SA(0, 0), a2, voffA);
            PG8_BAR; PG8_WAIT_L(0); PG8_MMA(1, 0, At, B0); PG8_BAR; PG8_SCHED;
            PG8_STAGE(PG8_SB(0, 1), b2 + hstepB, voffB);
            PG8_WAIT_V(6); PG8_BAR; PG8_MMA(1, 1, At, B1); PG8_BAR;
            PG8_LDB(B0, 1, 0); PG8_SCHED; PG8_LDA(At, 1, 0); PG8_STAGE(PG8_SA(0, 1), a2 + hstepA, voffA);
            PG8_WAIT_L(8); PG8_BAR; PG8_WAIT_L(0); PG8_MMA(0, 0, At, B0); PG8_BAR; PG8_SCHED;
            PG8_LDB(B1, 1, 1); PG8_STAGE(PG8_SB(1, 0), b3, voffB);
            PG8_BAR; PG8_WAIT_L(0); PG8_MMA(0, 1, At, B1); PG8_BAR;
            PG8_LDA(At, 1, 1); PG8_STAGE(PG8_SA(1, 0), a3, voffA);
            PG8_BAR; PG8_WAIT_L(0); PG8_MMA(1, 0, At, B0); PG8_BAR; PG8_SCHED;
            PG8_STAGE(PG8_SB(1, 1), b3 + hstepB, voffB);
            PG8_WAIT_V(6); PG8_BAR; PG8_MMA(1, 1, At, B1); PG8_BAR;
            }
        }
        if constexpr (ALIGN_EPI) { if (wr == 0) PG8_BAR; }
        E(acc, cur, wr, wc, fr, fq);
        if (!has_next) break;
#pragma unroll
        for (int a = 0; a < 2; ++a)
#pragma unroll
            for (int b = 0; b < 2; ++b)
#pragma unroll
                for (int m = 0; m < 4; ++m)
#pragma unroll
                    for (int n = 0; n < 2; ++n) acc[a][b][m][n] = (f32x4){0.f, 0.f, 0.f, 0.f};
        cur = nxt; cA = nA; cB = nB; ++ui;
        if constexpr (ALIGN_EPI) { if (wr == 1) PG8_BAR; }
    }
    PG8_WAIT_V(0);
    if constexpr (!ALIGN_EPI) { if (wr == 0) PG8_BAR; }
    PG8_BAR;
#undef PG8_SA
#undef PG8_SB
#undef PG8_STAGE
#undef PG8_LDA
#undef PG8_LDB
#undef PG8_MMA
#undef PG8_WAIT_V
#undef PG8_WAIT_L
#undef PG8_BAR
#undef PG8_SCHED
}

struct EpiBf16 {
    static constexpr bool PERM = true;
    bf16* O; int ldc; const float* bias;
    DI void operator()(const f32x4 (&acc)[2][2][4][2], const Unit& u, int wr, int wc, int fr, int fq) const {
        const int row0 = u.pm * BM + wr * 64 + fr, col0 = u.pn * BM + wc * 32 + 8 * fq;
        f32x4 bv[2][2];
#pragma unroll
        for (int bj = 0; bj < 2; ++bj)
#pragma unroll
            for (int n = 0; n < 2; ++n) bv[bj][n] = bias ? *(const f32x4*)(bias + col0 + bj * HALF + 4 * n) : (f32x4){0.f, 0.f, 0.f, 0.f};
#pragma unroll
        for (int ai = 0; ai < 2; ++ai)
#pragma unroll
            for (int m = 0; m < 4; ++m) { bf16* rowp = O + (size_t)(row0 + ai * HALF + m * 16) * ldc + col0;
#pragma unroll
                for (int bj = 0; bj < 2; ++bj) { const f32x4 v0 = acc[ai][bj][m][0] + bv[bj][0], v1 = acc[ai][bj][m][1] + bv[bj][1];
                    u32x4 w; w.x = pk2(v0[0], v0[1]); w.y = pk2(v0[2], v0[3]); w.z = pk2(v1[0], v1[1]); w.w = pk2(v1[2], v1[3]);
                    *(u32x4*)(rowp + bj * HALF) = w; } }
    }
};
struct EpiGate {
    static constexpr bool PERM = true;
    bf16* O; const bf16* Zg; int goff; const bf16* add;
    DI void operator()(const f32x4 (&acc)[2][2][4][2], const Unit& u, int wr, int wc, int fr, int fq) const {
        const int row0 = u.pm * BM + wr * 64 + fr, col0 = u.pn * BM + wc * 32 + 8 * fq;
#pragma unroll
        for (int ai = 0; ai < 2; ++ai)
#pragma unroll
            for (int m = 0; m < 4; ++m) { const size_t row = (size_t)(row0 + ai * HALF + m * 16);
                u32x4 gzs[2], ts[2];
#pragma unroll
                for (int bj = 0; bj < 2; ++bj) { const int col = col0 + bj * HALF; gzs[bj] = *(const u32x4*)(Zg + row * NZ + goff + col); if (add) ts[bj] = *(const u32x4*)(add + row * D + col); else ts[bj] = (u32x4){0u, 0u, 0u, 0u}; }
#pragma unroll
                for (int bj = 0; bj < 2; ++bj) {
                    const int col = col0 + bj * HALF;
                    const u32x4 gz = gzs[bj];
                    float a[8] = {0.f, 0.f, 0.f, 0.f, 0.f, 0.f, 0.f, 0.f};
                    if (add) { const u32x4 t = ts[bj]; a[0] = bflo(t.x); a[1] = bfhi(t.x); a[2] = bflo(t.y); a[3] = bfhi(t.y); a[4] = bflo(t.z); a[5] = bfhi(t.z); a[6] = bflo(t.w); a[7] = bfhi(t.w); }
                    const f32x4 v0 = acc[ai][bj][m][0], v1 = acc[ai][bj][m][1];
                    float o[8];
                    o[0] = a[0] + sigmoidf_(bflo(gz.x)) * v0[0]; o[1] = a[1] + sigmoidf_(bfhi(gz.x)) * v0[1];
                    o[2] = a[2] + sigmoidf_(bflo(gz.y)) * v0[2]; o[3] = a[3] + sigmoidf_(bfhi(gz.y)) * v0[3];
                    o[4] = a[4] + sigmoidf_(bflo(gz.z)) * v1[0]; o[5] = a[5] + sigmoidf_(bfhi(gz.z)) * v1[1];
                    o[6] = a[6] + sigmoidf_(bflo(gz.w)) * v1[2]; o[7] = a[7] + sigmoidf_(bfhi(gz.w)) * v1[3];
                    u32x4 w; w.x = pk2(o[0], o[1]); w.y = pk2(o[2], o[3]); w.z = pk2(o[4], o[5]); w.w = pk2(o[6], o[7]);
                    *(u32x4*)(O + row * D + col) = w; } }
    }
};
struct EpiResAdd {
    static constexpr bool PERM = false;
    float* H; const float* x; const float* meta;
    DI void operator()(const f32x4 (&acc)[2][2][4][2], const Unit& u, int wr, int wc, int fr, int fq) const {
        const int row0 = u.pm * BM + wr * 64 + fr, col0 = u.pn * BM + wc * 32 + 4 * fq;
#pragma unroll
        for (int ai = 0; ai < 2; ++ai)
#pragma unroll
            for (int m = 0; m < 4; ++m) { const int row = row0 + ai * HALF + m * 16; float* rowp = H + (size_t)row * D + col0; const float* srcp = resid_row(H, x, meta, row) + col0; f32x4 rs[2][2];
#pragma unroll
                for (int bj = 0; bj < 2; ++bj)
#pragma unroll
                    for (int n = 0; n < 2; ++n) rs[bj][n] = *(const f32x4*)(srcp + bj * HALF + n * 16);
#pragma unroll
                for (int bj = 0; bj < 2; ++bj)
#pragma unroll
                    for (int n = 0; n < 2; ++n) *(f32x4*)(rowp + bj * HALF + n * 16) = rs[bj][n] + acc[ai][bj][m][n]; }
    }
};
}

struct SkZ    { bf16* Z; const float* bias; DI void operator()(int row, int col, f32x4 v) const { v = v + *(const f32x4*)(bias + col); *(u32x2*)(Z + (size_t)row * NZ + col) = (u32x2){pk2(v[0], v[1]), pk2(v[2], v[3])}; } };
struct SkGate { bf16* O; const bf16* Zg; int goff; const bf16* add;
    DI void operator()(int row, int col, f32x4 v) const { const u32x2 gz = *(const u32x2*)(Zg + (size_t)row * NZ + goff + col); float a0 = 0.f, a1 = 0.f, a2 = 0.f, a3 = 0.f;
        if (add) { const u32x2 t = *(const u32x2*)(add + (size_t)row * D + col); a0 = bflo(t.x); a1 = bfhi(t.x); a2 = bflo(t.y); a3 = bfhi(t.y); }
        *(u32x2*)(O + (size_t)row * D + col) = (u32x2){pk2(a0 + sigmoidf_(bflo(gz.x)) * v[0], a1 + sigmoidf_(bfhi(gz.x)) * v[1]), pk2(a2 + sigmoidf_(bflo(gz.y)) * v[2], a3 + sigmoidf_(bfhi(gz.y)) * v[3])}; } };
struct SkRes  { float* H; const float* x; const float* meta; DI void operator()(int row, int col, f32x4 v) const { *(f32x4*)(H + (size_t)row * D + col) = *(const f32x4*)(resid_row(H, x, meta, row) + col) + v; } };
template <class Epi>
DI void skinny64(const bf16* A, int lda, const bf16* Bt, int ldb, int N, int K, int r0, LAS unsigned char* lds, const Epi& epi, int wave, int lane, int bid, int G) {
    const int n16 = lane & 15, q = lane >> 4; const int ksw = (K / 32) / 8;
    LAS f32x4* red = (LAS f32x4*)lds;
    for (int uu = bid; uu < (N / 16) * 2; uu += G) { const int nt = uu >> 1, mh = uu & 1;
        f32x4 acc[2];
#pragma unroll
        for (int mt = 0; mt < 2; ++mt) acc[mt] = (f32x4){0.f, 0.f, 0.f, 0.f};
        const bf16* wp = Bt + (size_t)(16 * nt + n16) * ldb + 8 * q + wave * ksw * 32; const bf16* ap = A + (size_t)(r0 + 32 * mh + n16) * lda + 8 * q + wave * ksw * 32;
#pragma unroll 8
        for (int ks = 0; ks < ksw; ++ks) { const bf16x8 wf = *(const bf16x8*)(wp + ks * 32);
#pragma unroll
            for (int mt = 0; mt < 2; ++mt) acc[mt] = __builtin_amdgcn_mfma_f32_16x16x32_bf16(wf, *(const bf16x8*)(ap + (size_t)(16 * mt) * lda + ks * 32), acc[mt], 0, 0, 0); }
        __syncthreads();
#pragma unroll
        for (int mt = 0; mt < 2; ++mt) red[(wave * 2 + mt) * 64 + lane] = acc[mt];
        __syncthreads();
        if (wave < 2) { f32x4 s = red[wave * 64 + lane];
#pragma unroll
            for (int w = 1; w < 8; ++w) s = s + red[(w * 2 + wave) * 64 + lane];
            epi(r0 + 32 * mh + 16 * wave + n16, 16 * nt + 4 * q, s); }
    }
    __syncthreads();
}

struct ArgsV { const float* in[33]; float* out; unsigned char* ws; int ph_lo, ph_hi; };
#define CAS __attribute__((address_space(4)))
typedef const CAS ArgsV* ArgsP;
struct Args { ArgsP p; GAS unsigned char* ws; GAS float* out; DI const float* inp(int i) const { return (const float*)(const GAS float*)p->in[i]; } };
enum InIdx { I_X = 0, I_META, I_NORM_MIX, I_W_IN, I_B_QKV, I_SINKS, I_MU, I_W0, I_DEC_UP, I_A0, I_ICLR_UP, I_GATE_UP, I_KK, I_KA, I_RK, I_LNW, I_LNB,
             I_VDOWN, I_VMU, I_V0, I_VUP, I_WBA, I_WBR, I_WOUT, I_NORM_FFN, I_WCOARSE, I_BCOARSE, I_WFINE, I_BFINE, I_WEG, I_WEU, I_WED, I_NORM_FINAL };

DI void tr_item(const float* W, int ldw, int K, int N, bf16* WT, int ldt, int kb, int nb, LAS float* scr, int lane) {
    (void)scr;
    const int k0 = 64 * kb + 8 * (lane >> 3), n0 = 32 * nb + 4 * (lane & 7);
    f32x4 v[8];
#pragma unroll
    for (int r = 0; r < 8; ++r) v[r] = (n0 < N && k0 + r < K) ? *(const f32x4*)(W + (size_t)(k0 + r) * ldw + n0) : (f32x4){0.f, 0.f, 0.f, 0.f};
    if (k0 < K && n0 < N) {
#pragma unroll
        for (int i = 0; i < 4; ++i) {
            u32x4 o; o.x = pk2(v[0][i], v[1][i]); o.y = pk2(v[2][i], v[3][i]); o.z = pk2(v[4][i], v[5][i]); o.w = pk2(v[6][i], v[7][i]);
            *(u32x4*)(WT + (size_t)(n0 + i) * ldt + k0) = o; } }
}

struct TrDesc { const float* W; bf16* WT; int ldw, K, N, ldt, kb, nb; };
DI void tr_load(const TrDesc& d, f32x4 (&v)[8], int lane) {
    const int k0 = 64 * d.kb + 8 * (lane >> 3), n0 = 32 * d.nb + 4 * (lane & 7);
#pragma unroll
    for (int r = 0; r < 8; ++r) v[r] = (n0 < d.N && k0 + r < d.K) ? *(const f32x4*)(d.W + (size_t)(k0 + r) * d.ldw + n0) : (f32x4){0.f, 0.f, 0.f, 0.f};
}
DI void tr_store(const TrDesc& d, const f32x4 (&v)[8], int lane) {
    const int k0 = 64 * d.kb + 8 * (lane >> 3), n0 = 32 * d.nb + 4 * (lane & 7);
    if (k0 < d.K && n0 < d.N) {
#pragma unroll
        for (int i = 0; i < 4; ++i) {
            u32x4 o; o.x = pk2(v[0][i], v[1][i]); o.y = pk2(v[2][i], v[3][i]); o.z = pk2(v[4][i], v[5][i]); o.w = pk2(v[6][i], v[7][i]);
            *(u32x4*)(d.WT + (size_t)(n0 + i) * d.ldt + k0) = o; } }
}
template <int GRP>
DI TrDesc tr_decode(const Args& a, int l, int r) {
    unsigned char* ws = (unsigned char*)a.ws;
    constexpr int NB_IN = NIN / 32;
    constexpr int J1 = 32 * NB_IN, J3 = 16 * 64, J5 = 32 * 64, J9 = 32 * 2, J10 = 32, J11 = 32, J2 = 32;
    if (GRP == 1) {
        if (r < J3) return TrDesc{a.inp(I_WBA) + (size_t)l * C * D, (bf16*)(ws + WS_WAT) + (size_t)l * D * C, D, C, D, C, r / 64, r % 64}; r -= J3;
        if (r < J3) return TrDesc{a.inp(I_WBR) + (size_t)l * C * D, (bf16*)(ws + WS_WRT) + (size_t)l * D * C, D, C, D, C, r / 64, r % 64}; r -= J3;
        if (r < J5) return TrDesc{a.inp(I_WOUT) + (size_t)l * D * D, (bf16*)(ws + WS_WOT) + (size_t)l * D * D, D, D, D, D, r / 64, r % 64}; r -= J5;
        if (r < J9) return TrDesc{a.inp(I_WFINE) + (size_t)l * D * 64, (bf16*)(ws + WS_WRO) + (size_t)l * 80 * D + (size_t)8 * D, 64, D, 64, D, r / 2, r % 2}; r -= J9;
        return TrDesc{a.inp(I_WCOARSE) + (size_t)l * D * 8, (bf16*)(ws + WS_WRO) + (size_t)l * 80 * D, 8, D, 8, D, r, 0};
    }
    if (r < J1) return TrDesc{a.inp(I_W_IN) + (size_t)l * D * NIN, (bf16*)(ws + WS_W1T) + (size_t)l * NZ * D, NIN, D, NIN, D, r / NB_IN, r % NB_IN}; r -= J1;
    if (r < J11) return TrDesc{a.inp(I_DEC_UP) + (size_t)l * 64 * C, (bf16*)(ws + WS_LDEC) + (size_t)l * C * 64, C, 64, C, 64, 0, r}; r -= J11;
    if (r < J11) return TrDesc{a.inp(I_ICLR_UP) + (size_t)l * 64 * C, (bf16*)(ws + WS_LICL) + (size_t)l * C * 64, C, 64, C, 64, 0, r}; r -= J11;
    if (r < J11 || GRP != 2) return TrDesc{a.inp(I_GATE_UP) + (size_t)l * 64 * C, (bf16*)(ws + WS_LGAT) + (size_t)l * C * 64, C, 64, C, 64, 0, r}; r -= J11;
    if (r < J2) return TrDesc{a.inp(I_VDOWN), (bf16*)(ws + WS_W1T) + (size_t)NZ * D + (size_t)ZVD * D, 32, D, 32, D, r, 0}; r -= J2;
    return TrDesc{a.inp(I_VUP), (bf16*)(ws + WS_LVUP), C, 32, C, 32, 0, r};
}
template <int GRP>
DI void phase_convert(const Args& a, int l, LAS unsigned char* lds, int gw, int NGW, int wave, int lane) {
    unsigned char* ws = (unsigned char*)a.ws; (void)lds; (void)wave;
    constexpr int NB_IN = NIN / 32;
    constexpr int NITEMS = (GRP == 1) ? 2 * 16 * 64 + 32 * 64 + 32 * 2 + 32 : 32 * NB_IN + 3 * 32 + (GRP == 2 ? 32 + 32 : 0);
    for (int it = gw; it < NITEMS; it += 2 * NGW) {
        const bool two = it + NGW < NITEMS;
        const TrDesc d0 = tr_decode<GRP>(a, l, it), d1 = tr_decode<GRP>(a, l, two ? it + NGW : it);
        f32x4 v0[8], v1[8];
        tr_load(d0, v0, lane); tr_load(d1, v1, lane);
        tr_store(d0, v0, lane); if (two) tr_store(d1, v1, lane);
    }
    if (GRP != 2) return;
    const size_t gt = (size_t)gw * 64 + lane, NGT = (size_t)NGW * 64;
    { unsigned* U = (unsigned*)(ws + WS_U);
      for (size_t i = gt; i < (size_t)(TP - T) * (D / 2); i += NGT) U[(size_t)T * (D / 2) + i] = 0u; }
    { float* bias = (float*)(ws + WS_BIAS);
      for (size_t i = gt; i < (size_t)2 * NZ; i += NGT) { const int l = (int)(i / NZ), c = (int)(i % NZ); bias[i] = (c < 1536) ? a.inp(I_B_QKV)[l * 1536 + c] : 0.f; } }
    { float* rope = (float*)(ws + WS_ROPE);
      for (size_t i = gt; i < (size_t)L * 8; i += NGT) { const int t = (int)(i / 8), k = (int)(i % 8);
          const float invf = (float)exp2(-(double)k * 0.125 * 18.931568569324174  );
          const float ang = (float)t * invf;
          const double rev = (double)ang * 0.15915494309189535; const float fr = (float)(rev - floor(rev));
          rope[i * 2 + 0] = __builtin_amdgcn_cosf(fr); rope[i * 2 + 1] = __builtin_amdgcn_sinf(fr); } }
    { unsigned* wro = (unsigned*)(ws + WS_WRO);
      for (size_t i = gt; i < (size_t)2 * 8 * (D / 2); i += NGT) { const int l = (int)(i / (8 * (D / 2))), rr = (int)(i % (8 * (D / 2))); wro[(size_t)l * 80 * (D / 2) + (size_t)72 * (D / 2) + rr] = 0u; } }
}

DI void moe_tables(const unsigned* cnt, LAS int* lc, int tid) {
    __syncthreads();
    if (tid < 64) {
        const int c = (int)__hip_atomic_load(cnt + tid * 16, RLX_AGENT); const int pad = (c + 15) & ~15; int inc = pad;
#pragma unroll
        for (int o = 1; o < 64; o <<= 1) { const int v = __shfl_up(inc, o); if (tid >= o) inc += v; }
        lc[LC_PSTART / 4 + tid] = inc - pad; lc[LC_CNT / 4 + tid] = c; }
    __syncthreads();
}
template <int MODE>
DI void phase_norm(const Args& a, const float* gain, bool comb, int lprev, LAS unsigned char* lds, int tid, int gw, int NGW, int lane, const float* x0 = nullptr, const float* meta0 = nullptr) {
    unsigned char* ws = (unsigned char*)a.ws; float* H = (float*)(ws + WS_H); bf16* U = (bf16*)(ws + WS_U);
    const bf16* YR = (const bf16*)(ws + WS_YR); const int* toke = (const int*)(ws + WS_TOKE); const int* toks = (const int*)(ws + WS_TOKS); const float* tokw = (const float*)(ws + WS_TOKW);
    LAS int* lc = (LAS int*)(lds + LDSCTL_OFF);
    (void)lprev;
    f32x4 g[8];
#pragma unroll
    for (int j = 0; j < 8; ++j) g[j] = *(const f32x4*)(gain + lane * 4 + 256 * j);
    constexpr int NSHN = 32;
    const int npairs = (T > 2 * NGW) ? (T - 2 * NGW + 1) / 2 : 0, ppn = (npairs + NSHN - 1) / NSHN, shn = gw % NSHN, plon = shn * ppn, phin = (plon + ppn < npairs) ? plon + ppn : npairs;
    unsigned* nqh = (unsigned*)(ws + WS_CTL) + CW_NQ + ((MODE * 2 + (comb ? 1 : 0)) * NSHN + shn) * 16;
#define NM_PULL() ((lane == 0) ? __hip_atomic_fetch_add(nqh, 1u, __ATOMIC_RELAXED, __HIP_MEMORY_SCOPE_AGENT) : 0u)
    unsigned pvn = NM_PULL();
    for (int it = 0; ; ++it) { int m0, m1; bool two;
        if (it == 0) { if (gw >= T) continue; m0 = gw; two = gw + NGW < T; m1 = two ? gw + NGW : gw; }
        else { const int p = plon + __builtin_amdgcn_readfirstlane((int)pvn); if (p >= phin) break; pvn = NM_PULL(); m0 = 2 * NGW + 2 * p; two = m0 + 1 < T; m1 = two ? m0 + 1 : m0; }
        const int mm[2] = {m0, m1};
        f32x4 v[2][8];
#pragma unroll
        for (int rr = 0; rr < 2; ++rr)
#pragma unroll
            for (int j = 0; j < 8; ++j) v[rr][j] = *(const f32x4*)(resid_row(H, x0, meta0, mm[rr]) + lane * 4 + 256 * j);
        if (comb) {
            int p[2][2]; float w[2][2];
#pragma unroll
            for (int rr = 0; rr < 2; ++rr)
#pragma unroll
                for (int k = 0; k < 2; ++k) { p[rr][k] = lc[LC_PSTART / 4 + toke[2 * mm[rr] + k]] + toks[2 * mm[rr] + k]; w[rr][k] = tokw[2 * mm[rr] + k]; }
            u32x2 y[2][2][8];
#pragma unroll
            for (int rr = 0; rr < 2; ++rr)
#pragma unroll
                for (int k = 0; k < 2; ++k)
#pragma unroll
                    for (int j = 0; j < 8; ++j) y[rr][k][j] = *(const u32x2*)(YR + (size_t)p[rr][k] * D + lane * 4 + 256 * j);
#pragma unroll
            for (int rr = 0; rr < 2; ++rr)
#pragma unroll
                for (int j = 0; j < 8; ++j) { const u32x2 a0 = y[rr][0][j], a1 = y[rr][1][j]; const float w0 = w[rr][0], w1 = w[rr][1];
                    v[rr][j][0] += w0 * bflo(a0.x) + w1 * bflo(a1.x); v[rr][j][1] += w0 * bfhi(a0.x) + w1 * bfhi(a1.x);
                    v[rr][j][2] += w0 * bflo(a0.y) + w1 * bflo(a1.y); v[rr][j][3] += w0 * bfhi(a0.y) + w1 * bfhi(a1.y);
                    if (MODE == 0 && (rr == 0 || two)) *(f32x4*)(H + (size_t)mm[rr] * D + lane * 4 + 256 * j) = v[rr][j]; }
        }
#pragma unroll
        for (int rr = 0; rr < 2; ++rr) {
            if (rr == 1 && !two) break;
            float ss = 0.f;
#pragma unroll
            for (int j = 0; j < 8; ++j) ss += (v[rr][j][0] * v[rr][j][0] + v[rr][j][1] * v[rr][j][1]) + (v[rr][j][2] * v[rr][j][2] + v[rr][j][3] * v[rr][j][3]);
            float rstd = rsqrtf(wave_sum(ss) * (1.f / D) + NORM_EPS);
#if defined(CHUNK_TEST)
            if (MODE == 1 && ((const unsigned*)(ws + WS_CTL))[40000] != 0u) rstd = __builtin_nanf("");
#endif
            if (MODE == 0) {
                bf16* ur = U + (size_t)mm[rr] * D + lane * 4;
#pragma unroll
                for (int j = 0; j < 8; ++j) { const f32x4 o = v[rr][j] * rstd * g[j]; u32x2 wv; wv.x = pk2(o[0], o[1]); wv.y = pk2(o[2], o[3]); *(u32x2*)(ur + 256 * j) = wv; }
            } else {
                const int b = mm[rr] / L, t = mm[rr] % L;
                if (t >= NMETA) { float* orow = (float*)a.out + ((size_t)b * SEQ + (t - NMETA)) * D + lane * 4;
#pragma unroll
                    for (int j = 0; j < 8; ++j) *(f32x4*)(orow + 256 * j) = v[rr][j] * rstd * g[j]; }
            }
        }
    }
}

#undef NM_PULL
DI void phase_rope(const Args& a, int gw, int NGW, int lane) {
    unsigned char* ws = (unsigned char*)a.ws; bf16* Z = (bf16*)(ws + WS_Z); const float* rope = (const float*)(ws + WS_ROPE);
    const int r = lane / 20, hs = lane % 20; const int cb = (hs < 16) ? ZQ + hs * 64 : ZK + (hs - 16) * 64;
    for (int m0 = 3 * gw; m0 < T; m0 += 3 * NGW) { const int m = m0 + r;
        if (lane < 60 && m < T) { const int t = m % L; bf16* zp = Z + (size_t)m * NZ + cb;
            const u32x4 a1 = *(const u32x4*)zp, a2 = *(const u32x4*)(zp + 8);
            const f32x4* rt = (const f32x4*)(rope + (size_t)t * 16);
            unsigned o1[4], o2[4];
#pragma unroll
            for (int w = 0; w < 4; ++w) { const f32x4 cs = rt[w];
                const unsigned w1 = (w == 0) ? a1.x : (w == 1) ? a1.y : (w == 2) ? a1.z : a1.w, w2 = (w == 0) ? a2.x : (w == 1) ? a2.y : (w == 2) ? a2.z : a2.w;
                const float x1a = bflo(w1), x1b = bfhi(w1), x2a = bflo(w2), x2b = bfhi(w2);
                o1[w] = pk2(x1a * cs[0] - x2a * cs[1], x1b * cs[2] - x2b * cs[3]); o2[w] = pk2(x2a * cs[0] + x1a * cs[1], x2b * cs[2] + x1b * cs[3]); }
            *(u32x4*)zp = (u32x4){o1[0], o1[1], o1[2], o1[3]}; *(u32x4*)(zp + 8) = (u32x4){o2[0], o2[1], o2[2], o2[3]}; } }
}
DI void phase_vt(const Args& a, int gw, int NGW, int lane) {
    unsigned char* ws = (unsigned char*)a.ws; const bf16* Z = (const bf16*)(ws + WS_Z); bf16* VT = (bf16*)(ws + WS_VT);
    const int tgl = lane >> 3, cgl = lane & 7; constexpr int NTG = (LPAD + 63) / 64;
    for (int u = gw; u < NB * NTG * 4; u += NGW) { const int kvh = u & 3, tg8 = (u >> 2) % NTG, b = (u >> 2) / NTG; const int t0 = 64 * tg8 + 8 * tgl;
        u32x4 x[8];
#pragma unroll
        for (int j = 0; j < 8; ++j) { const int t = t0 + j; x[j] = (t < L) ? *(const u32x4*)(Z + (size_t)(b * L + t) * NZ + ZV + kvh * 64 + 8 * cgl) : (u32x4){0u, 0u, 0u, 0u}; }
        if (t0 < LPAD) {
#pragma unroll
            for (int ch = 0; ch < 8; ++ch) { unsigned o[4];
#pragma unroll
                for (int w = 0; w < 4; ++w) { const unsigned lo = (ch >> 1) == 0 ? x[2 * w].x : (ch >> 1) == 1 ? x[2 * w].y : (ch >> 1) == 2 ? x[2 * w].z : x[2 * w].w;
                    const unsigned hi = (ch >> 1) == 0 ? x[2 * w + 1].x : (ch >> 1) == 1 ? x[2 * w + 1].y : (ch >> 1) == 2 ? x[2 * w + 1].z : x[2 * w + 1].w;
                    o[w] = (ch & 1) ? ((lo >> 16) | (hi & 0xffff0000u)) : ((lo & 0xffffu) | (hi << 16)); }
                *(u32x4*)(VT + ((size_t)(b * 4 + kvh) * HD + 8 * cgl + ch) * LPAD + t0) = (u32x4){o[0], o[1], o[2], o[3]}; } }
    }
}
template <int MODE> DI bf16x8 lora_in8(const u32x4 c, const u32x4 p, const f32x4 m0, const f32x4 m1) {
    float o[8];
#pragma unroll
    for (int j = 0; j < 8; ++j) { const unsigned cw = (j < 2) ? c.x : (j < 4) ? c.y : (j < 6) ? c.z : c.w, pw = (j < 2) ? p.x : (j < 4) ? p.y : (j < 6) ? p.z : p.w;
        const float cv = (j & 1) ? bfhi(cw) : bflo(cw), pv = (j & 1) ? bfhi(pw) : bflo(pw); const float mm = (j < 4) ? m0[j & 3] : m1[j & 3];
        const float zs = cv + (pv - cv) * mm;
        if (MODE == 0) { const float e = __expf(2.f * zs); o[j] = 1.f - 2.f / (e + 1.f); } else if (MODE == 1) o[j] = zs; else o[j] = sigmoidf_(zs); }
    u32x4 w; w.x = pk2(o[0], o[1]); w.y = pk2(o[2], o[3]); w.z = pk2(o[4], o[5]); w.w = pk2(o[6], o[7]);
    return __builtin_bit_cast(bf16x8, w);
}
DI void phase_rwkvprep(const Args& a, int l, LAS unsigned char* lds, int tid, int gw, int NGW, int lane) {
    unsigned char* ws = (unsigned char*)a.ws; const bf16* Z = (const bf16*)(ws + WS_Z);
    const float* mu = a.inp(I_MU) + (size_t)l * 3264; const float* vmu = a.inp(I_VMU);
    const bf16* WdT = (const bf16*)(ws + WS_LDEC) + (size_t)l * C * 64; const bf16* WiT = (const bf16*)(ws + WS_LICL) + (size_t)l * C * 64; const bf16* WgT = (const bf16*)(ws + WS_LGAT) + (size_t)l * C * 64;
    const bf16* WvT = (const bf16*)(ws + WS_LVUP);
    bf16* Rr = (bf16*)(ws + WS_R); float* Ww = (float*)(ws + WS_W); bf16* Kk = (bf16*)(ws + WS_K); bf16* Vv = (bf16*)(ws + WS_V); bf16* KKn = (bf16*)(ws + WS_KK); bf16* Bb = (bf16*)(ws + WS_B);
    bf16* VF = (bf16*)(ws + WS_VF); bf16* Gg = (bf16*)(ws + WS_G); float* RK = (float*)(ws + WS_RK);
    LAS float* par = (LAS float*)lds;
    __syncthreads();
    { const float* pw0 = a.inp(I_W0) + (size_t)l * C; const float* pa0 = a.inp(I_A0) + (size_t)l * C; const float* pkk = a.inp(I_KK) + (size_t)l * C; const float* pka = a.inp(I_KA) + (size_t)l * C;
      const float* prk = a.inp(I_RK) + (size_t)l * C; const float* pv0 = a.inp(I_V0);
      float pvals[C / NTHR][9];
#pragma unroll
      for (int j = 0; j < C / NTHR; ++j) { const int ch = tid + j * NTHR;
          pvals[j][0] = mu[ch]; pvals[j][1] = mu[C + ch]; pvals[j][2] = mu[2 * C + ch]; pvals[j][3] = pw0[ch]; pvals[j][4] = pa0[ch]; pvals[j][5] = pkk[ch]; pvals[j][6] = pka[ch]; pvals[j][7] = prk[ch];
          pvals[j][8] = (l > 0) ? pv0[ch] : 0.f; }
#pragma unroll
      for (int j = 0; j < C / NTHR; ++j)
#pragma unroll
          for (int w = 0; w < 9; ++w) par[w * C + tid + j * NTHR] = pvals[j][w]; }
    for (int i = tid; i < 224; i += NTHR) par[9 * C + i] = (i < 192) ? mu[3072 + i] : vmu[i - 192];
    __syncthreads();
    const LAS float* pmu = par + 9 * C;
    const int tk = lane & 15, q = lane >> 4;
    constexpr int NU = (T / 16) * NH;
    const int nmain = (NU / (4 * NGW)) * (4 * NGW);
    int ptile = -1; bf16x8 bw[2], ba[2], bg[2], bs = {0, 0, 0, 0, 0, 0, 0, 0};
#pragma unroll
    for (int ks = 0; ks < 2; ++ks) { bw[ks] = bs; ba[ks] = bs; bg[ks] = bs; }
    const int RND = nmain / (4 * NGW), npool = RND * NGW + (NU - nmain);
    constexpr int NSH = 32; const int pper = (npool + NSH - 1) / NSH, pshard = gw % NSH, plo = pshard * pper, phi = (plo + pper < npool) ? plo + pper : npool;
    unsigned* pqh = (unsigned*)(ws + WS_CTL) + CW_PQ + (l * NSH + pshard) * 16;
#define RP_PULL() ((lane == 0) ? __hip_atomic_fetch_add(pqh, 1u, __ATOMIC_RELAXED, __HIP_MEMORY_SCOPE_AGENT) : 0u)
    unsigned pv = 0u; if (RND == 0) pv = RP_PULL();
    for (int it = 0; ; ++it) {
        int u;
        if (it < 3 * RND) { u = ((it / 3) * NGW + gw) * 4 + (it % 3); if (it + 1 == 3 * RND) pv = RP_PULL(); }
        else { const int p = plo + __builtin_amdgcn_readfirstlane((int)pv); if (p >= phi) break; pv = RP_PULL(); u = (p < RND * NGW) ? p * 4 + 3 : nmain + (p - RND * NGW); }
        const int hd = u & 15, tile = u >> 4; const int b = tile / (L / 16), t0 = (tile % (L / 16)) * 16; const int row = b * L + t0 + tk, t = t0 + tk;
        const bf16* zrow = Z + (size_t)row * NZ; const bf16* prow = zrow - NZ; const bool hp = t > 0;
        const bf16* zc = zrow + ZR0; const bf16* zp = prow + ZR0;
        struct CtIn { bf16x8 wd[2], wi[2], wg[2], wv; u32x2 zr, zk, zv, pr, pk, pv, vf; };
#define RP_LOAD(dst, ct) do { const int chA_ = hd * 64 + (ct) * 16 + (lane & 15), c0_ = hd * 64 + (ct) * 16 + 4 * q; \
            _Pragma("unroll") for (int ks = 0; ks < 2; ++ks) { dst.wd[ks] = *(const bf16x8*)(WdT + (size_t)chA_ * 64 + ks * 32 + 8 * q); dst.wi[ks] = *(const bf16x8*)(WiT + (size_t)chA_ * 64 + ks * 32 + 8 * q); dst.wg[ks] = *(const bf16x8*)(WgT + (size_t)chA_ * 64 + ks * 32 + 8 * q); } \
            dst.wv = (l > 0) ? *(const bf16x8*)(WvT + (size_t)chA_ * 32 + 8 * q) : (bf16x8){0, 0, 0, 0, 0, 0, 0, 0}; \
            dst.zr = *(const u32x2*)(zc + c0_); dst.zk = *(const u32x2*)(zc + 1024 + c0_); dst.zv = *(const u32x2*)(zc + 2048 + c0_); \
            dst.pr = (u32x2){0u, 0u}; dst.pk = dst.pr; dst.pv = dst.pr; if (hp) { dst.pr = *(const u32x2*)(zp + c0_); dst.pk = *(const u32x2*)(zp + 1024 + c0_); dst.pv = *(const u32x2*)(zp + 2048 + c0_); } \
            dst.vf = (l > 0) ? *(const u32x2*)(VF + (size_t)row * C + c0_) : (u32x2){0u, 0u}; } while (0)
        CtIn in[2];
        RP_LOAD(in[0], 0);
        if (tile != ptile) { ptile = tile;
            const u32x4 z4 = {0u, 0u, 0u, 0u}; u32x4 cw[2], ca[2], cg[2], pw[2], pa[2], pg[2], cs = z4, ps = z4;
#pragma unroll
            for (int ks = 0; ks < 2; ++ks) { const int ko = ks * 32 + 8 * q;
                cw[ks] = *(const u32x4*)(zrow + ZR0 + 3072 + ko); ca[ks] = *(const u32x4*)(zrow + ZR0 + 3136 + ko); cg[ks] = *(const u32x4*)(zrow + ZR0 + 3200 + ko);
                pw[ks] = hp ? *(const u32x4*)(prow + ZR0 + 3072 + ko) : z4; pa[ks] = hp ? *(const u32x4*)(prow + ZR0 + 3136 + ko) : z4; pg[ks] = hp ? *(const u32x4*)(prow + ZR0 + 3200 + ko) : z4; }
            if (l > 0) { cs = *(const u32x4*)(zrow + ZVD + 8 * q); ps = hp ? *(const u32x4*)(prow + ZVD + 8 * q) : z4; }
            __builtin_amdgcn_sched_barrier(0);
#pragma unroll
            for (int ks = 0; ks < 2; ++ks) { const int ko = ks * 32 + 8 * q;
                bw[ks] = lora_in8<0>(cw[ks], pw[ks], *(const LAS f32x4*)(pmu + ko), *(const LAS f32x4*)(pmu + ko + 4));
                ba[ks] = lora_in8<1>(ca[ks], pa[ks], *(const LAS f32x4*)(pmu + 64 + ko), *(const LAS f32x4*)(pmu + 64 + ko + 4));
                bg[ks] = lora_in8<2>(cg[ks], pg[ks], *(const LAS f32x4*)(pmu + 128 + ko), *(const LAS f32x4*)(pmu + 128 + ko + 4)); }
            if (l > 0) bs = lora_in8<1>(cs, ps, *(const LAS f32x4*)(pmu + 192 + 8 * q), *(const LAS f32x4*)(pmu + 192 + 8 * q + 4)); }
        float kkv[4][4], av[4][4]; float ss = 0.f, rks = 0.f;
#pragma unroll
        for (int ct = 0; ct < 4; ++ct) { const int ch0 = hd * 64 + ct * 16;
            if (ct + 1 < 4) RP_LOAD(in[(ct + 1) & 1], ct + 1);
            __builtin_amdgcn_sched_barrier(0);
            const CtIn& I = in[ct & 1];
            f32x4 aw = {0.f, 0.f, 0.f, 0.f}, aa = aw, ag = aw, avr = aw;
#pragma unroll
            for (int ks = 0; ks < 2; ++ks) {
                aw = __builtin_amdgcn_mfma_f32_16x16x32_bf16(I.wd[ks], bw[ks], aw, 0, 0, 0);
                aa = __builtin_amdgcn_mfma_f32_16x16x32_bf16(I.wi[ks], ba[ks], aa, 0, 0, 0);
                ag = __builtin_amdgcn_mfma_f32_16x16x32_bf16(I.wg[ks], bg[ks], ag, 0, 0, 0); }
            if (l > 0) avr = __builtin_amdgcn_mfma_f32_16x16x32_bf16(I.wv, bs, avr, 0, 0, 0);
            const int c0 = ch0 + 4 * q;
            const u32x2 zr_ = I.zr, zk_ = I.zk, zv_ = I.zv, pr_ = I.pr, pk_ = I.pk, pv_ = I.pv, vfw = I.vf;
            const f32x4 mr = *(const LAS f32x4*)(par + c0), mk = *(const LAS f32x4*)(par + C + c0), mv = *(const LAS f32x4*)(par + 2 * C + c0);
            const f32x4 w0v = *(const LAS f32x4*)(par + 3 * C + c0), a0v = *(const LAS f32x4*)(par + 4 * C + c0), kkw = *(const LAS f32x4*)(par + 5 * C + c0), kaw = *(const LAS f32x4*)(par + 6 * C + c0), rkw = *(const LAS f32x4*)(par + 7 * C + c0);
            const f32x4 v0v = *(const LAS f32x4*)(par + 8 * C + c0);
            f32x4 ro, wo, ko, vo, go;
#pragma unroll
            for (int j = 0; j < 4; ++j) {
                const float rc = (j & 1) ? bfhi(j < 2 ? zr_.x : zr_.y) : bflo(j < 2 ? zr_.x : zr_.y), rp = (j & 1) ? bfhi(j < 2 ? pr_.x : pr_.y) : bflo(j < 2 ? pr_.x : pr_.y);
                const float kc = (j & 1) ? bfhi(j < 2 ? zk_.x : zk_.y) : bflo(j < 2 ? zk_.x : zk_.y), kp = (j & 1) ? bfhi(j < 2 ? pk_.x : pk_.y) : bflo(j < 2 ? pk_.x : pk_.y);
                const float vc = (j & 1) ? bfhi(j < 2 ? zv_.x : zv_.y) : bflo(j < 2 ? zv_.x : zv_.y), vp = (j & 1) ? bfhi(j < 2 ? pv_.x : pv_.y) : bflo(j < 2 ? pv_.x : pv_.y);
                const float vfj = (j & 1) ? bfhi(j < 2 ? vfw.x : vfw.y) : bflo(j < 2 ? vfw.x : vfw.y);
                const float r = rc + (rp - rc) * mr[j]; float k = kc + (kp - kc) * mk[j]; float v = vc + (vp - vc) * mv[j];
                const float xw = -(w0v[j] + aw[j]);
                const float sp = fmaxf(xw, 0.f) + __logf(1.f + __expf(-fabsf(xw)));
                const float wlog = -sp - 0.5f; const float dec = __expf(-__expf(wlog));
                const float aval = sigmoidf_(a0v[j] + aa[j]);
                if (l > 0) v = v + (vfj - v) * sigmoidf_(v0v[j] + avr[j]);
                const float kk = k * kkw[j]; ss += kk * kk;
                k = k * (1.f + (aval - 1.f) * kaw[j]);
                rks += r * k * rkw[j];
                kkv[ct][j] = kk; av[ct][j] = aval;
                ro[j] = r; wo[j] = dec; ko[j] = k; vo[j] = v; go[j] = ag[j]; }
            const size_t o = (size_t)row * C + c0;
            *(u32x2*)(Rr + o) = (u32x2){pk2(ro[0], ro[1]), pk2(ro[2], ro[3])}; *(f32x4*)(Ww + o) = wo; *(u32x2*)(Kk + o) = (u32x2){pk2(ko[0], ko[1]), pk2(ko[2], ko[3])};
            const u32x2 vpk = {pk2(vo[0], vo[1]), pk2(vo[2], vo[3])}; *(u32x2*)(Vv + o) = vpk; *(u32x2*)(Gg + o) = (u32x2){pk2(go[0], go[1]), pk2(go[2], go[3])};
            if (l == 0) *(u32x2*)(VF + o) = vpk; }
#undef RP_LOAD
        ss += __shfl_xor(ss, 16); ss += __shfl_xor(ss, 32); rks += __shfl_xor(rks, 16); rks += __shfl_xor(rks, 32);
        const float inv = 1.f / fmaxf(sqrtf(ss), 1e-12f);
#pragma unroll
        for (int ct = 0; ct < 4; ++ct) { const size_t o = (size_t)row * C + hd * 64 + ct * 16 + 4 * q;
            float kn[4], bo[4];
#pragma unroll
            for (int j = 0; j < 4; ++j) { kn[j] = kkv[ct][j] * inv; bo[j] = kn[j] * av[ct][j]; }
            *(u32x2*)(KKn + o) = (u32x2){pk2(kn[0], kn[1]), pk2(kn[2], kn[3])}; *(u32x2*)(Bb + o) = (u32x2){pk2(bo[0], bo[1]), pk2(bo[2], bo[3])}; }
        if (q == 0) RK[(size_t)row * NH + hd] = rks;
    }
}

#undef RP_PULL
DI void phase_attn(const Args& a, int l, int gw, int NGW, int lane) {
    unsigned char* ws = (unsigned char*)a.ws; const bf16* Z = (const bf16*)(ws + WS_Z); const bf16* VT = (const bf16*)(ws + WS_VT); bf16* O = (bf16*)(ws + WS_OATT);
    const float* sinks = a.inp(I_SINKS) + l * NH;
    constexpr int NMAIN = NB * NH * (SEQ / 32), NUNITS = NMAIN + NB * NH;
    const int c = lane & 31, h = lane >> 5;
    const int kperm = (c & ~12) | ((c & 8) >> 1) | ((c & 4) << 1);
    constexpr float SCL = 0.125f * 1.44269504088896f;
    constexpr int NSHARD = 32, PER = (NUNITS + NSHARD - 1) / NSHARD;
    const int shard = gw % NSHARD, ulo = shard * PER, uhi = (ulo + PER < NUNITS) ? ulo + PER : NUNITS;
    unsigned* qh = (unsigned*)(ws + WS_CTL) + CW_AQ + (l * NSHARD + shard) * 16;
#define AT_PULL() ((lane == 0) ? __hip_atomic_fetch_add(qh, 1u, __ATOMIC_RELAXED, __HIP_MEMORY_SCOPE_AGENT) : 0u)
    unsigned pv = AT_PULL();
    for (;;) {
        const int u = ulo + __builtin_amdgcn_readfirstlane((int)pv);
        if (u >= uhi) break;
        pv = AT_PULL();
        const bool metaq = u >= NMAIN; const int uu = metaq ? u - NMAIN : u;
        const int hq4 = uu & 3, rest = uu >> 2; const int qb = metaq ? -8 : (rest & 63), bk = metaq ? rest : (rest >> 6); const int kvh = bk & 3, b = bk >> 2; const int hq = kvh * 4 + hq4;
        const int qpos = metaq ? c : NMETA + 32 * qb + c;
        const bf16* zb = Z + (size_t)(b * L) * NZ; const bf16* vb = VT + ((size_t)(b * 4 + kvh) * HD + c) * LPAD + 8 * h;
#define AT_KBASE(s) (((s) == 0) ? 0 : NMETA + 32 * (qb - 5 + (s)))
#define AT_VALID(s) (((s) == 0) || (qb - 5 + (s) >= 0))
#define AT_KLOAD(dst, s) do { if (AT_VALID(s)) { const bf16* kp_ = zb + (size_t)(AT_KBASE(s) + kperm) * NZ + ZK + kvh * 64 + 8 * h; _Pragma("unroll") for (int ks = 0; ks < 4; ++ks) dst[ks] = *(const bf16x8*)(kp_ + 16 * ks); } } while (0)
#define AT_VLOAD(dst, s) do { if (AT_VALID(s)) { const bf16* vp_ = vb + AT_KBASE(s); dst[0] = *(const bf16x8*)(vp_); dst[1] = *(const bf16x8*)(vp_ + 16); dst[2] = *(const bf16x8*)(vp_ + (size_t)32 * LPAD); dst[3] = *(const bf16x8*)(vp_ + (size_t)32 * LPAD + 16); } } while (0)
        bf16x8 qf[4], fr[2][4];
#pragma unroll
        for (int ks = 0; ks < 4; ++ks) qf[ks] = *(const bf16x8*)(zb + (size_t)qpos * NZ + ZQ + hq * 64 + 16 * ks + 8 * h);
        AT_KLOAD(fr[0], 0);
        f32x16 sc[6];
        float mx = sinks[hq] * 1.44269504088896f;
#pragma unroll
        for (int s = 0; s < 6; ++s) {
            const bool valid = AT_VALID(s); const int kbase = AT_KBASE(s);
            if (s + 1 < 6) AT_KLOAD(fr[(s + 1) & 1], s + 1);
            __builtin_amdgcn_sched_barrier(0);
#pragma unroll
            for (int i = 0; i < 16; ++i) sc[s][i] = 0.f;
            if (valid) {
#pragma unroll
                for (int ks = 0; ks < 4; ++ks) sc[s] = __builtin_amdgcn_mfma_f32_32x32x16_bf16(fr[s & 1][ks], qf[ks], sc[s], 0, 0, 0);
            }
#pragma unroll
            for (int i = 0; i < 16; ++i) { const int kpos = kbase + 16 * (i >> 3) + 8 * h + 4 * ((i >> 2) & 1) + (i & 3);
                const int dist = qpos - kpos;
                const bool vis = valid && ((s == 0) ? (kpos < NMETA && kpos <= qpos) : (s >= 2 && s <= 4) ? true : (dist >= 0 && dist < 128));
                sc[s][i] = vis ? sc[s][i] * SCL : -1e30f; mx = fmaxf(mx, sc[s][i]); }
        }
        AT_VLOAD(fr[0], 0);
        mx = fmaxf(mx, __shfl_xor(mx, 32));
        float sum = 0.f;
#pragma unroll
        for (int s = 0; s < 6; ++s)
#pragma unroll
            for (int i = 0; i < 16; ++i) { const float p = __builtin_amdgcn_exp2f(sc[s][i] - mx); sc[s][i] = p; sum += p; }
        sum += __shfl_xor(sum, 32);
        sum += __builtin_amdgcn_exp2f(sinks[hq] * 1.44269504088896f - mx);
        f32x16 o0, o1;
#pragma unroll
        for (int i = 0; i < 16; ++i) { o0[i] = 0.f; o1[i] = 0.f; }
#pragma unroll
        for (int s = 0; s < 6; ++s) {
            const bool valid = AT_VALID(s);
            if (s + 1 < 6) AT_VLOAD(fr[(s + 1) & 1], s + 1);
            __builtin_amdgcn_sched_barrier(0);
            if (valid) {
#pragma unroll
                for (int s2 = 0; s2 < 2; ++s2) {
                    u32x4 pw; pw.x = pk2(sc[s][8 * s2 + 0], sc[s][8 * s2 + 1]); pw.y = pk2(sc[s][8 * s2 + 2], sc[s][8 * s2 + 3]); pw.z = pk2(sc[s][8 * s2 + 4], sc[s][8 * s2 + 5]); pw.w = pk2(sc[s][8 * s2 + 6], sc[s][8 * s2 + 7]);
                    const bf16x8 pf = __builtin_bit_cast(bf16x8, pw);
                    o0 = __builtin_amdgcn_mfma_f32_32x32x16_bf16(fr[s & 1][s2], pf, o0, 0, 0, 0);
                    o1 = __builtin_amdgcn_mfma_f32_32x32x16_bf16(fr[s & 1][2 + s2], pf, o1, 0, 0, 0); }
            }
        }
#undef AT_KBASE
#undef AT_VALID
#undef AT_KLOAD
#undef AT_VLOAD
        if (!metaq || c < NMETA) { const float inv = 1.f / sum; bf16* orow = O + (size_t)(b * L + qpos) * C + hq * 64 + 4 * h;
#pragma unroll
            for (int g4 = 0; g4 < 4; ++g4) { u32x2 w0, w1;
                w0.x = pk2(o0[4 * g4] * inv, o0[4 * g4 + 1] * inv); w0.y = pk2(o0[4 * g4 + 2] * inv, o0[4 * g4 + 3] * inv);
                w1.x = pk2(o1[4 * g4] * inv, o1[4 * g4 + 1] * inv); w1.y = pk2(o1[4 * g4 + 2] * inv, o1[4 * g4 + 3] * inv);
                *(u32x2*)(orow + 8 * g4) = w0; *(u32x2*)(orow + 32 + 8 * g4) = w1; } }
    }
}

#undef AT_PULL
constexpr int CK = 64, NCK = (L + CK - 1) / CK  , NCHUNK = NB * NH * NCK  ;
constexpr size_t CH_P = WS_XR, CH_Q = CH_P + (size_t)NCHUNK * 4096 * 2, CH_RH = CH_Q + (size_t)NCHUNK * 4096 * 4, CH_YL = CH_RH + (size_t)NCHUNK * 4096 * 2, CH_ZS = CH_YL + (size_t)NCHUNK * 4096 * 4;
static_assert(CH_ZS + (size_t)NCHUNK * 4096 * 2 <= WS_HID, "chunk buffers fit the free XR region");
constexpr int CP = 72, CMS = 64 * CP * 2;
struct CkF { bf16x8 a[2], b[2][2]; };
DI void ck_ld(CkF& f, const LAS bf16* A, const LAS bf16* Bt, int wave, int lane) {
    const int mt = wave >> 1, nt0 = 2 * (wave & 1), r = lane & 15, q = lane >> 4;
#pragma unroll
    for (int ks = 0; ks < 2; ++ks) { f.a[ks] = *(const LAS bf16x8*)(A + (16 * mt + r) * CP + 32 * ks + 8 * q);
#pragma unroll
        for (int j = 0; j < 2; ++j) f.b[j][ks] = *(const LAS bf16x8*)(Bt + (16 * (nt0 + j) + r) * CP + 32 * ks + 8 * q); }
}
DI void ck_mma(f32x4 (&acc)[2], const CkF& f) {
#pragma unroll
    for (int ks = 0; ks < 2; ++ks)
#pragma unroll
        for (int j = 0; j < 2; ++j) acc[j] = __builtin_amdgcn_mfma_f32_16x16x32_bf16(f.a[ks], f.b[j][ks], acc[j], 0, 0, 0);
}
template <class F> DI void ck_epi(const f32x4 (&acc)[2], int wave, int lane, const F& epi) {
    const int mt = wave >> 1, nt0 = 2 * (wave & 1), r = lane & 15, q = lane >> 4;
#pragma unroll
    for (int j = 0; j < 2; ++j) epi(16 * mt + 4 * q, 16 * (nt0 + j) + r, acc[j]);
}
template <class F>
DI void ck_mm(const LAS bf16* A, const LAS bf16* Bt, const LAS bf16* A2, const LAS bf16* Bt2, int wave, int lane, const F& epi) {
    CkF f; ck_ld(f, A, Bt, wave, lane); f32x4 acc[2] = {{0.f, 0.f, 0.f, 0.f}, {0.f, 0.f, 0.f, 0.f}}; ck_mma(acc, f);
    if (A2) { CkF g; ck_ld(g, A2, Bt2, wave, lane); ck_mma(acc, g); }
    ck_epi(acc, wave, lane, epi);
}
#define CK_Z2 {{0.f, 0.f, 0.f, 0.f}, {0.f, 0.f, 0.f, 0.f}}
DI void ck_wr_row(LAS bf16* X, int m, int n, f32x4 v) {
#pragma unroll
    for (int g = 0; g < 4; ++g) X[(m + g) * CP + n] = (bf16)(pk2(v[g], 0.f) & 0xffffu);
}
DI void ck_wr_tr(LAS bf16* XT, int m, int n, f32x4 v) { *(LAS u32x2*)(XT + n * CP + m) = (u32x2){pk2(v[0], v[1]), pk2(v[2], v[3])}; }

DI void phase_chunkA(const Args& a, LAS unsigned char* lds, int wave, int lane, int tid, int bid, int G) {
    unsigned char* ws = (unsigned char*)a.ws;
    const float* Ww = (const float*)(ws + WS_W); const bf16* KKn = (const bf16*)(ws + WS_KK); const bf16* Bb = (const bf16*)(ws + WS_B);
    const bf16* Kk = (const bf16*)(ws + WS_K); const bf16* Rr = (const bf16*)(ws + WS_R); const bf16* Vv = (const bf16*)(ws + WS_V);
#define SL(i) ((LAS bf16*)(lds + (i) * CMS))
#define CK_BAR() do { asm volatile("s_waitcnt lgkmcnt(0)" ::: "memory"); __builtin_amdgcn_s_barrier(); asm volatile("" ::: "memory"); } while (0)
    LAS float* Gf = (LAS float*)(lds + 8 * CMS);
    LAS float* gC = (LAS float*)(lds + 14 * CMS);
    f32x4 nw0, nw1; u32x4 nr8, nk8, nv8, nkk8, nb8;
#define CK_LOADIN(cc, hh, bb) do { const int t_ = tid >> 3, c8_ = (tid & 7) * 8; const bool ok_ = CK * (cc) + t_ < L; const size_t ro_ = (size_t)((bb) * L + CK * (cc) + t_) * C + (hh) * 64 + c8_; \
        const f32x4 one_ = {1.f, 1.f, 1.f, 1.f}; const u32x4 z_ = {0u, 0u, 0u, 0u}; \
        nw0 = ok_ ? *(const f32x4*)(Ww + ro_) : one_; nw1 = ok_ ? *(const f32x4*)(Ww + ro_ + 4) : one_; \
        nr8 = ok_ ? *(const u32x4*)(Rr + ro_) : z_; nk8 = ok_ ? *(const u32x4*)(Kk + ro_) : z_; nv8 = ok_ ? *(const u32x4*)(Vv + ro_) : z_; nkk8 = ok_ ? *(const u32x4*)(KKn + ro_) : z_; nb8 = ok_ ? *(const u32x4*)(Bb + ro_) : z_; } while (0)
    if (bid < NCHUNK) { const int c0_ = bid % NCK, bh0_ = bid / NCK; CK_LOADIN(c0_, bh0_ & 15, bh0_ >> 4); }
    for (int cid = bid; cid < NCHUNK; cid += G) {
        const int c = cid % NCK, bh = cid / NCK, hd = bh & 15, b = bh >> 4; const int tok0 = CK * c; (void)tok0; (void)hd; (void)b;
        CK_BAR();
        const int t = tid >> 3, c8 = (tid & 7) * 8;
        float wv[8], gv[8], gp[8];
#pragma unroll
        for (int e = 0; e < 4; ++e) { wv[e] = nw0[e]; wv[4 + e] = nw1[e]; }
        const u32x4 r8 = nr8, k8 = nk8, v8 = nv8, kk8 = nkk8, b8 = nb8;
        { const int cid2 = cid + G; if (cid2 < NCHUNK) { const int c2 = cid2 % NCK, bh2 = cid2 / NCK; CK_LOADIN(c2, bh2 & 15, bh2 >> 4); } }
        { const int tl = lane >> 3;
#pragma unroll
          for (int e = 0; e < 8; ++e) { float x = wv[e];
              float y = __shfl_up(x, 8); if (tl >= 1) x *= y;
              y = __shfl_up(x, 16); if (tl >= 2) x *= y;
              y = __shfl_up(x, 32); if (tl >= 4) x *= y;
              gv[e] = x; }
          if (tl == 7) {
#pragma unroll
              for (int e = 0; e < 8; ++e) Gf[wave * 64 + c8 + e] = gv[e]; } }
        CK_BAR();
        {
#pragma unroll 1
          for (int w2 = 0; w2 < wave; ++w2) {
#pragma unroll
              for (int e = 0; e < 8; ++e) gv[e] *= Gf[w2 * 64 + c8 + e]; }
#pragma unroll
          for (int e = 0; e < 8; ++e) gp[e] = gv[e] / wv[e];
          if (t == CK - 1) {
#pragma unroll
              for (int e = 0; e < 8; ++e) gC[c8 + e] = gv[e]; } }
        {
          float rt[8], at[8], kt[8], bt[8], vv[8];
#pragma unroll
          for (int e = 0; e < 8; ++e) { const unsigned rw = (e < 2) ? r8.x : (e < 4) ? r8.y : (e < 6) ? r8.z : r8.w, kw = (e < 2) ? k8.x : (e < 4) ? k8.y : (e < 6) ? k8.z : k8.w, vw = (e < 2) ? v8.x : (e < 4) ? v8.y : (e < 6) ? v8.z : v8.w,
                  qw = (e < 2) ? kk8.x : (e < 4) ? kk8.y : (e < 6) ? kk8.z : kk8.w, bw = (e < 2) ? b8.x : (e < 4) ? b8.y : (e < 6) ? b8.z : b8.w;
              const float rv = (e & 1) ? bfhi(rw) : bflo(rw), kv = (e & 1) ? bfhi(kw) : bflo(kw), vx = (e & 1) ? bfhi(vw) : bflo(vw), qv = (e & 1) ? bfhi(qw) : bflo(qw), bv = (e & 1) ? bfhi(bw) : bflo(bw);
              const float ig = 1.f / gv[e];
              rt[e] = rv * gv[e]; at[e] = -qv * gp[e]; kt[e] = kv * ig; bt[e] = bv * ig; vv[e] = vx; }
          *(LAS u32x4*)(SL(6) + t * CP + c8) = (u32x4){pk2(rt[0], rt[1]), pk2(rt[2], rt[3]), pk2(rt[4], rt[5]), pk2(rt[6], rt[7])};
          *(LAS u32x4*)(SL(0) + t * CP + c8) = (u32x4){pk2(at[0], at[1]), pk2(at[2], at[3]), pk2(at[4], at[5]), pk2(at[6], at[7])};
          *(LAS u32x4*)(SL(4) + t * CP + c8) = (u32x4){pk2(kt[0], kt[1]), pk2(kt[2], kt[3]), pk2(kt[4], kt[5]), pk2(kt[6], kt[7])};
          *(LAS u32x4*)(SL(2) + t * CP + c8) = (u32x4){pk2(bt[0], bt[1]), pk2(bt[2], bt[3]), pk2(bt[4], bt[5]), pk2(bt[6], bt[7])};
          *(LAS u32x4*)(SL(10) + t * CP + c8) = (u32x4){pk2(vv[0], vv[1]), pk2(vv[2], vv[3]), pk2(vv[4], vv[5]), pk2(vv[6], vv[7])};
          { unsigned iw[4];
#pragma unroll
            for (int e = 0; e < 4; ++e) iw[e] = ((c8 + 2 * e == t) ? 0x3f80u : 0u) | ((c8 + 2 * e + 1 == t) ? 0x3f800000u : 0u);
            *(LAS u32x4*)(SL(11) + t * CP + c8) = (u32x4){iw[0], iw[1], iw[2], iw[3]}; } }
        CK_BAR();
#define CK_RUN2(A1, B1, E1, A2, B2, E2) do { CkF f1_, f2_; ck_ld(f1_, A1, B1, wave, lane); ck_ld(f2_, A2, B2, wave, lane); __builtin_amdgcn_sched_barrier(0); \
            f32x4 c1_[2] = CK_Z2, c2_[2] = CK_Z2; ck_mma(c1_, f1_); ck_mma(c2_, f2_); ck_epi(c1_, wave, lane, E1); ck_epi(c2_, wave, lane, E2); } while (0)
#define CK_RUN3(A1, B1, E1, A2, B2, E2, A3, B3, E3) do { CkF f1_, f2_, f3_; ck_ld(f1_, A1, B1, wave, lane); ck_ld(f2_, A2, B2, wave, lane); ck_ld(f3_, A3, B3, wave, lane); __builtin_amdgcn_sched_barrier(0); \
            f32x4 c1_[2] = CK_Z2, c2_[2] = CK_Z2, c3_[2] = CK_Z2; ck_mma(c1_, f1_); ck_mma(c2_, f2_); ck_mma(c3_, f3_); ck_epi(c1_, wave, lane, E1); ck_epi(c2_, wave, lane, E2); ck_epi(c3_, wave, lane, E3); } while (0)
        { auto t1 = [&](int m, int n, f32x4 v) { ck_wr_tr(SL(1), m, n, v); }; auto t3 = [&](int m, int n, f32x4 v) { ck_wr_tr(SL(3), m, n, v); };
          auto t5 = [&](int m, int n, f32x4 v) { ck_wr_tr(SL(5), m, n, v); }; auto t7 = [&](int m, int n, f32x4 v) { ck_wr_tr(SL(7), m, n, v); };
          CK_RUN2(SL(0), SL(11), t1, SL(2), SL(11), t3); CK_RUN2(SL(4), SL(11), t5, SL(10), SL(11), t7); }
        CK_BAR();
        { auto ePT = [&](int m, int n, f32x4 v) {
#pragma unroll
              for (int g = 0; g < 4; ++g) v[g] = (n < m + g) ? v[g] : 0.f;
              ck_wr_tr(SL(13), m, n, v); };
          auto ePA = [&](int m, int n, f32x4 v) { f32x4 tt;
#pragma unroll
              for (int g = 0; g < 4; ++g) { v[g] = (m + g < n) ? v[g] : 0.f; tt[g] = (m + g == n) ? 1.f : v[g]; }
              ck_wr_tr(SL(12), m, n, v); ck_wr_tr(SL(8), m, n, tt); };
          auto eMak = [&](int m, int n, f32x4 v) {
#pragma unroll
              for (int g = 0; g < 4; ++g) v[g] = (m + g < n) ? v[g] : 0.f;
              ck_wr_tr(SL(9), m, n, v); };
          CK_RUN3(SL(0), SL(2), ePT, SL(2), SL(0), ePA, SL(4), SL(0), eMak); }
        { auto eNrb = [&](int m, int n, f32x4 v) {
#pragma unroll
              for (int g = 0; g < 4; ++g) v[g] = (m + g <= n) ? v[g] : 0.f;
              ck_wr_tr(SL(10), m, n, v); };
          auto eNrk = [&](int m, int n, f32x4 v) {
#pragma unroll
              for (int g = 0; g < 4; ++g) v[g] = (m + g <= n) ? v[g] : 0.f;
              ck_wr_tr(SL(11), m, n, v); };
          CK_RUN2(SL(2), SL(6), eNrb, SL(4), SL(6), eNrk); }
        CK_BAR();
#define CK_NEU(TA, TB, PA_, PT_, PAN, PTN) do { \
            auto eT_ = [&](int m, int n, f32x4 v) { const u32x2 o = *(const LAS u32x2*)(SL(TA) + n * CP + m); v[0] += bflo(o.x); v[1] += bfhi(o.x); v[2] += bflo(o.y); v[3] += bfhi(o.y); ck_wr_tr(SL(TB), m, n, v); }; \
            auto eS1_ = [&](int m, int n, f32x4 v) { ck_wr_tr(SL(PTN), m, n, v); }; auto eS2_ = [&](int m, int n, f32x4 v) { ck_wr_tr(SL(PAN), m, n, v); }; \
            CK_RUN3(SL(PT_), SL(TA), eT_, SL(PA_), SL(PT_), eS1_, SL(PT_), SL(PA_), eS2_); CK_BAR(); } while (0)
        { auto eS1 = [&](int m, int n, f32x4 v) { ck_wr_tr(SL(2), m, n, v); }; auto eS2 = [&](int m, int n, f32x4 v) { ck_wr_tr(SL(0), m, n, v); };
          CK_RUN2(SL(12), SL(13), eS1, SL(13), SL(12), eS2); }
        CK_BAR();
        CK_NEU(8, 4, 0, 2, 12, 13);
        CK_NEU(4, 8, 12, 13, 0, 2);
        CK_NEU(8, 4, 0, 2, 12, 13);
        CK_NEU(4, 8, 12, 13, 0, 2);
        ck_mm(SL(2), SL(8), nullptr, nullptr, wave, lane, [&](int m, int n, f32x4 v) { const u32x2 o = *(const LAS u32x2*)(SL(8) + n * CP + m);
            v[0] += bflo(o.x); v[1] += bfhi(o.x); v[2] += bflo(o.y); v[3] += bfhi(o.y); ck_wr_tr(SL(4), m, n, v); });
        CK_BAR();
#undef CK_NEU
        { auto e12 = [&](int m, int n, f32x4 v) { ck_wr_tr(SL(12), m, n, v); }; auto e0 = [&](int m, int n, f32x4 v) { ck_wr_tr(SL(0), m, n, v); };
          CK_RUN2(SL(9), SL(7), e12, SL(4), SL(1), e0); }
        CK_BAR();
        { bf16* Pg = (bf16*)(ws + CH_P) + (size_t)cid * 4096; bf16* Rg = (bf16*)(ws + CH_RH) + (size_t)cid * 4096;
          auto e13 = [&](int m, int n, f32x4 v) { ck_wr_tr(SL(13), m, n, v); };
          auto eP = [&](int m, int n, f32x4 v) { const float gc = gC[n];
#pragma unroll
              for (int g = 0; g < 4; ++g) v[g] = gc * (((m + g == n) ? 1.f : 0.f) + v[g]);
              *(u32x2*)(Pg + n * 64 + m) = (u32x2){pk2(v[0], v[1]), pk2(v[2], v[3])}; };
          auto eR = [&](int m, int n, f32x4 v) { const u32x2 o = *(const LAS u32x2*)(SL(6) + n * CP + m);
              v[0] += bflo(o.x); v[1] += bfhi(o.x); v[2] += bflo(o.y); v[3] += bfhi(o.y);
              *(u32x2*)(Rg + n * 64 + m) = (u32x2){pk2(v[0], v[1]), pk2(v[2], v[3])}; };
          CK_RUN3(SL(4), SL(12), e13, SL(0), SL(3), eP, SL(0), SL(10), eR); }
        CK_BAR();
        { float* Qg = (float*)(ws + CH_Q) + (size_t)cid * 4096; float* Yg = (float*)(ws + CH_YL) + (size_t)cid * 4096;
          CkF f1, f2, f3, f4; ck_ld(f1, SL(13), SL(3), wave, lane); ck_ld(f2, SL(7), SL(5), wave, lane); ck_ld(f3, SL(13), SL(10), wave, lane); ck_ld(f4, SL(7), SL(11), wave, lane); __builtin_amdgcn_sched_barrier(0);
          f32x4 cq[2] = CK_Z2, cy[2] = CK_Z2; ck_mma(cq, f1); ck_mma(cq, f2); ck_mma(cy, f3); ck_mma(cy, f4);
          ck_epi(cq, wave, lane, [&](int m, int n, f32x4 v) { *(f32x4*)(Qg + n * 64 + m) = v * gC[n]; });
          ck_epi(cy, wave, lane, [&](int m, int n, f32x4 v) { *(f32x4*)(Yg + n * 64 + m) = v; }); }
#undef CK_RUN2
#undef CK_RUN3
    }
#undef SL
#undef CK_BAR
#undef CK_LOADIN
}
DI void phase_chunkB(const Args& a, LAS unsigned char* lds, int wave, int lane, int bid, int G) {
    unsigned char* ws = (unsigned char*)a.ws; LAS bf16* Zb = (LAS bf16*)lds;
    const int r = lane & 15, q = lane >> 4;
    if (wave != 0) return;
    __builtin_amdgcn_s_setprio(3);
    for (int u = bid; u < NB * NH * 4; u += G) { const int iq = u & 3, bh = u >> 2;
        bf16x8 pf[3][4][2]; f32x4 qv[3][4];
#define CB_LOAD(s_, cc) do { const size_t cid_ = (size_t)bh * NCK + (cc); const bf16* Pg_ = (const bf16*)(ws + CH_P) + cid_ * 4096; const float* Qg_ = (const float*)(ws + CH_Q) + cid_ * 4096; \
            _Pragma("unroll") for (int mt = 0; mt < 4; ++mt) { _Pragma("unroll") for (int ks = 0; ks < 2; ++ks) pf[s_][mt][ks] = *(const bf16x8*)(Pg_ + (16 * mt + r) * 64 + 32 * ks + 8 * q); \
            _Pragma("unroll") for (int g = 0; g < 4; ++g) qv[s_][mt][g] = Qg_[(16 * mt + 4 * q + g) * 64 + 16 * iq + r]; } } while (0)
#define CB_STEP(s_, cc) do { if ((cc) < NCK - 1) { const size_t cid = (size_t)bh * NCK + (cc); \
            asm volatile("s_waitcnt lgkmcnt(0)" ::: "memory");                    \
            bf16x8 zf[2]; \
            _Pragma("unroll") for (int ks = 0; ks < 2; ++ks) zf[ks] = *(const LAS bf16x8*)(Zb + r * CP + 32 * ks + 8 * q); \
            f32x4 z[4]; \
            _Pragma("unroll") for (int mt = 0; mt < 4; ++mt) { z[mt] = qv[s_][mt]; \
                _Pragma("unroll") for (int ks = 0; ks < 2; ++ks) z[mt] = __builtin_amdgcn_mfma_f32_16x16x32_bf16(pf[s_][mt][ks], zf[ks], z[mt], 0, 0, 0); } \
            if ((cc) + 3 < NCK - 1) CB_LOAD(s_, (cc) + 3); \
            _Pragma("unroll") for (int mt = 0; mt < 4; ++mt) { const u32x2 zw = {pk2(z[mt][0], z[mt][1]), pk2(z[mt][2], z[mt][3])}; *(LAS u32x2*)(Zb + r * CP + 16 * mt + 4 * q) = zw; \
                *(u32x2*)((bf16*)(ws + CH_ZS) + (cid + 1) * 4096 + (16 * iq + r) * 64 + 16 * mt + 4 * q) = zw; } } } while (0)
        asm volatile("s_waitcnt lgkmcnt(0)" ::: "memory");
#pragma unroll
        for (int mt = 0; mt < 4; ++mt) { *(LAS u32x2*)(Zb + r * CP + 16 * mt + 4 * q) = (u32x2){0u, 0u};
            *(u32x2*)((bf16*)(ws + CH_ZS) + ((size_t)bh * NCK) * 4096 + (16 * iq + r) * 64 + 16 * mt + 4 * q) = (u32x2){0u, 0u}; }
        CB_LOAD(0, 0); CB_LOAD(1, 1); CB_LOAD(2, 2);
        static_assert(NCK - 1 >= 3, "three steps are requested before the loop");
#pragma unroll 1
        for (int c = 0; c < NCK - 1; c += 3) { CB_STEP(0, c); CB_STEP(1, c + 1); CB_STEP(2, c + 2); }
    }
    __builtin_amdgcn_s_setprio(0);
#undef CB_STEP
#undef CB_LOAD
}
DI void phase_chunkC(const Args& a, int l, int gw, int NGW, int lane) {
    unsigned char* ws = (unsigned char*)a.ws; const int r = lane & 15, q = lane >> 4;
    const bf16* Vv = (const bf16*)(ws + WS_V); const bf16* Gg = (const bf16*)(ws + WS_G); const float* RK = (const float*)(ws + WS_RK); bf16* ORW = (bf16*)(ws + WS_ORW);
    const float* lnw = a.inp(I_LNW) + (size_t)l * C; const float* lnb = a.inp(I_LNB) + (size_t)l * C;
    constexpr int NUC = NCHUNK * 4, NSHC = 32;
    const int nstat = (3 * NGW <= NUC) ? 3 : NUC / NGW, npoolc = NUC - nstat * NGW, pperc = (npoolc + NSHC - 1) / NSHC, shc = gw % NSHC, ploc = shc * pperc, phic = (ploc + pperc < npoolc) ? ploc + pperc : npoolc;
    unsigned* cqh = (unsigned*)(ws + WS_CTL) + CW_CQ + (l * NSHC + shc) * 16;
#define CC_PULL() ((lane == 0) ? __hip_atomic_fetch_add(cqh, 1u, __ATOMIC_RELAXED, __HIP_MEMORY_SCOPE_AGENT) : 0u)
    unsigned pvc = 0u; if (nstat == 0) pvc = CC_PULL();
    for (int it = 0; ; ++it) { int u;
        if (it < nstat) { u = gw + it * NGW; if (it + 1 == nstat) pvc = CC_PULL(); }
        else { const int p = ploc + __builtin_amdgcn_readfirstlane((int)pvc); if (p >= phic) break; pvc = CC_PULL(); u = nstat * NGW + p; }
        const int tt = u & 3, cid = u >> 2; const int c = cid % NCK, bh = cid / NCK, hd = bh & 15, b = bh >> 4;
        const bf16* Zg = (const bf16*)(ws + CH_ZS) + (size_t)cid * 4096; const bf16* Rg = (const bf16*)(ws + CH_RH) + (size_t)cid * 4096; const float* Yg = (const float*)(ws + CH_YL) + (size_t)cid * 4096;
        const int t = 16 * tt + r, tok = CK * c + t; const bool ok = tok < L; const size_t ro = (size_t)(b * L + (ok ? tok : 0)) * C + hd * 64;
        bf16x8 bfr[2], zfr[4][2]; f32x4 y[4], lw[4], lb[4]; u32x2 vw[4], gw_[4];
#pragma unroll
        for (int ks = 0; ks < 2; ++ks) bfr[ks] = *(const bf16x8*)(Rg + t * 64 + 32 * ks + 8 * q);
#pragma unroll
        for (int it = 0; it < 4; ++it) { y[it] = *(const f32x4*)(Yg + t * 64 + 16 * it + 4 * q);
#pragma unroll
            for (int ks = 0; ks < 2; ++ks) zfr[it][ks] = *(const bf16x8*)(Zg + (16 * it + r) * 64 + 32 * ks + 8 * q); }
        const float rk = RK[(size_t)(b * L + (ok ? tok : 0)) * NH + hd];
#pragma unroll
        for (int it = 0; it < 4; ++it) { const int ch = 16 * it + 4 * q; vw[it] = *(const u32x2*)(Vv + ro + ch); gw_[it] = *(const u32x2*)(Gg + ro + ch);
            lw[it] = *(const f32x4*)(lnw + hd * 64 + ch); lb[it] = *(const f32x4*)(lnb + hd * 64 + ch); }
        __builtin_amdgcn_sched_barrier(0);
        float s = 0.f;
#pragma unroll
        for (int it = 0; it < 4; ++it) { f32x4 acc = y[it];
#pragma unroll
            for (int ks = 0; ks < 2; ++ks) acc = __builtin_amdgcn_mfma_f32_16x16x32_bf16(zfr[it][ks], bfr[ks], acc, 0, 0, 0);
            y[it] = acc; s += (acc[0] + acc[1]) + (acc[2] + acc[3]); }
        s += __shfl_xor(s, 16); s += __shfl_xor(s, 32); const float mean = s * (1.f / 64.f); float qs = 0.f;
#pragma unroll
        for (int it = 0; it < 4; ++it) { y[it] = y[it] - mean; qs += (y[it][0] * y[it][0] + y[it][1] * y[it][1]) + (y[it][2] * y[it][2] + y[it][3] * y[it][3]); }
        qs += __shfl_xor(qs, 16); qs += __shfl_xor(qs, 32); const float rstd = rsqrtf(qs * (1.f / 64.f) + GN_EPS);
#pragma unroll
        for (int it = 0; it < 4; ++it) { const int ch = 16 * it + 4 * q;
            const f32x4 v = {bflo(vw[it].x), bfhi(vw[it].x), bflo(vw[it].y), bfhi(vw[it].y)}, g = {bflo(gw_[it].x), bfhi(gw_[it].x), bflo(gw_[it].y), bfhi(gw_[it].y)};
            const f32x4 o = (y[it] * rstd * lw[it] + lb[it] + rk * v) * g;
            if (ok) *(u32x2*)(ORW + ro + ch) = (u32x2){pk2(o[0], o[1]), pk2(o[2], o[3])}; }
    }
}
#undef CC_PULL
DI void phase_router(const Args& a, int l, LAS unsigned char* lds, int wave, int lane, int bid, int G, bool dummy = false) {
    unsigned char* ws = (unsigned char*)a.ws; const float* H = (const float*)(ws + WS_H); bf16* U = (bf16*)(ws + WS_U); const bf16* WRO = (const bf16*)(ws + WS_WRO) + (size_t)l * 80 * D;
    const float* gain = a.inp(I_NORM_FFN) + (size_t)l * D; const float* bco = a.inp(I_BCOARSE) + l * 8; const float* bfi = a.inp(I_BFINE) + l * 64;
    int* toke = (int*)(ws + WS_TOKE); int* toks = (int*)(ws + WS_TOKS); float* tokw = (float*)(ws + WS_TOKW); unsigned* cnt = (unsigned*)(ws + WS_CTL) + CW_CNT + l * 64 * 16;
    int* elist = (int*)(ws + WS_ELIST);
    if (dummy) { toke = (int*)(ws + WS_XR); toks = toke + 2 * T; tokw = (float*)(toks + 2 * T); cnt += 8192; U = (bf16*)(ws + WS_XR) + (size_t)8 * T; elist = (int*)(ws + WS_XR) + (size_t)(8 + 2048) * T; }
    LAS float* red = (LAS float*)lds;
    LAS float* ssp = red + 8 * 16 * 80;
    LAS float* lg = ssp + 8 * 16;
    LAS float* rs = lg + 16 * 72;
    LAS float* bia = rs + 16;
    const int tid = wave * 64 + lane;
    const int n = lane & 15, q = lane >> 4;
    f32x4 hv[8][2];
    const float* gp = gain + wave * 256 + 8 * q;
#define RT_LOADH(tile_) do { const float* hp_ = H + (size_t)((tile_) * 16 + n) * D + wave * 256 + 8 * q; _Pragma("unroll") for (int ks = 0; ks < 8; ++ks) { hv[ks][0] = *(const f32x4*)(hp_ + ks * 32); hv[ks][1] = *(const f32x4*)(hp_ + ks * 32 + 4); } } while (0)
    if (bid < T / 16) RT_LOADH(bid);
    if (wave * 64 + lane < 72) { const int nn_ = wave * 64 + lane; bia[nn_] = (nn_ < 8) ? bco[nn_] : bfi[nn_ - 8]; }
    for (int tile = bid; tile < T / 16; tile += G) { const int row0 = tile * 16;
        __syncthreads();
        f32x4 acc[5];
#pragma unroll
        for (int nt = 0; nt < 5; ++nt) acc[nt] = (f32x4){0.f, 0.f, 0.f, 0.f};
        float ss = 0.f;
        bf16x8 wfr[2][5]; f32x4 gfr[2][2];
#define RT_WLOAD(s_, ks_) do { const int k0_ = wave * 256 + (ks_) * 32 + 8 * q; _Pragma("unroll") for (int nt = 0; nt < 5; ++nt) wfr[s_][nt] = *(const bf16x8*)(WRO + (size_t)(nt * 16 + n) * D + k0_); \
            gfr[s_][0] = *(const f32x4*)(gp + (ks_) * 32); gfr[s_][1] = *(const f32x4*)(gp + (ks_) * 32 + 4); } while (0)
        RT_WLOAD(0, 0);
#pragma unroll
        for (int ks = 0; ks < 8; ++ks) {
            if (ks < 7) RT_WLOAD((ks + 1) & 1, ks + 1);
            __builtin_amdgcn_sched_barrier(0);
            const f32x4 g0 = gfr[ks & 1][0], g1 = gfr[ks & 1][1]; const f32x4 x0 = hv[ks][0], x1 = hv[ks][1];
            ss += (x0[0] * x0[0] + x0[1] * x0[1]) + (x0[2] * x0[2] + x0[3] * x0[3]) + (x1[0] * x1[0] + x1[1] * x1[1]) + (x1[2] * x1[2] + x1[3] * x1[3]);
            const f32x4 y0 = x0 * g0, y1 = x1 * g1; hv[ks][0] = y0; hv[ks][1] = y1; u32x4 aw;     aw.x = pk2(y0[0], y0[1]); aw.y = pk2(y0[2], y0[3]); aw.z = pk2(y1[0], y1[1]); aw.w = pk2(y1[2], y1[3]);
            const bf16x8 af = __builtin_bit_cast(bf16x8, aw);
#pragma unroll
            for (int nt = 0; nt < 5; ++nt) acc[nt] = __builtin_amdgcn_mfma_f32_16x16x32_bf16(af, wfr[ks & 1][nt], acc[nt], 0, 0, 0);
            __builtin_amdgcn_sched_barrier(0); }
#undef RT_WLOAD
        ss += __shfl_xor(ss, 16); ss += __shfl_xor(ss, 32);
        if (q == 0) ssp[wave * 16 + n] = ss;
#pragma unroll
        for (int nt = 0; nt < 5; ++nt)
#pragma unroll
            for (int j = 0; j < 4; ++j) red[(wave * 16 + 4 * q + j) * 80 + nt * 16 + n] = acc[nt][j];
        __syncthreads();
        if (tid < 16) { float s = 0.f;
#pragma unroll
            for (int w = 0; w < 8; ++w) s += ssp[w * 16 + tid];
            rs[tid] = rsqrtf(s * (1.f / D) + NORM_EPS); }
        __syncthreads();
        for (int i = tid; i < 16 * 72; i += NTHR) { const int tk = i / 72, nn = i % 72; float s = 0.f;
#pragma unroll
            for (int w = 0; w < 8; ++w) s += red[(w * 16 + tk) * 80 + nn];
            lg[tk * 72 + nn] = s * rs[tk] + bia[nn]; }
        { const float rstd = rs[n]; bf16* up = U + (size_t)(row0 + n) * D + wave * 256 + 8 * q;
#pragma unroll
          for (int ks = 0; ks < 8; ++ks) { const f32x4 y0 = hv[ks][0] * rstd, y1 = hv[ks][1] * rstd;
              *(u32x4*)(up + ks * 32) = (u32x4){pk2(y0[0], y0[1]), pk2(y0[2], y0[3]), pk2(y1[0], y1[1]), pk2(y1[2], y1[3])}; } }
        if (tile + G < T / 16) RT_LOADH(tile + G);
        asm volatile("s_waitcnt lgkmcnt(0)" ::: "memory"); __builtin_amdgcn_s_barrier(); asm volatile("" ::: "memory");
        if (tid < 16) { const int m = row0 + tid; const LAS float* p = lg + tid * 72;
            int gi = 0; float gm = p[0];
#pragma unroll
            for (int j = 1; j < 8; ++j) if (p[j] > gm) { gm = p[j]; gi = j; }
            float se = 0.f;
#pragma unroll
            for (int j = 0; j < 8; ++j) se += __expf(p[j] - gm);
            const float pgrp = 1.f / se;
            const LAS float* f = p + 8 + gi * 8;
            int i0 = 0; float f0 = f[0];
#pragma unroll
            for (int j = 1; j < 8; ++j) if (f[j] > f0) { f0 = f[j]; i0 = j; }
            int i1 = -1; float f1 = -3.0e38f;
#pragma unroll
            for (int j = 0; j < 8; ++j) if (j != i0 && f[j] > f1) { f1 = f[j]; i1 = j; }
            const float e1 = __expf(f1 - f0), den = 1.f / (1.f + e1);
            const int e0x = gi * 8 + i0, e1x = gi * 8 + i1;
            toke[2 * m] = e0x; toke[2 * m + 1] = e1x; tokw[2 * m] = den * pgrp; tokw[2 * m + 1] = e1 * den * pgrp;
            const int s0 = (int)__hip_atomic_fetch_add(cnt + e0x * 16, 1u, RLX_AGENT), s1 = (int)__hip_atomic_fetch_add(cnt + e1x * 16, 1u, RLX_AGENT);
            toks[2 * m] = s0; toks[2 * m + 1] = s1; elist[(size_t)e0x * T + s0] = m; elist[(size_t)e1x * T + s1] = m; }
    }
}
#undef RT_LOADH
constexpr int MS_XOFF = 2 * 128 * 128, MS_XBUF = 48 * 128, MS_XWAVE = 2 * MS_XBUF;
constexpr int MS_TILE = 128 * 128;
template <int MODE, int VAR = 0>
DI void moe_stream_phase(const Args& a, int l, LAS unsigned char* lds, int wave, int lane, int tid, int bid, int G, int lw = -1, size_t out_off = 0) {
    unsigned char* ws = (unsigned char*)a.ws; LAS int* lc = (LAS int*)(lds + LDSCTL_OFF);
    if (MODE == 0 || lw >= 0) moe_tables((const unsigned*)(ws + WS_CTL) + CW_CNT + l * 64 * 16, lc, tid);
    if (lw >= 0) l = lw;
    const size_t o_hid = out_off ? out_off : WS_HID, o_yr = out_off ? out_off : WS_YR;
    constexpr int KD = (MODE == 0) ? D : DEXP, NT = KD / 64, NSLAB = (MODE == 0) ? 8 : 16, LDW = (MODE == 0) ? DEXP : D, LDX = KD;
    const int half = wave & 1, nb16 = lane & 15, kb = 4 * (wave >> 1) + (lane >> 4);
    const int tk = lane & 15, q = lane >> 4;
    const GAS char* wmat = (const GAS char*)((MODE == 0) ? (half ? a.inp(I_WEU) : a.inp(I_WEG)) : a.inp(I_WED));
    const unsigned wvo = (unsigned)((4 * kb * LDW + 4 * nb16) * 4);
    const int lw0 = (64 * half + 4 * nb16) * 128 + (((kb >> 1) ^ ((2 * nb16) & 7)) << 4) + (kb & 1) * 8, lw1 = lw0 ^ 16;
    const int rd_g = (tk >> 1) & 7;
    for (int vb = bid; vb < NEXP * NSLAB; vb += G) {
        const int xcd = vb & 7, idx = vb >> 3; const int e = xcd * 8 + idx / NSLAB, slab = idx % NSLAB;
        const int M = __builtin_amdgcn_readfirstlane(lc[LC_CNT / 4 + e]), row0 = __builtin_amdgcn_readfirstlane(lc[LC_PSTART / 4 + e]);
        const size_t wuo = (MODE == 0) ? ((size_t)(l * NEXP + e) * D * DEXP + slab * 64) * 4 : ((size_t)(l * NEXP + e) * DEXP * D + slab * 128 + 64 * half) * 4;
        const __amdgpu_buffer_rsrc_t wrs = __builtin_amdgcn_make_buffer_rsrc((void*)(wmat + wuo), 0, KD * LDW * 4, 0x00020000);
        const __amdgpu_buffer_rsrc_t xrs = __builtin_amdgcn_make_buffer_rsrc((MODE == 0) ? (void*)(ws + WS_U) : (void*)((const GAS char*)(ws + WS_HID) + (size_t)row0 * LDX * 2), 0, 0x7fffffff, 0x00020000);
        const int* el = (const int*)(ws + WS_ELIST) + (size_t)e * T;
        for (int rp = 0; rp < M; rp += 384) {
            unsigned xso[6];
#pragma unroll
            for (int i = 0; i < 6; ++i) { int tok = rp + wave * 48 + 8 * i + (lane >> 3); tok = min(tok, M - 1); if (VAR == 5) tok &= 15; if (MODE == 0) tok = el[tok]; xso[i] = (unsigned)(tok * LDX * 2 + (lane & 7) * 16); }
            LAS unsigned char* xw = lds + MS_XOFF + wave * MS_XWAVE; const int xwo = (lane >> 3) * 128 + (((lane & 7) ^ ((lane >> 4) & 3)) << 4);
            const LAS unsigned char* xr = lds + MS_XOFF + wave * MS_XWAVE + tk * 128 + ((q ^ rd_g) << 4);
            f32x4 acc[3][8];
#pragma unroll
            for (int mt = 0; mt < 3; ++mt)
#pragma unroll
                for (int j = 0; j < 8; ++j) acc[mt][j] = (f32x4){0.f, 0.f, 0.f, 0.f};
            f32x4 wr[2][4];
            bf16x8 xs[6];
#define MS_CL(t) (((t) < NT) ? (t) : NT - 1)
#define MS_WLOAD(set, t) do { _Pragma("unroll") for (int r_ = 0; r_ < 4; ++r_) wr[set][r_] = __builtin_bit_cast(f32x4, __builtin_amdgcn_raw_buffer_load_b128(wrs, (int)wvo + r_ * LDW * 4, MS_CL(t) * (64 * LDW * 4), 0)); } while (0)
#define MS_WCOMMIT(set, bufi) do { LAS unsigned char* wb_ = lds + (bufi) * MS_TILE; _Pragma("unroll") for (int i_ = 0; i_ < 4; ++i_) { \
            u32x2 p_; p_.x = pk2(wr[set][0][i_], wr[set][1][i_]); p_.y = pk2(wr[set][2][i_], wr[set][3][i_]); \
            *(LAS u32x2*)(wb_ + ((i_ < 2) ? lw0 : lw1) + i_ * 128) = p_; } } while (0)
#define MS_XSLOAD(t) do { _Pragma("unroll") for (int i_ = 0; i_ < 6; ++i_) xs[i_] = __builtin_bit_cast(bf16x8, __builtin_amdgcn_raw_buffer_load_b128(xrs, (int)xso[i_], MS_CL(t) * 128, 0)); } while (0)
#define MS_XSWRITE(bufi) do { _Pragma("unroll") for (int i_ = 0; i_ < 6; ++i_) *(LAS bf16x8*)(xw + (bufi) * MS_XBUF + i_ * 1024 + ((i_ & 1) ? (xwo ^ 64) : xwo)) = xs[i_]; } while (0)
#define MS_WF(dst, bufi, g) do { const LAS unsigned char* wb_ = lds + (bufi) * MS_TILE + tk * 128; _Pragma("unroll") for (int jj = 0; jj < 4; ++jj) \
            dst[jj] = *(const LAS bf16x8*)(wb_ + (16 * (4 * ((g) & 1) + jj)) * 128 + (((4 * ((g) >> 1) + q) ^ rd_g) << 4)); } while (0)
#define MS_XF(ks, bufi) do { _Pragma("unroll") for (int mt = 0; mt < 3; ++mt) xf[mt] = *(const LAS bf16x8*)(((ks) ? xr1 : xr) + (bufi) * MS_XBUF + mt * 2048); } while (0)
#define MS_MM(wf, g) do { _Pragma("unroll") for (int jj = 0; jj < 4; ++jj) _Pragma("unroll") for (int mt = 0; mt < 3; ++mt) \
            acc[mt][4 * ((g) & 1) + jj] = __builtin_amdgcn_mfma_f32_16x16x32_bf16(wf[jj], xf[mt], acc[mt][4 * ((g) & 1) + jj], 0, 0, 0); } while (0)
#define MS_COMPUTE(bufi) do { bf16x8 wf_[4], xf[3]; MS_XF(0, bufi); MS_WF(wf_, bufi, 0); __builtin_amdgcn_sched_barrier(0); MS_MM(wf_, 0); __builtin_amdgcn_sched_barrier(0); \
            MS_WF(wf_, bufi, 1); __builtin_amdgcn_sched_barrier(0); MS_MM(wf_, 1); __builtin_amdgcn_sched_barrier(0); MS_XF(1, bufi); MS_WF(wf_, bufi, 2); __builtin_amdgcn_sched_barrier(0); MS_MM(wf_, 2); \
            __builtin_amdgcn_sched_barrier(0); MS_WF(wf_, bufi, 3); __builtin_amdgcn_sched_barrier(0); MS_MM(wf_, 3); } while (0)
#define MS_STEP(I, J, t) do { MS_WCOMMIT(J, J); MS_WLOAD(J, (t) + 3); MS_COMPUTE(I); MS_XSWRITE(J); MS_XSLOAD((t) + 2); __syncthreads(); } while (0)
            const LAS unsigned char* xr1 = lds + MS_XOFF + wave * MS_XWAVE + tk * 128 + (((4 + q) ^ rd_g) << 4);
            __syncthreads();
            MS_XSLOAD(0); MS_WLOAD(0, 0); MS_WLOAD(1, 1);
            MS_WCOMMIT(0, 0); MS_WLOAD(0, 2);
            MS_XSWRITE(0); MS_XSLOAD(1);
            __syncthreads();
#pragma unroll 1
            for (int t = 0; t < NT; t += 2) { MS_STEP(0, 1, t); MS_STEP(1, 0, t + 1); }
#pragma unroll
            for (int mt = 0; mt < 3; ++mt) { const int tok = rp + wave * 48 + mt * 16 + tk;
                if (tok < M) {
                    if (MODE == 0) { bf16* o = (bf16*)(ws + o_hid) + (size_t)(row0 + tok) * DEXP + slab * 64 + 4 * q;
#pragma unroll
                        for (int j = 0; j < 4; ++j) { float h[4];
#pragma unroll
                            for (int i = 0; i < 4; ++i) { const float gt = acc[mt][j][i]; h[i] = gt * sigmoidf_(gt) * acc[mt][j + 4][i]; }
                            *(u32x2*)(o + 16 * j) = (u32x2){pk2(h[0], h[1]), pk2(h[2], h[3])}; }
                    } else { bf16* o = (bf16*)(ws + o_yr) + (size_t)(row0 + tok) * D + slab * 128 + 4 * q;
#pragma unroll
                        for (int j = 0; j < 8; ++j) *(u32x2*)(o + 16 * j) = (u32x2){pk2(acc[mt][j][0], acc[mt][j][1]), pk2(acc[mt][j][2], acc[mt][j][3])}; } } }
#undef MS_CL
#undef MS_XSLOAD
#undef MS_XSWRITE
#undef MS_XF
#undef MS_STEP
#undef MS_WLOAD
#undef MS_WCOMMIT
#undef MS_COMPUTE
#undef MS_WF
#undef MS_MM
        }
    }
}

constexpr int PH_PER_LAYER = 10, NPHASE = 1 + 2 * PH_PER_LAYER + 1;
__global__ void __launch_bounds__(NTHR, 2) mk_fwd(ArgsV argsv) {
    extern __shared__ __attribute__((aligned(16))) unsigned char lds_raw[];
    LAS unsigned char* lds = (LAS unsigned char*)lds_raw;
    Args args; args.p = (ArgsP)__builtin_amdgcn_kernarg_segment_ptr(); args.ws = (GAS unsigned char*)args.p->ws; args.out = (GAS float*)args.p->out;
    { const int tid0 = threadIdx.x; for (int u = tid0; u < (LDS_BYTES - LDSCTL_OFF) / 4; u += NTHR) ((LAS unsigned*)(lds + LDSCTL_OFF))[u] = 0u; }
    __syncthreads();
    XcdBarrier bar; bar.bar = (unsigned*)(args.ws + WS_CTL) + CW_BAR; bar.x = 0; bar.st = nullptr;
    const int lo = args.p->ph_lo, hi = args.p->ph_hi;
    if (hi - lo > 1) bar = xcd_barrier_post((unsigned*)(args.ws + WS_CTL) + CW_BAR, (volatile LAS unsigned*)(lds + LDSCTL_OFF + LC_BAR));
#ifndef PHMASK
#define PHMASK 0xffffffffu
#endif
#define PHBIT(k) ((k) == 0 ? 0 : ((k) == NPHASE - 1 ? 12 : 1 + ((k) - 1) % PH_PER_LAYER))
#define IN(k) (((PHMASK >> PHBIT(k)) & 1u) && lo <= (k) && (k) < hi)
#define SEAM(k) do { if (IN(k) && IN((k) + 1)) xcd_barrier(bar); } while (0)
#define PH_BEGIN() int tid = threadIdx.x; asm volatile("" : "+v"(tid)); Args a = args; asm volatile("" : "+s"(a.p), "+s"(a.ws), "+s"(a.out)); unsigned char* ws = (unsigned char*)a.ws; \
    const int lane = tid & 63, wave = __builtin_amdgcn_readfirstlane(tid >> 6); int G = gridDim.x, bid = blockIdx.x; asm volatile("" : "+s"(G), "+s"(bid)); const int gw = bid * NWAVES + wave, NGW = G * NWAVES; (void)lane; (void)gw; (void)NGW; (void)ws

#ifndef PROBE_DUP
#define PROBE_DUP 0u
#endif
#define DUP(bit) if constexpr (((PROBE_DUP >> (bit)) & 1u) != 0u)
    enum { PB_CONVERT = 0, PB_NORM0, PB_GEMM1, PB_VT, PB_RWKVPREP, PB_SCAN, PB_ATTN, PB_POST, PB_BRANCH, PB_GATHER, PB_MOEK, PB_MOEL, PB_FINAL, PB_WOUT, PB_ROUTER, PB_MOEK_COLD, PB_MOEL_COLD, PB_MK5, PB_CKA, PB_CKB, PB_CKC };

    if (IN(0)) { { PH_BEGIN(); phase_convert<2>(a, 0, lds, gw, NGW, wave, lane); } DUP(PB_CONVERT) { PH_BEGIN(); phase_convert<2>(a, 0, lds, gw, NGW, wave, lane); } } SEAM(0);

#pragma unroll 1
    for (int l = 0; l < 2; ++l) {
        const int pb = 1 + l * PH_PER_LAYER;
        if (IN(pb + 0)) { { PH_BEGIN(); phase_norm<0>(a, a.inp(I_NORM_MIX) + (size_t)l * D, l > 0, l - 1, lds, tid, gw, NGW, lane, (l == 0) ? a.inp(I_X) : nullptr, a.inp(I_META)); }
            DUP(PB_NORM0) { if (l == 0) { PH_BEGIN(); phase_norm<0>(a, a.inp(I_NORM_MIX) + (size_t)l * D, false, 0, lds, tid, gw, NGW, lane, a.inp(I_X), a.inp(I_META)); } } } SEAM(pb + 0);
#define RUN_GEMM1() { PH_BEGIN(); pg8::RectOrder S; S.init(ws + WS_U, (const bf16*)(ws + WS_W1T) + (size_t)l * NZ * D, D, D, TP / 256, NZ / 256, G, bid); \
            pg8::EpiBf16 E{(bf16*)(ws + WS_Z), NZ, (const float*)(ws + WS_BIAS) + (size_t)l * NZ}; \
            pg8::gemm_phase<pg8::EpiBf16, pg8::RectOrder>(lds, pg8::Dims{D, D, D / 64}, S, E); }
        if (IN(pb + 1)) { RUN_GEMM1(); DUP(PB_GEMM1) RUN_GEMM1();
            { PH_BEGIN(); const int nfull = (TP / 256) * (NZ / 256) % G;
              if (l == 0) { if (nfull != 0 && bid >= nfull) phase_convert<0>(a, 1, lds, (bid - nfull) * NWAVES + wave, (G - nfull) * NWAVES, wave, lane); else if (nfull == 0) phase_convert<0>(a, 1, lds, gw, NGW, wave, lane); }
              else        { if (nfull != 0 && bid >= nfull) phase_convert<1>(a, 1, lds, (bid - nfull) * NWAVES + wave, (G - nfull) * NWAVES, wave, lane); else if (nfull == 0) phase_convert<1>(a, 1, lds, gw, NGW, wave, lane); } } } SEAM(pb + 1);
        if (IN(pb + 2)) { { PH_BEGIN(); phase_rope(a, gw, NGW, lane); } { PH_BEGIN(); phase_vt(a, gw, NGW, lane); } DUP(PB_VT) { PH_BEGIN(); phase_vt(a, gw, NGW, lane); }
            { PH_BEGIN(); phase_rwkvprep(a, l, lds, tid, gw, NGW, lane); } DUP(PB_RWKVPREP) { PH_BEGIN(); phase_rwkvprep(a, l, lds, tid, gw, NGW, lane); } } SEAM(pb + 2);
        if (IN(pb + 3)) { { PH_BEGIN(); phase_chunkA(a, lds, wave, lane, tid, bid, G); } DUP(PB_CKA) { PH_BEGIN(); phase_chunkA(a, lds, wave, lane, tid, bid, G); }
            { PH_BEGIN(); phase_attn(a, l, gw, NGW, lane); } DUP(PB_ATTN) { PH_BEGIN(); phase_attn(a, l, gw, NGW, lane); }
            xcd_barrier(bar);
            { PH_BEGIN(); phase_chunkB(a, lds, wave, lane, bid, G); if (wave != 0 && wave != 4 && l == 0) phase_convert<1>(a, 0, lds, bid * (NWAVES - 2) + (wave < 4 ? wave - 1 : wave - 2), G * (NWAVES - 2), wave, lane); }
            DUP(PB_CKB) { PH_BEGIN(); phase_chunkB(a, lds, wave, lane, bid, G); } xcd_barrier(bar);
            { PH_BEGIN(); phase_chunkC(a, l, gw, NGW, lane); } DUP(PB_CKC) { PH_BEGIN(); phase_chunkC(a, l, gw, NGW, lane); } }
        SEAM(pb + 3);
#define RUN_BRANCH() { \
            { PH_BEGIN(); pg8::RectOrder S; S.init(ws + WS_OATT, (const bf16*)(ws + WS_WAT) + (size_t)l * D * C, C, C, MBIG / 256, D / 256, G, bid); \
              pg8::EpiGate E{(bf16*)(ws + WS_T1), (const bf16*)(ws + WS_Z), ZGA, nullptr}; \
              pg8::gemm_phase<pg8::EpiGate, pg8::RectOrder>(lds, pg8::Dims{C, C, C / 64}, S, E); \
              skinny64((const bf16*)(ws + WS_OATT), C, (const bf16*)(ws + WS_WAT) + (size_t)l * D * C, C, D, C, MBIG, lds, SkGate{(bf16*)(ws + WS_T1), (const bf16*)(ws + WS_Z), ZGA, nullptr}, wave, lane, bid, G); } \
            { PH_BEGIN(); pg8::RectOrder S; S.init(ws + WS_ORW, (const bf16*)(ws + WS_WRT) + (size_t)l * D * C, C, C, MBIG / 256, D / 256, G, bid); \
              pg8::EpiGate E{(bf16*)(ws + WS_MIX), (const bf16*)(ws + WS_Z), ZGR, (const bf16*)(ws + WS_T1)}; \
              pg8::gemm_phase<pg8::EpiGate, pg8::RectOrder>(lds, pg8::Dims{C, C, C / 64}, S, E); \
              skinny64((const bf16*)(ws + WS_ORW), C, (const bf16*)(ws + WS_WRT) + (size_t)l * D * C, C, D, C, MBIG, lds, SkGate{(bf16*)(ws + WS_MIX), (const bf16*)(ws + WS_Z), ZGR, (const bf16*)(ws + WS_T1)}, wave, lane, bid, G); } }
        if (IN(pb + 5)) { RUN_BRANCH(); DUP(PB_BRANCH) RUN_BRANCH(); } SEAM(pb + 5);
#define RUN_WOUT(HP) { PH_BEGIN(); pg8::RectOrder S; S.init(ws + WS_MIX, (const bf16*)(ws + WS_WOT) + (size_t)l * D * D, D, D, MBIG / 256, D / 256, G, bid); \
            pg8::EpiResAdd E{(float*)(ws + (HP)), (l == 0) ? a.inp(I_X) : nullptr, a.inp(I_META)}; \
            pg8::gemm_phase<pg8::EpiResAdd, pg8::RectOrder>(lds, pg8::Dims{D, D, D / 64}, S, E); \
            skinny64((const bf16*)(ws + WS_MIX), D, (const bf16*)(ws + WS_WOT) + (size_t)l * D * D, D, D, D, MBIG, lds, SkRes{(float*)(ws + (HP)), (l == 0) ? a.inp(I_X) : nullptr, a.inp(I_META)}, wave, lane, bid, G); }
        if (IN(pb + 6)) { RUN_WOUT(WS_H); DUP(PB_WOUT) RUN_WOUT(WS_YR); } SEAM(pb + 6);
        if (IN(pb + 7)) { { PH_BEGIN(); phase_router(a, l, lds, wave, lane, bid, G); } DUP(PB_ROUTER) { PH_BEGIN(); phase_router(a, l, lds, wave, lane, bid, G, true); } } SEAM(pb + 7);
        if (IN(pb + 8)) { { PH_BEGIN(); moe_stream_phase<0>(a, l, lds, wave, lane, tid, bid, G); } DUP(PB_MOEK) { PH_BEGIN(); moe_stream_phase<0>(a, l, lds, wave, lane, tid, bid, G); }
            DUP(PB_MOEK_COLD) { PH_BEGIN(); moe_stream_phase<0>(a, l, lds, wave, lane, tid, bid, G, 1 - l, WS_T1); }
            DUP(PB_MK5) { PH_BEGIN(); moe_stream_phase<0, 5>(a, l, lds, wave, lane, tid, bid, G, 1 - l, WS_T1); } } SEAM(pb + 8);
        if (IN(pb + 9)) { { PH_BEGIN(); moe_stream_phase<1>(a, l, lds, wave, lane, tid, bid, G); } DUP(PB_MOEL) { PH_BEGIN(); moe_stream_phase<1>(a, l, lds, wave, lane, tid, bid, G); }
            DUP(PB_MOEL_COLD) { PH_BEGIN(); moe_stream_phase<1>(a, l, lds, wave, lane, tid, bid, G, 1 - l, WS_XR); } } SEAM(pb + 9);
    }
    if (IN(NPHASE - 1)) { { PH_BEGIN(); phase_norm<1>(a, a.inp(I_NORM_FINAL), true, 1, lds, tid, gw, NGW, lane); } DUP(PB_FINAL) { PH_BEGIN(); phase_norm<1>(a, a.inp(I_NORM_FINAL), true, 1, lds, tid, gw, NGW, lane); } }
#undef IN
#undef SEAM
}

extern "C" void kernel_launch(void* const* d_in, const int* in_sizes, int n_in, void* d_out, int out_size, void* d_ws, size_t ws_size, hipStream_t stream) {
    static int grid = 0;
    if (grid == 0) {
        if (n_in != 33 || ws_size < WS_END) { fprintf(stderr, "kernel_launch: need 33 inputs and %zu bytes of workspace (got %d, %zu)\n", (size_t)WS_END, n_in, ws_size); grid = -1; return; }
        int dev = 0, cus = 0, per_cu = 0;
        if (hipGetDevice(&dev) != hipSuccess || hipDeviceGetAttribute(&cus, hipDeviceAttributeMultiprocessorCount, dev) != hipSuccess) { grid = -1; return; }
        if (hipFuncSetAttribute((const void*)mk_fwd, hipFuncAttributeMaxDynamicSharedMemorySize, LDS_BYTES) != hipSuccess) { fprintf(stderr, "kernel_launch: hipFuncSetAttribute failed\n"); grid = -1; return; }
        if (hipOccupancyMaxActiveBlocksPerMultiprocessor(&per_cu, (const void*)mk_fwd, NTHR, LDS_BYTES) != hipSuccess || per_cu < 1) fprintf(stderr, "kernel_launch: occupancy query says %d\n", per_cu);
        (void)hipGetLastError();
        grid = cus;
    }
    if (grid < 0) return;
    (void)hipMemsetAsync((char*)d_ws + WS_CTL, 0, 256 * 1024, stream);
    ArgsV a{};
    for (int i = 0; i < 33; ++i) a.in[i] = (const float*)d_in[i];
    a.out = (float*)d_out; a.ws = (unsigned char*)d_ws;
#if MK_N_LAUNCHES == 1
    a.ph_lo = 0; a.ph_hi = NPHASE;
    hipLaunchKernelGGL(mk_fwd, dim3(grid), dim3(NTHR), LDS_BYTES, stream, a);
#else
    for (int p = 0; p < NPHASE; ++p) { a.ph_lo = p; a.ph_hi = p + 1; hipLaunchKernelGGL(mk_fwd, dim3(grid), dim3(NTHR), LDS_BYTES, stream, a); }
#endif
}
```
